# Optimizing an MI355X kernel written in HIP

```python
import jax, jax.numpy as jnp
from jax import lax
import numpy as np

D_MODEL = 1024
BATCH = 2
SEQ = 8192
DEPTH = 2

CTX_LEN = 256
GRID_W = 64
HEAD_DIM = 64
A_HEADS = 6
A_KV_HEADS = 2
B_HEADS = 6
B_KV_HEADS = 2
C_GROUPS = 4
C_GROUP_DIM = 64
A_Q = A_HEADS * HEAD_DIM
A_KV = A_KV_HEADS * HEAD_DIM
B_Q = B_HEADS * HEAD_DIM
B_KV = B_KV_HEADS * HEAD_DIM
C_WIDTH = C_GROUPS * C_GROUP_DIM
MIX_WIDTH = A_Q + B_Q + C_WIDTH
D_IN = A_Q + 2 * A_KV + B_Q + 2 * B_KV + C_WIDTH
WINDOW = 128
BLOCK = 128
D_FF = 2816
ROPE_THETA = 10000.0
NORM_EPS = 1e-6
N_MOD = 9
NEG_INF = -1e30

kernel_name = "hybrid_window_axial_fourier_macaron_dit"


def rms_norm(x, g):
    xf = x.astype(jnp.float32)
    y = xf * lax.rsqrt(jnp.mean(xf * xf, axis=-1, keepdims=True) + NORM_EPS)
    return (y * g.astype(jnp.float32)).astype(x.dtype)


def modulate(x, shift, scale):
    return x * (1 + scale) + shift


def swiglu(x, w_gate, w_up, w_down):
    return (jax.nn.silu(x @ w_gate) * (x @ w_up)) @ w_down


def axial_rope_angles(length):
    t = jnp.arange(length)
    row = (t // GRID_W).astype(jnp.float32)
    col = (t % GRID_W).astype(jnp.float32)
    half = HEAD_DIM // 2
    inv = ROPE_THETA ** (-jnp.arange(0, half, 2, dtype=jnp.float32) / half)
    return row[:, None] * inv, col[:, None] * inv


def _rotate_half(x, ang):
    n2 = x.shape[-1] // 2
    cos = jnp.cos(ang)[:, None, :]
    sin = jnp.sin(ang)[:, None, :]
    x1, x2 = x[..., :n2], x[..., n2:]
    return jnp.concatenate([x1 * cos - x2 * sin, x2 * cos + x1 * sin], axis=-1)


def apply_axial_rope(x, ang_row, ang_col):
    xf = x.astype(jnp.float32)
    half = HEAD_DIM // 2
    out = jnp.concatenate([_rotate_half(xf[..., :half], ang_row),
                           _rotate_half(xf[..., half:], ang_col)], axis=-1)
    return out.astype(x.dtype)


def split_mixer_inputs(u):
    bn, length = u.shape[:2]
    sizes = (A_Q, A_KV, A_KV, B_Q, B_KV, B_KV, C_WIDTH)
    idx = [int(i) for i in np.cumsum(sizes)[:-1]]
    qa, ka, va, qb, kb, vb, uf = jnp.split(u, idx, axis=-1)
    heads = lambda t: t.reshape(bn, length, -1, HEAD_DIM)
    return heads(qa), heads(ka), heads(va), heads(qb), heads(kb), heads(vb), uf


def window_attention_latent(q, k, v, k_ctx, v_ctx, sink):
    bn, length = q.shape[:2]
    nb = length // BLOCK
    g = A_HEADS // A_KV_HEADS
    span = BLOCK + 2 * WINDOW
    scale = HEAD_DIM ** -0.5
    qb = q.reshape(bn, nb, BLOCK, A_KV_HEADS, g, HEAD_DIM)
    pad = ((0, 0), (WINDOW, WINDOW), (0, 0), (0, 0))
    kp, vp = jnp.pad(k, pad), jnp.pad(v, pad)

    def band(t):
        return jnp.concatenate(
            [t[:, s:s + length].reshape(bn, nb, BLOCK, A_KV_HEADS, HEAD_DIM) for s in (0, BLOCK, 2 * BLOCK)],
            axis=2)

    kb, vb = band(kp), band(vp)
    s_band = jnp.einsum('bnqkgd,bnskd->bnkgqs', qb, kb, preferred_element_type=jnp.float32) * scale
    s_ctx = jnp.einsum('bnqkgd,bskd->bnkgqs', qb, k_ctx, preferred_element_type=jnp.float32) * scale
    qpos = jnp.arange(nb)[:, None, None] * BLOCK + jnp.arange(BLOCK)[None, :, None]
    kpos = jnp.arange(nb)[:, None, None] * BLOCK - WINDOW + jnp.arange(span)[None, None, :]
    valid = (jnp.abs(kpos - qpos) <= WINDOW) & (kpos >= 0) & (kpos < length)
    s_band = jnp.where(valid[None, :, None, None], s_band, NEG_INF)
    sink_l = jnp.broadcast_to(sink.astype(jnp.float32).reshape(1, 1, A_KV_HEADS, g, 1, 1),
                              s_band.shape[:-1] + (1,))
    p = jax.nn.softmax(jnp.concatenate([s_band, s_ctx, sink_l], axis=-1), axis=-1)
    lc = k_ctx.shape[1]
    p_band = p[..., :span].astype(v.dtype)
    p_ctx = p[..., span:span + lc].astype(v.dtype)
    o = (jnp.einsum('bnkgqs,bnskd->bnqkgd', p_band, vb)
         + jnp.einsum('bnkgqs,bskd->bnqkgd', p_ctx, v_ctx))
    return o.reshape(bn, length, A_Q)


def global_attention_latent(q, k, v, k_ctx, v_ctx):
    bn, length = q.shape[:2]
    nb = length // BLOCK
    g = B_HEADS // B_KV_HEADS
    scale = HEAD_DIM ** -0.5
    qb = q.reshape(bn, nb, BLOCK, B_KV_HEADS, g, HEAD_DIM).transpose(1, 0, 2, 3, 4, 5)

    def one_block(qblk):
        s_lat = jnp.einsum('bqkgd,bskd->bkgqs', qblk, k, preferred_element_type=jnp.float32) * scale
        s_ctx = jnp.einsum('bqkgd,bskd->bkgqs', qblk, k_ctx, preferred_element_type=jnp.float32) * scale
        p = jax.nn.softmax(jnp.concatenate([s_lat, s_ctx], axis=-1), axis=-1).astype(v.dtype)
        return (jnp.einsum('bkgqs,bskd->bqkgd', p[..., :length], v)
                + jnp.einsum('bkgqs,bskd->bqkgd', p[..., length:], v_ctx))

    o = lax.map(one_block, qb)
    return o.transpose(1, 0, 2, 3, 4, 5).reshape(bn, length, B_Q)


def ctx_attention(q, k, v, sink=None):
    bn, lc, hq, _ = q.shape
    hk = k.shape[2]
    g = hq // hk
    qg = q.reshape(bn, lc, hk, g, HEAD_DIM)
    s = jnp.einsum('bqkgd,bskd->bkgqs', qg, k, preferred_element_type=jnp.float32) * (HEAD_DIM ** -0.5)
    if sink is not None:
        sink_l = jnp.broadcast_to(sink.astype(jnp.float32).reshape(1, hk, g, 1, 1), s.shape[:-1] + (1,))
        s = jnp.concatenate([s, sink_l], axis=-1)
    p = jax.nn.softmax(s, axis=-1)[..., :lc].astype(v.dtype)
    o = jnp.einsum('bkgqs,bskd->bqkgd', p, v)
    return o.reshape(bn, lc, hq * HEAD_DIM)


def fourier_mix(u, w_four):
    bn, length = u.shape[:2]
    ug = u.astype(jnp.float32).reshape(bn, length, C_GROUPS, C_GROUP_DIM)
    f = jnp.fft.fft2(ug, axes=(1, 3), norm='ortho').real.astype(u.dtype)
    return jnp.einsum('blgc,gcd->blgd', f, w_four).reshape(bn, length, C_WIDTH)


def trunk_layer(h, hc, c, c_ctx, p, ang_row, ang_col, update_ctx):
    mod = (jax.nn.silu(c) @ p['w_ada'] + p['b_ada'])[:, None, :]
    mod_c = jax.nn.silu(c_ctx) @ p['w_ada'] + p['b_ada']
    s1, sc1, g1, s2, sc2, g2, s3, sc3, g3 = jnp.split(mod, N_MOD, axis=-1)
    s1c, sc1c, g1c, s2c, sc2c, g2c, s3c, sc3c, g3c = jnp.split(mod_c, N_MOD, axis=-1)

    h = h + 0.5 * g1 * swiglu(modulate(rms_norm(h, p['g_ffn1']), s1, sc1), p['w1_gate'], p['w1_up'], p['w1_down'])
    hc = hc + 0.5 * g1c * swiglu(modulate(rms_norm(hc, p['g_ffn1']), s1c, sc1c), p['w1_gate'], p['w1_up'], p['w1_down'])

    qa, ka, va, qb, kb, vb, uf = split_mixer_inputs(modulate(rms_norm(h, p['g_mix']), s2, sc2) @ p['w_in'])
    qa_c, ka_c, va_c, qb_c, kb_c, vb_c, uf_c = split_mixer_inputs(
        modulate(rms_norm(hc, p['g_mix']), s2c, sc2c) @ p['w_in'])
    qb, kb = rms_norm(qb, p['g_qn']), rms_norm(kb, p['g_kn'])
    qb_c, kb_c = rms_norm(qb_c, p['g_qn']), rms_norm(kb_c, p['g_kn'])
    qa, ka = apply_axial_rope(qa, ang_row, ang_col), apply_axial_rope(ka, ang_row, ang_col)
    qb, kb = apply_axial_rope(qb, ang_row, ang_col), apply_axial_rope(kb, ang_row, ang_col)

    o = jnp.concatenate([
        window_attention_latent(qa, ka, va, ka_c, va_c, p['sink']),
        global_attention_latent(qb, kb, vb, kb_c, vb_c),
        fourier_mix(uf, p['w_four']),
    ], axis=-1) @ p['w_out']
    h = h + g2 * o

    h = h + 0.5 * g3 * swiglu(modulate(rms_norm(h, p['g_ffn2']), s3, sc3), p['w2_gate'], p['w2_up'], p['w2_down'])

    if update_ctx:
        oc = jnp.concatenate([
            ctx_attention(qa_c, ka_c, va_c, p['sink']),
            ctx_attention(qb_c, kb_c, vb_c),
            fourier_mix(uf_c, p['w_four']),
        ], axis=-1) @ p['w_out']
        hc = hc + g2c * oc
        hc = hc + 0.5 * g3c * swiglu(modulate(rms_norm(hc, p['g_ffn2']), s3c, sc3c),
                                     p['w2_gate'], p['w2_up'], p['w2_down'])
    return h, hc


def setup_inputs(seed: int = 0) -> dict:
    key = jax.random.key(seed)
    ks = jax.random.split(key, 24)
    f32 = jnp.float32
    nrm = lambda k, shape, s: jax.random.normal(k, shape, f32) * s
    gain = lambda k, shape: 1.0 + 0.02 * jax.random.normal(k, shape, f32)
    D, L = DEPTH, D_MODEL
    return {
        'x': nrm(ks[0], (BATCH, SEQ, D_MODEL), 1.0),
        'c': nrm(ks[1], (BATCH, D_MODEL), 1.0),
        'ctx': nrm(ks[2], (BATCH, CTX_LEN, D_MODEL), 1.0),
        'c_ctx': nrm(ks[3], (D_MODEL,), 1.0),
        'w_ada': nrm(ks[4], (D, L, N_MOD * L), 0.5 * L ** -0.5),
        'b_ada': nrm(ks[5], (D, N_MOD * L), 0.01),
        'g_ffn1': gain(ks[6], (D, L)),
        'g_mix': gain(ks[7], (D, L)),
        'g_ffn2': gain(ks[8], (D, L)),
        'w_in': nrm(ks[9], (D, L, D_IN), L ** -0.5),
        'g_qn': gain(ks[10], (D, HEAD_DIM)),
        'g_kn': gain(ks[11], (D, HEAD_DIM)),
        'sink': nrm(ks[12], (D, A_HEADS), 0.5),
        'w_four': nrm(ks[13], (D, C_GROUPS, C_GROUP_DIM, C_GROUP_DIM), C_GROUP_DIM ** -0.5),
        'w_out': nrm(ks[14], (D, MIX_WIDTH, L), MIX_WIDTH ** -0.5),
        'w1_gate': nrm(ks[15], (D, L, D_FF), L ** -0.5),
        'w1_up': nrm(ks[16], (D, L, D_FF), L ** -0.5),
        'w1_down': nrm(ks[17], (D, D_FF, L), D_FF ** -0.5),
        'w2_gate': nrm(ks[18], (D, L, D_FF), L ** -0.5),
        'w2_up': nrm(ks[19], (D, L, D_FF), L ** -0.5),
        'w2_down': nrm(ks[20], (D, D_FF, L), D_FF ** -0.5),
        'g_final': gain(ks[21], (L,)),
    }


def reference(x, c, ctx, c_ctx, w_ada, b_ada, g_ffn1, g_mix, g_ffn2, w_in, g_qn, g_kn, sink, w_four,
              w_out, w1_gate, w1_up, w1_down, w2_gate, w2_up, w2_down, g_final):
    length = x.shape[1]
    ang_row, ang_col = axial_rope_angles(length)
    h, hc = x, ctx
    for l in range(DEPTH):
        p = {
            'w_ada': w_ada[l], 'b_ada': b_ada[l], 'g_ffn1': g_ffn1[l], 'g_mix': g_mix[l], 'g_ffn2': g_ffn2[l],
            'w_in': w_in[l], 'g_qn': g_qn[l], 'g_kn': g_kn[l], 'sink': sink[l], 'w_four': w_four[l],
            'w_out': w_out[l], 'w1_gate': w1_gate[l], 'w1_up': w1_up[l], 'w1_down': w1_down[l],
            'w2_gate': w2_gate[l], 'w2_up': w2_up[l], 'w2_down': w2_down[l],
        }
        h, hc = trunk_layer(h, hc, c, c_ctx, p, ang_row, ang_col, update_ctx=(l < DEPTH - 1))
    return rms_norm(h, g_final)
```

```cpp
#include <hip/hip_runtime.h>
#include <stdint.h>
#include <cstdio>

typedef unsigned short bf16_t;
__device__ __forceinline__ float bf2f(bf16_t v) { return __uint_as_float(((unsigned)v) << 16); }
__device__ __forceinline__ bf16_t f2bf(float f) { unsigned u = __float_as_uint(f); return (bf16_t)((u + 0x7fffu + ((u >> 16) & 1u)) >> 16); }

constexpr int DM = 1024, NB = 2, SEQ = 8192, CTXL = 256, RPB = SEQ + CTXL, M = NB * RPB, DFF = 2816, DIN = 1536, NMOD = 9216;
constexpr float QSCALE = 0.125f * 1.4426950408889634f;
constexpr float LOG2E = 1.4426950408889634f;
constexpr size_t MiB = 1u << 20;
constexpr size_t WS_H = 0, WS_XN = 66 * MiB, WS_MID = 99 * MiB;
constexpr size_t WS_QA = 99 * MiB, WS_QB = 112 * MiB, WS_KA = 125 * MiB, WS_KB = 130 * MiB, WS_VTA = 135 * MiB, WS_VTB = 140 * MiB, WS_VS = 145 * MiB, WS_ZS = 161 * MiB, WS_VC = 177 * MiB;
constexpr size_t WS_MOD = 190 * MiB, WS_TAB = 191 * MiB, WS_WT = 192 * MiB;
constexpr int TAB_COS = 0, TAB_ROPE = 8192;

__device__ __forceinline__ float silu_f(float x) { return x / (1.f + __expf(-x)); }
__device__ __forceinline__ int row_w(int row) { int b = row / RPB, t = row - b * RPB; return t >= SEQ ? 2 : b; }

__global__ void k_tables(float* TAB) {
    int i = blockIdx.x * 256 + threadIdx.x;
    if (i < 8192) TAB[TAB_COS + i] = cospif((float)i / 4096.f);
    if (i < 192 * 16) {
        int p = i / 16, k = i % 16;
        float inv = powf(10000.f, -(float)(2 * k) / 32.f);
        float pos = (float)(p < 128 ? p : p - 128);
        float ang = pos * inv;
        TAB[TAB_ROPE + i * 2] = cosf(ang); TAB[TAB_ROPE + i * 2 + 1] = sinf(ang);
    }
}
__global__ void k_mod(const float* c, const float* cctx, const float* w_ada, const float* b_ada, float* MOD) {
    __shared__ float sv[3][1024];
    for (int i = threadIdx.x; i < 1024; i += 256) { sv[0][i] = silu_f(c[i]); sv[1][i] = silu_f(c[1024 + i]); sv[2][i] = silu_f(cctx[i]); }
    __syncthreads();
    int idx = blockIdx.x * 256 + threadIdx.x;
    if (idx >= 2 * NMOD) return;
    int l = idx / NMOD, n = idx % NMOD;
    const float* W = w_ada + (size_t)l * 1024 * NMOD + n;
    float a0 = 0, a1 = 0, a2 = 0;
#pragma unroll 8
    for (int k = 0; k < 1024; ++k) { float w = W[(size_t)k * NMOD]; a0 += sv[0][k] * w; a1 += sv[1][k] * w; a2 += sv[2][k] * w; }
    float bb = b_ada[l * NMOD + n];
    MOD[(l * 3 + 0) * NMOD + n] = a0 + bb; MOD[(l * 3 + 1) * NMOD + n] = a1 + bb; MOD[(l * 3 + 2) * NMOD + n] = a2 + bb;
}
__global__ void k_init(const float* x, const float* ctx, float* H) {
    size_t i = (size_t)blockIdx.x * 256 + threadIdx.x;
    if (i >= (size_t)M * DM / 4) return;
    int row = (int)(i / 256), c4 = (int)(i % 256);
    int b = row / RPB, t = row - b * RPB;
    const float4* src = t < SEQ ? (const float4*)(x + ((size_t)b * SEQ + t) * DM) : (const float4*)(ctx + ((size_t)b * CTXL + (t - SEQ)) * DM);
    ((float4*)H)[i] = src[c4];
}
__global__ void k_wofold(const float* w_out, const float* w_four, float* WO2) {
    int idx = blockIdx.x * 256 + threadIdx.x;
    int l = idx >> 20, r = (idx >> 10) & 1023, n = idx & 1023;
    const float* wo = w_out + (size_t)l * 1024 * 1024;
    float v;
    if (r < 768) v = wo[r * 1024 + n];
    else { int g = (r - 768) >> 6, cc = (r - 768) & 63; const float* wf = w_four + ((size_t)(l * 4 + g) * 64 + cc) * 64; v = 0.f;
        for (int d = 0; d < 64; ++d) v += wf[d] * wo[(768 + g * 64 + d) * 1024 + n]; }
    WO2[idx] = v;
}
__global__ void k_norm(const float* H, const float* g, const float* MODl, int shift_chunk, int scale_chunk, bf16_t* XN) {
    int row = blockIdx.x * 4 + (threadIdx.x >> 6), lane = threadIdx.x & 63;
    const float4* h = (const float4*)(H + (size_t)row * DM);
    float4 v[4]; float ss = 0.f;
#pragma unroll
    for (int j = 0; j < 4; ++j) { v[j] = h[lane + 64 * j]; ss += v[j].x * v[j].x + v[j].y * v[j].y + v[j].z * v[j].z + v[j].w * v[j].w; }
#pragma unroll
    for (int o = 1; o < 64; o <<= 1) ss += __shfl_xor(ss, o);
    float r = rsqrtf(ss * (1.f / DM) + 1e-6f);
    int w = row_w(row);
    const float* sh = MODl + w * NMOD + shift_chunk * 1024; const float* sc = MODl + w * NMOD + scale_chunk * 1024;
#pragma unroll
    for (int j = 0; j < 4; ++j) { int c = (lane + 64 * j) * 4; float4 gg = *(const float4*)(g + c), s4 = *(const float4*)(sh + c), c4 = *(const float4*)(sc + c);
        ushort4 o; o.x = f2bf(v[j].x * r * gg.x * (1.f + c4.x) + s4.x); o.y = f2bf(v[j].y * r * gg.y * (1.f + c4.y) + s4.y);
        o.z = f2bf(v[j].z * r * gg.z * (1.f + c4.z) + s4.z); o.w = f2bf(v[j].w * r * gg.w * (1.f + c4.w) + s4.w);
        *(ushort4*)(XN + (size_t)row * DM + c) = o; }
}
__global__ void k_final(const float* H, const float* g, float* out) {
    int orow = blockIdx.x * 4 + (threadIdx.x >> 6), lane = threadIdx.x & 63;
    int b = orow / SEQ, t = orow % SEQ; int row = b * RPB + t;
    const float4* h = (const float4*)(H + (size_t)row * DM);
    float4 v[4]; float ss = 0.f;
#pragma unroll
    for (int j = 0; j < 4; ++j) { v[j] = h[lane + 64 * j]; ss += v[j].x * v[j].x + v[j].y * v[j].y + v[j].z * v[j].z + v[j].w * v[j].w; }
#pragma unroll
    for (int o = 1; o < 64; o <<= 1) ss += __shfl_xor(ss, o);
    float r = rsqrtf(ss * (1.f / DM) + 1e-6f);
#pragma unroll
    for (int j = 0; j < 4; ++j) { int c = (lane + 64 * j) * 4; float4 gg = *(const float4*)(g + c);
        float4 o; o.x = v[j].x * r * gg.x; o.y = v[j].y * r * gg.y; o.z = v[j].z * r * gg.z; o.w = v[j].w * r * gg.w;
        *(float4*)(out + (size_t)orow * DM + c) = o; }
}

struct EpiArgs {
    bf16_t* MIDo;
    float* H; const float* MODl; int gate_chunk; float coef;
    const float* gqn; const float* gkn; const float* TAB;
    bf16_t *QA, *QB, *KA, *KB, *VTA, *VTB, *VS, *VC;
};
template <int EPI, bool DUAL>
__global__ void __launch_bounds__(256) gemm_naive(const bf16_t* A, int K, const float* W0, const float* W1, int N, EpiArgs e) {
    __shared__ float As[16][68];
    __shared__ float Bs0[16][64];
    __shared__ float Bs1[DUAL ? 16 : 1][64];
    __shared__ float Ct[64][65];
    __shared__ float cs64[64];
    const int tid = threadIdx.x, tx = tid & 15, ty = tid >> 4;
    const int n0 = blockIdx.x * 64, m0 = blockIdx.y * 64;
    float acc[4][4] = {}, acc1[4][4] = {};
    for (int k0 = 0; k0 < K; k0 += 16) {
        { int r = tid >> 2, kk = (tid & 3) * 4; const bf16_t* ap = A + (size_t)(m0 + r) * K + k0 + kk; ushort4 a4 = *(const ushort4*)ap;
          As[kk][r] = bf2f(a4.x); As[kk + 1][r] = bf2f(a4.y); As[kk + 2][r] = bf2f(a4.z); As[kk + 3][r] = bf2f(a4.w); }
        { int kk = tid >> 4, nn = (tid & 15) * 4; *(float4*)&Bs0[kk][nn] = *(const float4*)(W0 + (size_t)(k0 + kk) * N + n0 + nn);
          if (DUAL) *(float4*)&Bs1[kk][nn] = *(const float4*)(W1 + (size_t)(k0 + kk) * N + n0 + nn); }
        __syncthreads();
#pragma unroll
        for (int kk = 0; kk < 16; ++kk) {
            float a[4], b[4], b1[4];
#pragma unroll
            for (int i = 0; i < 4; ++i) a[i] = As[kk][ty * 4 + i];
#pragma unroll
            for (int j = 0; j < 4; ++j) { b[j] = Bs0[kk][tx * 4 + j]; if (DUAL) b1[j] = Bs1[kk][tx * 4 + j]; }
#pragma unroll
            for (int i = 0; i < 4; ++i)
#pragma unroll
                for (int j = 0; j < 4; ++j) { acc[i][j] += a[i] * b[j]; if (DUAL) acc1[i][j] += a[i] * b1[j]; }
        }
        __syncthreads();
    }
    if (EPI == 0) {
#pragma unroll
        for (int i = 0; i < 4; ++i)
#pragma unroll
            for (int j = 0; j < 4; ++j) { int m = m0 + ty * 4 + i, n = n0 + tx * 4 + j; e.MIDo[(size_t)m * N + n] = f2bf(silu_f(acc[i][j]) * acc1[i][j]); }
    } else if (EPI == 1) {
#pragma unroll
        for (int i = 0; i < 4; ++i) { int m = m0 + ty * 4 + i; int w = row_w(m); const float* gate = e.MODl + w * NMOD + e.gate_chunk * 1024;
#pragma unroll
            for (int j = 0; j < 4; ++j) { int n = n0 + tx * 4 + j; e.H[(size_t)m * DM + n] += e.coef * gate[n] * acc[i][j]; } }
    } else {
#pragma unroll
        for (int i = 0; i < 4; ++i)
#pragma unroll
            for (int j = 0; j < 4; ++j) Ct[ty * 4 + i][tx * 4 + j] = acc[i][j];
        if (tid < 64) cs64[tid] = e.TAB[TAB_COS + tid * 128];
        __syncthreads();
        if (tid < 64) {
            float* x = Ct[tid];
            const int row = m0 + tid, b = row / RPB, t = row - b * RPB; const bool lat = t < SEQ;
            const int unit = n0 >> 6;
            const bool isq = unit < 6 || (unit >= 10 && unit < 16), isk = (unit >= 6 && unit < 8) || (unit >= 16 && unit < 18);
            const bool isv = (unit >= 8 && unit < 10) || (unit >= 18 && unit < 20), isB = unit >= 10;
            if (unit >= 20) {
                const int g = unit - 20;
                for (int d = 0; d < 64; ++d) { float vr = 0.f, vi = 0.f;
                    for (int cc = 0; cc < 64; ++cc) { int j = (d * cc) & 63; vr += x[cc] * cs64[j]; vi -= x[cc] * cs64[(j - 16) & 63]; }
                    int ch = g * 64 + d; unsigned pk = (unsigned)f2bf(vr) | ((unsigned)f2bf(vi) << 16);
                    if (lat) { int l2 = t & 127, l1 = t >> 7; ((unsigned*)e.VS)[((size_t)(b * 128 + l2) * 256 + ch) * 64 + l1] = pk; }
                    else { int j = t - SEQ; ((unsigned*)e.VC)[((size_t)(b * 256 + ch)) * 256 + j] = pk; } }
            } else {
                if (isB && (isq || isk)) { const float* gg = isq ? e.gqn : e.gkn; float ss = 0.f; for (int d = 0; d < 64; ++d) ss += x[d] * x[d];
                    float r = rsqrtf(ss * (1.f / 64.f) + 1e-6f); for (int d = 0; d < 64; ++d) x[d] = x[d] * r * gg[d]; }
                if ((isq || isk) && lat) { const float* rr = e.TAB + TAB_ROPE + (t >> 6) * 32; const float* rc = e.TAB + TAB_ROPE + (128 + (t & 63)) * 32;
                    for (int i = 0; i < 16; ++i) { float c = rr[2 * i], s = rr[2 * i + 1]; float a = x[i], bb = x[i + 16]; x[i] = a * c - bb * s; x[i + 16] = bb * c + a * s;
                        c = rc[2 * i]; s = rc[2 * i + 1]; a = x[32 + i]; bb = x[48 + i]; x[32 + i] = a * c - bb * s; x[48 + i] = bb * c + a * s; } }
                if (isq) { int h = isB ? unit - 10 : unit; bf16_t* o = (isB ? e.QB : e.QA) + (size_t)row * 384 + h * 64; for (int d = 0; d < 64; ++d) o[d] = f2bf(x[d] * QSCALE); }
                else if (isk) { int h = isB ? unit - 16 : unit - 6; bf16_t* o = (isB ? e.KB : e.KA) + (size_t)row * 128 + h * 64; for (int d = 0; d < 64; ++d) o[d] = f2bf(x[d]); }
                else if (isv) { int h = isB ? unit - 18 : unit - 8; bf16_t* o = (isB ? e.VTB : e.VTA) + ((size_t)(b * 2 + h) * 64) * RPB + t; for (int d = 0; d < 64; ++d) o[(size_t)d * RPB] = f2bf(x[d]); }
            }
        }
    }
}

__global__ void __launch_bounds__(64) attn_naive(const bf16_t* QA, const bf16_t* QB, const bf16_t* KA, const bf16_t* KB, const bf16_t* VTA, const bf16_t* VTB,
                                                   const float* sink, bf16_t* OM, int do_ctx) {
    const int rb = blockIdx.x, hh = blockIdx.y;
    const int row = rb * 64 + threadIdx.x, b = row / RPB, t = row - b * RPB; const bool lat = t < SEQ;
    if (!lat && !do_ctx) return;
    const bool isB = hh >= 6; const int h = isB ? hh - 6 : hh, kvh = h / 3;
    const bf16_t* Q = (isB ? QB : QA) + (size_t)row * 384 + h * 64;
    const bf16_t* K = (isB ? KB : KA) + (size_t)b * RPB * 128 + kvh * 64;
    const bf16_t* VT = (isB ? VTB : VTA) + ((size_t)(b * 2 + kvh) * 64) * RPB;
    float q[64], o[64];
#pragma unroll
    for (int d = 0; d < 64; ++d) { q[d] = bf2f(Q[d]); o[d] = 0.f; }
    float m = -1e30f, l = 0.f;
    const int t0 = (rb * 64) % RPB;
    int lo1, hi1; bool band = false;
    if (!lat) { lo1 = SEQ; hi1 = RPB; } else if (isB) { lo1 = 0; hi1 = RPB; } else { lo1 = max(0, t0 - 128); hi1 = min(SEQ, t0 + 64 + 128); band = true; }
    for (int seg = 0; seg < 2; ++seg) {
        int lo = seg == 0 ? lo1 : SEQ, hi = seg == 0 ? hi1 : RPB;
        if (seg == 1 && !(lat && !isB)) break;
        for (int key = lo; key < hi; ++key) {
            const bf16_t* kp = K + (size_t)key * 128; float s = 0.f;
#pragma unroll
            for (int d = 0; d < 64; ++d) s += q[d] * bf2f(kp[d]);
            bool valid = !(band && seg == 0) || (abs(key - t) <= 128);
            if (valid) {
                if (s > m) { float al = exp2f(m - s); l *= al;
#pragma unroll
                    for (int d = 0; d < 64; ++d) o[d] *= al;
                    m = s; }
                float p = exp2f(s - m); l += p;
#pragma unroll
                for (int d = 0; d < 64; ++d) o[d] += p * bf2f(VT[(size_t)d * RPB + key]);
            }
        }
    }
    if (!isB) { float s2 = sink[h] * LOG2E; float mf = fmaxf(m, s2); float al = exp2f(m - mf); l = l * al + exp2f(s2 - mf);
#pragma unroll
        for (int d = 0; d < 64; ++d) o[d] *= al; }
    float il = 1.f / l;
    bf16_t* op = OM + (size_t)row * DM + (isB ? 384 : 0) + h * 64;
#pragma unroll
    for (int d = 0; d < 64; ++d) op[d] = f2bf(o[d] * il);
}

__global__ void __launch_bounds__(256) fourier_lat_naive(const bf16_t* VS, const float* TAB, bf16_t* OM) {
    __shared__ float ct[8192];
    for (int i = threadIdx.x; i < 8192; i += 256) ct[i] = TAB[TAB_COS + i];
    __syncthreads();
    const int b = blockIdx.x / SEQ, k = blockIdx.x % SEQ, ch = threadIdx.x;
    float acc = 0.f;
    for (int l2 = 0; l2 < 128; ++l2) {
        const unsigned* vp = (const unsigned*)VS + ((size_t)(b * 128 + l2) * 256 + ch) * 64;
        for (int l1 = 0; l1 < 64; ++l1) { unsigned pk = vp[l1]; float vr = bf2f((bf16_t)(pk & 0xffff)), vi = bf2f((bf16_t)(pk >> 16));
            int l = l1 * 128 + l2; int j = (k * l) & 8191; acc += vr * ct[j] + vi * ct[(j - 2048) & 8191]; }
    }
    OM[(size_t)(b * RPB + k) * DM + 768 + ch] = f2bf(acc * 0.0013810679320049757f);
}
__global__ void __launch_bounds__(256) fourier_ctx_naive(const bf16_t* VC, const float* TAB, bf16_t* OM) {
    const int b = blockIdx.x / CTXL, k = blockIdx.x % CTXL, ch = threadIdx.x;
    const unsigned* vp = (const unsigned*)VC + ((size_t)(b * 256 + ch)) * 256;
    float acc = 0.f;
    for (int j = 0; j < 256; ++j) { unsigned pk = vp[j]; float vr = bf2f((bf16_t)(pk & 0xffff)), vi = bf2f((bf16_t)(pk >> 16));
        int a = ((k * j) & 255) * 32; acc += vr * TAB[TAB_COS + a] + vi * TAB[TAB_COS + ((a - 2048) & 8191)]; }
    OM[(size_t)(b * RPB + SEQ + k) * DM + 768 + ch] = f2bf(acc * (1.f / 128.f));
}

extern "C" void kernel_launch(void* const* d_in, const int* in_sizes, int n_in, void* d_out, int out_size, void* d_ws, size_t ws_size, hipStream_t stream) {
    const float* x = (const float*)d_in[0]; const float* c = (const float*)d_in[1]; const float* ctx = (const float*)d_in[2]; const float* cctx = (const float*)d_in[3];
    const float* w_ada = (const float*)d_in[4]; const float* b_ada = (const float*)d_in[5];
    const float* g_ffn1 = (const float*)d_in[6]; const float* g_mix = (const float*)d_in[7]; const float* g_ffn2 = (const float*)d_in[8];
    const float* w_in = (const float*)d_in[9]; const float* g_qn = (const float*)d_in[10]; const float* g_kn = (const float*)d_in[11];
    const float* sink = (const float*)d_in[12]; const float* w_four = (const float*)d_in[13]; const float* w_out = (const float*)d_in[14];
    const float* w1g = (const float*)d_in[15]; const float* w1u = (const float*)d_in[16]; const float* w1d = (const float*)d_in[17];
    const float* w2g = (const float*)d_in[18]; const float* w2u = (const float*)d_in[19]; const float* w2d = (const float*)d_in[20];
    const float* g_final = (const float*)d_in[21];
    unsigned char* ws = (unsigned char*)d_ws;
    float* H = (float*)(ws + WS_H); bf16_t* XN = (bf16_t*)(ws + WS_XN); bf16_t* MID = (bf16_t*)(ws + WS_MID); bf16_t* OM = XN;
    float* MOD = (float*)(ws + WS_MOD); float* TAB = (float*)(ws + WS_TAB); float* WO2 = (float*)(ws + WS_WT);
    EpiArgs e{}; e.H = H; e.TAB = TAB;
    e.QA = (bf16_t*)(ws + WS_QA); e.QB = (bf16_t*)(ws + WS_QB); e.KA = (bf16_t*)(ws + WS_KA); e.KB = (bf16_t*)(ws + WS_KB);
    e.VTA = (bf16_t*)(ws + WS_VTA); e.VTB = (bf16_t*)(ws + WS_VTB); e.VS = (bf16_t*)(ws + WS_VS); e.VC = (bf16_t*)(ws + WS_VC);
    if (ws_size < 280 * MiB) { fprintf(stderr, "ws too small %zu\n", ws_size); return; }

    k_tables<<<32, 256, 0, stream>>>(TAB);
    k_mod<<<(2 * NMOD + 255) / 256, 256, 0, stream>>>(c, cctx, w_ada, b_ada, MOD);
    k_init<<<(M * DM / 4 + 255) / 256, 256, 0, stream>>>(x, ctx, H);
    k_wofold<<<2 * 1024 * 1024 / 256, 256, 0, stream>>>(w_out, w_four, WO2);
    for (int l = 0; l < 2; ++l) {
        const float* MODl = MOD + (size_t)l * 3 * NMOD; e.MODl = MODl;
        const size_t fo = (size_t)l * 1024 * DFF;
        k_norm<<<M / 4, 256, 0, stream>>>(H, g_ffn1 + l * 1024, MODl, 0, 1, XN);
        e.MIDo = MID;
        gemm_naive<0, true><<<dim3(DFF / 64, M / 64), 256, 0, stream>>>(XN, 1024, w1g + fo, w1u + fo, DFF, e);
        e.gate_chunk = 2; e.coef = 0.5f;
        gemm_naive<1, false><<<dim3(DM / 64, M / 64), 256, 0, stream>>>(MID, DFF, w1d + fo, nullptr, DM, e);
        k_norm<<<M / 4, 256, 0, stream>>>(H, g_mix + l * 1024, MODl, 3, 4, XN);
        e.gqn = g_qn + l * 64; e.gkn = g_kn + l * 64;
        gemm_naive<2, false><<<dim3(DIN / 64, M / 64), 256, 0, stream>>>(XN, 1024, w_in + (size_t)l * 1024 * DIN, nullptr, DIN, e);
        attn_naive<<<dim3(M / 64, 12), 64, 0, stream>>>(e.QA, e.QB, e.KA, e.KB, e.VTA, e.VTB, sink + l * 6, OM, l == 0 ? 1 : 0);
        fourier_lat_naive<<<NB * SEQ, 256, 0, stream>>>(e.VS, TAB, OM);
        if (l == 0) fourier_ctx_naive<<<NB * CTXL, 256, 0, stream>>>(e.VC, TAB, OM);
        e.gate_chunk = 5; e.coef = 1.0f;
        gemm_naive<1, false><<<dim3(DM / 64, M / 64), 256, 0, stream>>>(OM, 1024, WO2 + (size_t)l * 1024 * 1024, nullptr, DM, e);
        k_norm<<<M / 4, 256, 0, stream>>>(H, g_ffn2 + l * 1024, MODl, 6, 7, XN);
        gemm_naive<0, true><<<dim3(DFF / 64, M / 64), 256, 0, stream>>>(XN, 1024, w2g + fo, w2u + fo, DFF, e);
        e.gate_chunk = 8; e.coef = 0.5f;
        gemm_naive<1, false><<<dim3(DM / 64, M / 64), 256, 0, stream>>>(MID, DFF, w2d + fo, nullptr, DM, e);
    }
    k_final<<<NB * SEQ / 4, 256, 0, stream>>>(H, g_final, (float*)d_out);
}
```

```cpp
#include <hip/hip_runtime.h>
#include <hip/hip_cooperative_groups.h>
#include <stdint.h>
#include <cstdio>
namespace cg = cooperative_groups;

typedef unsigned short bf16_t;
__device__ __forceinline__ float bf2f(bf16_t v) { return __uint_as_float(((unsigned)v) << 16); }
__device__ __forceinline__ bf16_t f2bf(float f) { unsigned u = __float_as_uint(f); return (bf16_t)((u + 0x7fffu + ((u >> 16) & 1u)) >> 16); }
__device__ __forceinline__ unsigned pk2(float lo, float hi) { return (unsigned)f2bf(lo) | ((unsigned)f2bf(hi) << 16); }

constexpr int DM = 1024, NB = 2, SEQ = 8192, CTXL = 256, RPB = SEQ + CTXL, M = NB * RPB, DFF = 2816, DIN = 1536, NMOD = 9216, NIN = 1792;
constexpr float QSCALE = 0.125f * 1.4426950408889634f;
constexpr float LOG2E = 1.4426950408889634f;
constexpr size_t MiB = 1u << 20;
constexpr size_t WS_H = 0, WS_XN = 66 * MiB, WS_MID = 99 * MiB;
constexpr size_t WS_QA = 99 * MiB, WS_QB = 112 * MiB, WS_KA = 125 * MiB, WS_KB = 130 * MiB, WS_VTA = 135 * MiB, WS_VTB = 140 * MiB, WS_VS = 145 * MiB, WS_ZS = 161 * MiB, WS_VC = 177 * MiB;
constexpr size_t WS_MOD = 190 * MiB, WS_TAB = 191 * MiB, WS_WT = 192 * MiB, WS_END = 270 * MiB;
constexpr int TAB_COS = 0, TAB_ROPE = 8192;
constexpr size_t TAB_D1_BYTES = 65536, TAB_D3_BYTES = 65536 + 32768;
constexpr size_t WT_GU = 0, WT_DN = 2ull * 5632 * 1024, WT_IN = WT_DN + 2ull * 1024 * 2816, WT_OUT = WT_IN + 1792ull * 1024, WT_L = WT_OUT + 1024ull * 1024;
static_assert(WS_WT + 2 * WT_L * 2 <= WS_END, "ws map");

__device__ __forceinline__ float silu_f(float x) { return x * __builtin_amdgcn_rcpf(1.f + __expf(-x)); }
__device__ __forceinline__ int row_w(int row) { int b = row / RPB, t = row - b * RPB; return t >= SEQ ? 2 : b; }

struct Params {
    const float *x, *c, *ctx, *cctx, *w_ada, *b_ada, *g_ffn1, *g_mix, *g_ffn2, *w_in, *g_qn, *g_kn, *sink, *w_four, *w_out, *w1g, *w1u, *w1d, *w2g, *w2u, *w2d, *g_final;
    float* out; unsigned char* ws;
};
typedef const __attribute__((address_space(4))) Params* KP;

namespace pg8 {
#define PG8_LAS __attribute__((address_space(3)))
typedef unsigned short bf16_t;
typedef short bf16x8 __attribute__((ext_vector_type(8)));
typedef float f32x4 __attribute__((ext_vector_type(4)));
typedef unsigned u32x4 __attribute__((ext_vector_type(4)));
constexpr int BM = 256, BK = 64, HALF = 128, HTB = HALF * BK * 2  , STAGE_BYTES = 8 * HTB, NXCD = 8, WGM = 8;

__host__ __device__ __forceinline__ int lds_byte(int r, int c) { const int st = (r >> 4) * 2 + (c >> 5), rr = r & 15, cc = c & 31, ob = rr * 64 + cc * 2; return st * 1024 + (ob ^ (((ob >> 9) & 1) << 5)); }
__host__ __device__ __forceinline__ void stage_rc(int b, int& R, int& C) { const int st = b / 1024, sb = b % 1024, swz = sb ^ (((sb >> 9) & 1) << 5); R = (st >> 1) * 16 + swz / 64; C = (st & 1) * 32 + (swz % 64) / 2; }
__host__ __device__ __forceinline__ int perm32(int rho) { const int n = rho >> 4, i = rho & 15; return 8 * (i >> 2) + 4 * n + (i & 3); }

struct Unit { int pm, pn; };
struct Gemm { const bf16_t* A; const bf16_t* Bt; int M, N, K; };

struct StaticOrder {
    int nM, nN, nwg, G, c;
    __host__ __device__ void init(int M, int N, int G_, int c_) { nM = M / BM; nN = N / BM; nwg = nM * nN; G = G_; c = c_; }
    __host__ __device__ bool next(int i, Unit& u) const {
        const long L = (long)i * G + c; if (L >= nwg) return false;
        int wgid = (int)L; { const int q = nwg / NXCD, r = nwg % NXCD, xcd = wgid % NXCD, off = wgid / NXCD; wgid = (xcd < r ? xcd * (q + 1) : r * (q + 1) + (xcd - r) * q) + off; }
        const int nig = WGM * nN, gid = wgid / nig, fm = gid * WGM, gsz = (nM - fm) < WGM ? (nM - fm) : WGM;
        u.pm = fm + ((wgid % nig) % gsz); u.pn = (wgid % nig) / gsz; return true;
    }
    __device__ __forceinline__ void a_ready(const Unit&) const {}
    __device__ __forceinline__ void done(const Unit&) const {}
};

__device__ __forceinline__ unsigned cvt_pk_bf16(float lo, float hi) { unsigned r; asm volatile("v_cvt_pk_bf16_f32 %0, %1, %2" : "=v"(r) : "v"(lo), "v"(hi)); return r; }
__device__ __forceinline__ int tile_w(int pm) { const int b = pm / 33, wi = pm - b * 33; return wi == 32 ? 2 : b; }
struct EpiSwiglu {
    static constexpr bool PERM = false, AFTER_DRAIN = false;
    bf16_t* O;
    __device__ __forceinline__ void operator()(const f32x4 (&acc)[2][2][4][2], const Unit& u, int wr, int wc, int fr, int fq) const {
        const int row0 = u.pm * BM + wr * 64 + fr, col = u.pn * 128 + wc * 32 + fq * 8;
#pragma unroll
        for (int ai = 0; ai < 2; ++ai)
#pragma unroll
            for (int m = 0; m < 4; ++m) {
                const f32x4 g0 = acc[ai][0][m][0], u0 = acc[ai][1][m][0], g1 = acc[ai][0][m][1], u1 = acc[ai][1][m][1];
                u32x4 w;
                w.x = cvt_pk_bf16(silu_f(g0[0]) * u0[0], silu_f(g0[1]) * u0[1]); w.y = cvt_pk_bf16(silu_f(g0[2]) * u0[2], silu_f(g0[3]) * u0[3]);
                w.z = cvt_pk_bf16(silu_f(g1[0]) * u1[0], silu_f(g1[1]) * u1[1]); w.w = cvt_pk_bf16(silu_f(g1[2]) * u1[2], silu_f(g1[3]) * u1[3]);
                *(u32x4*)(O + (size_t)(row0 + ai * HALF + m * 16) * DFF + col) = w;
            }
    }
};
struct EpiRes {
    static constexpr bool PERM = false, AFTER_DRAIN = false;
    float* H; const float* MODl; int gate_chunk; float coef;
    __device__ __forceinline__ void operator()(const f32x4 (&acc)[2][2][4][2], const Unit& u, int wr, int wc, int fr, int fq) const {
        const float* gate = MODl + tile_w(u.pm) * NMOD + gate_chunk * 1024;
        const int row0 = u.pm * BM + wr * 64 + fr;
#pragma unroll
        for (int bj = 0; bj < 2; ++bj)
#pragma unroll
            for (int n = 0; n < 2; ++n) {
                const int col = u.pn * BM + bj * HALF + wc * 32 + n * 16 + fq * 4;
                const f32x4 gv = *(const f32x4*)(gate + col) * coef;
#pragma unroll
                for (int ai = 0; ai < 2; ++ai)
#pragma unroll
                    for (int m = 0; m < 4; ++m) { f32x4* p = (f32x4*)(H + (size_t)(row0 + ai * HALF + m * 16) * DM + col); *p = *p + gv * acc[ai][bj][m][n]; }
            }
    }
};
struct EpiWin {
    static constexpr bool PERM = false, AFTER_DRAIN = false;
    const float* gqn; const float* gkn; const float* ROPE;
    bf16_t *QA, *QB, *KA, *KB, *VTA, *VTB; unsigned *VS, *VC;
    __device__ __forceinline__ void operator()(const f32x4 (&acc)[2][2][4][2], const Unit& u, int wr, int wc, int fr, int fq) const {
        const int unit = u.pn * 4 + wc;
        const int b = u.pm / 33, wi = u.pm - b * 33; const bool lat = wi < 32; const int t0 = wi * 256;
        if (unit < 20) {
            const bool isB = unit >= 10; const int ul = isB ? unit - 10 : unit;
            const bool isq = ul < 6, isk = ul >= 6 && ul < 8;
            f32x4 gg[2][2];
            if (isB && (isq || isk)) { const float* g = isq ? gqn : gkn;
#pragma unroll
                for (int bj = 0; bj < 2; ++bj)
#pragma unroll
                    for (int n = 0; n < 2; ++n) gg[bj][n] = *(const f32x4*)(g + 32 * bj + 16 * n + 4 * fq); }
#pragma unroll
            for (int ai = 0; ai < 2; ++ai)
#pragma unroll
                for (int m = 0; m < 4; ++m) {
                    const int t = t0 + ai * HALF + wr * 64 + m * 16 + fr; const size_t row = (size_t)b * RPB + t;
                    f32x4 v[2][2];
#pragma unroll
                    for (int bj = 0; bj < 2; ++bj)
#pragma unroll
                        for (int n = 0; n < 2; ++n) v[bj][n] = acc[ai][bj][m][n];
                    if (isB && (isq || isk)) {
                        float ss = 0.f;
#pragma unroll
                        for (int bj = 0; bj < 2; ++bj)
#pragma unroll
                            for (int n = 0; n < 2; ++n) ss += (v[bj][n][0] * v[bj][n][0] + v[bj][n][1] * v[bj][n][1]) + (v[bj][n][2] * v[bj][n][2] + v[bj][n][3] * v[bj][n][3]);
                        ss += __shfl_xor(ss, 16); ss += __shfl_xor(ss, 32);
                        const float r = rsqrtf(ss * (1.f / 64.f) + 1e-6f);
#pragma unroll
                        for (int bj = 0; bj < 2; ++bj)
#pragma unroll
                            for (int n = 0; n < 2; ++n) v[bj][n] = v[bj][n] * r * gg[bj][n];
                    }
                    if (lat && (isq || isk)) {
#pragma unroll
                        for (int bj = 0; bj < 2; ++bj) {
                            const int p = bj == 0 ? (t >> 6) : 128 + (t & 63);
                            const f32x4 cs0 = *(const f32x4*)(ROPE + (p * 16 + 4 * fq) * 2), cs1 = *(const f32x4*)(ROPE + (p * 16 + 4 * fq) * 2 + 4);
                            const f32x4 cv = {cs0[0], cs0[2], cs1[0], cs1[2]}, sv = {cs0[1], cs0[3], cs1[1], cs1[3]};
                            const f32x4 a = v[bj][0], bb = v[bj][1];
                            v[bj][0] = a * cv - bb * sv; v[bj][1] = bb * cv + a * sv;
                        }
                    }
                    if (isq || isk) {
                        const float sc = isq ? QSCALE : 1.f;
                        bf16_t* dst = isq ? ((isB ? QB : QA) + row * 384 + ul * 64) : ((isB ? KB : KA) + row * 128 + (ul - 6) * 64);
#pragma unroll
                        for (int bj = 0; bj < 2; ++bj)
#pragma unroll
                            for (int n = 0; n < 2; ++n) { const f32x4 x = v[bj][n] * sc; uint2 w; w.x = cvt_pk_bf16(x[0], x[1]); w.y = cvt_pk_bf16(x[2], x[3]);
                                *(uint2*)(dst + 32 * bj + 16 * n + 4 * fq) = w; }
                    } else {
                        bf16_t* dst = (isB ? VTB : VTA) + ((size_t)(b * 2 + (ul - 8)) * 64) * RPB + t;
#pragma unroll
                        for (int bj = 0; bj < 2; ++bj)
#pragma unroll
                            for (int n = 0; n < 2; ++n)
#pragma unroll
                                for (int i = 0; i < 4; ++i) dst[(size_t)(32 * bj + 16 * n + 4 * fq + i) * RPB] = f2bf(v[bj][n][i]);
                    }
                }
        } else {
            const int chb = ((unit - 20) >> 1) * 64 + 32 * ((unit - 20) & 1);
#pragma unroll
            for (int ai = 0; ai < 2; ++ai)
#pragma unroll
                for (int m = 0; m < 4; ++m) {
                    const int t = t0 + ai * HALF + wr * 64 + m * 16 + fr;
#pragma unroll
                    for (int bj = 0; bj < 2; ++bj)
#pragma unroll
                        for (int n = 0; n < 2; ++n) {
                            const f32x4 x = acc[ai][bj][m][n]; const int ch = chb + 16 * bj + 8 * n + 2 * fq;
                            const unsigned w0 = cvt_pk_bf16(x[0], x[1]), w1 = cvt_pk_bf16(x[2], x[3]);
                            if (lat) { const int l2 = t & 127, l1 = t >> 7; unsigned* d = VS + ((size_t)(b * 128 + l2) * 256 + ch) * 64 + l1; d[0] = w0; d[64] = w1; }
                            else { unsigned* d = VC + ((size_t)(b * 256 + (t - SEQ)) * 256 + ch); d[0] = w0; d[1] = w1; }
                        }
                }
        }
    }
};

struct EpiAll {
    static constexpr bool PERM = false, AFTER_DRAIN = false;
    unsigned char* ws; const float* gqn; const float* gkn; int mode, l, chunk; float coef;
    __device__ __forceinline__ void operator()(const f32x4 (&acc)[2][2][4][2], const Unit& u, int wr, int wc, int fr, int fq) const {
        if (mode == 0) { EpiSwiglu E{(bf16_t*)(ws + WS_MID)}; E(acc, u, wr, wc, fr, fq); }
        else if (mode == 1) { EpiRes E{(float*)(ws + WS_H), (const float*)(ws + WS_MOD) + (size_t)l * 3 * NMOD, chunk, coef}; E(acc, u, wr, wc, fr, fq); }
        else { EpiWin E{gqn, gkn, (const float*)(ws + WS_TAB) + TAB_ROPE, (bf16_t*)(ws + WS_QA), (bf16_t*)(ws + WS_QB), (bf16_t*)(ws + WS_KA), (bf16_t*)(ws + WS_KB),
                        (bf16_t*)(ws + WS_VTA), (bf16_t*)(ws + WS_VTB), (unsigned*)(ws + WS_VS), (unsigned*)(ws + WS_VC)}; E(acc, u, wr, wc, fr, fq); }
    }
};

template <class Epi, class Sched, bool ALIGN_EPI = false, bool SP2 = false>
__device__ __forceinline__ void gemm_phase(PG8_LAS unsigned char* lds, const Gemm g, const Sched& S, const Epi& E) {
    int tid_ = threadIdx.x; asm volatile("" : "+v"(tid_)); const int tid = tid_, wid = __builtin_amdgcn_readfirstlane(tid >> 6), lane = tid & 63, wr = wid >> 2, wc = wid & 3, fr = lane & 15, fq = lane >> 4;
    const int K = g.K, nt = K / BK;
    unsigned voffA[2], voffB[2];
#pragma unroll
    for (int i = 0; i < 2; ++i) { int R, C; stage_rc(tid * 16 + i * 8192, R, C); const int Rb = Epi::PERM ? ((R & ~31) + perm32(R & 31)) : R;
        voffA[i] = (unsigned)(R * K + C) * 2u; voffB[i] = (unsigned)(Rb * K + C) * 2u; }
    const size_t kstep = (size_t)(BK * 2);
    const size_t hstep = (size_t)HALF * K * 2;
    const size_t tstep = 2 * hstep;
    const unsigned ldsw = (unsigned)wid * 1024u;
    const int aoff = lds_byte(wr * 64 + fr, fq * 8), boff = lds_byte(wc * 32 + fr, fq * 8);
#define PG8_SA(b, h) (((b) * 2 + (h)) * HTB)
#define PG8_SB(b, h) ((4 + (b) * 2 + (h)) * HTB)
#define PG8_STAGE(bufoff, gbase, voff) do { _Pragma("unroll") for (int _i = 0; _i < 2; ++_i) \
        __builtin_amdgcn_global_load_lds((const unsigned*)((const char*)(gbase) + (voff)[_i]), (PG8_LAS unsigned*)(lds + (bufoff) + ldsw + _i * 8192), 16, 0, 0); } while (0)
#define PG8_LDA(dst, b, h) do { _Pragma("unroll") for (int m = 0; m < 4; ++m) _Pragma("unroll") for (int k = 0; k < 2; ++k) dst[m][k] = *(const PG8_LAS bf16x8*)(lds + PG8_SA(b, h) + aoff + m * 2048 + k * 1024); } while (0)
#define PG8_LDB(dst, b, h) do { _Pragma("unroll") for (int n = 0; n < 2; ++n) _Pragma("unroll") for (int k = 0; k < 2; ++k) dst[n][k] = *(const PG8_LAS bf16x8*)(lds + PG8_SB(b, h) + boff + n * 2048 + k * 1024); } while (0)
#define PG8_MMA(ai, bj, At, Bt) do { __builtin_amdgcn_s_setprio(1); _Pragma("unroll") for (int m = 0; m < 4; ++m) _Pragma("unroll") for (int n = 0; n < 2; ++n) _Pragma("unroll") for (int k = 0; k < 2; ++k) \
        acc[ai][bj][m][n] = __builtin_amdgcn_mfma_f32_16x16x32_bf16(Bt[n][k], At[m][k], acc[ai][bj][m][n], 0, 0, 0); __builtin_amdgcn_s_setprio(0); } while (0)
#define PG8_WAIT_V(n) asm volatile("s_waitcnt vmcnt(" #n ")" ::: "memory")
#define PG8_WAIT_L(n) asm volatile("s_waitcnt lgkmcnt(" #n ")" ::: "memory")
#define PG8_BAR __builtin_amdgcn_s_barrier()
#define PG8_SCHED __builtin_amdgcn_sched_barrier(0)
    Unit cur, nxt; int ui = 0;
    if (!S.next(0, cur)) return;
    f32x4 acc[2][2][4][2];
#pragma unroll
    for (int a = 0; a < 2; ++a)
#pragma unroll
        for (int b = 0; b < 2; ++b)
#pragma unroll
            for (int m = 0; m < 4; ++m)
#pragma unroll
                for (int n = 0; n < 2; ++n) acc[a][b][m][n] = (f32x4){0.f, 0.f, 0.f, 0.f};
    bf16x8 At[4][2], B0[2][2], B1[2][2];
    const char* cA = (const char*)g.A + (size_t)cur.pm * tstep; const char* cB = (const char*)g.Bt + (size_t)cur.pn * tstep;
    S.a_ready(cur);
    if constexpr (SP2) {
        PG8_STAGE(PG8_SB(0, 0), cB, voffB); PG8_STAGE(PG8_SB(0, 1), cB + hstep, voffB); PG8_STAGE(PG8_SA(0, 0), cA, voffA); PG8_STAGE(PG8_SA(0, 1), cA + hstep, voffA);
        if (wr == 1) PG8_BAR;
        PG8_WAIT_V(2); PG8_BAR;
        PG8_STAGE(PG8_SB(1, 0), cB + kstep, voffB); PG8_STAGE(PG8_SA(1, 0), cA + kstep, voffA); PG8_STAGE(PG8_SB(1, 1), cB + hstep + kstep, voffB);
        PG8_WAIT_V(6); PG8_BAR;
    } else {
        PG8_STAGE(PG8_SB(0, 0), cB, voffB); PG8_STAGE(PG8_SA(0, 0), cA, voffA); PG8_STAGE(PG8_SB(0, 1), cB + hstep, voffB); PG8_STAGE(PG8_SA(0, 1), cA + hstep, voffA);
        if (wr == 1) PG8_BAR;
        PG8_WAIT_V(4); PG8_BAR;
        PG8_STAGE(PG8_SB(1, 0), cB + kstep, voffB); PG8_STAGE(PG8_SA(1, 0), cA + kstep, voffA); PG8_STAGE(PG8_SB(1, 1), cB + hstep + kstep, voffB);
        PG8_WAIT_V(6); PG8_BAR;
    }
    for (;;) {
        const bool has_next = S.next(ui + 1, nxt);
        const char* nA = has_next ? (const char*)g.A + (size_t)nxt.pm * tstep : cA; const char* nB = has_next ? (const char*)g.Bt + (size_t)nxt.pn * tstep : cB;
        for (int t = 0; t < nt; t += 2) {
            const bool last = (t == nt - 2);
            const char* a1 = cA + (size_t)(t + 1) * kstep;
            const char* a2 = last ? nA : cA + (size_t)(t + 2) * kstep; const char* b2 = last ? nB : cB + (size_t)(t + 2) * kstep;
            const char* a3 = a2 + kstep; const char* b3 = b2 + kstep;
            if (last && has_next) S.a_ready(nxt);
            if constexpr (SP2) {
            PG8_LDB(B0, 0, 0); PG8_LDB(B1, 0, 1); PG8_SCHED; PG8_LDA(At, 0, 0); PG8_STAGE(PG8_SA(1, 1), a1 + hstep, voffA);
            PG8_WAIT_V(8); PG8_WAIT_L(0); PG8_BAR; PG8_MMA(0, 0, At, B0); PG8_MMA(0, 1, At, B1); PG8_BAR; PG8_SCHED;
            PG8_LDA(At, 0, 1); PG8_STAGE(PG8_SB(0, 0), b2, voffB); PG8_STAGE(PG8_SB(0, 1), b2 + hstep, voffB); PG8_STAGE(PG8_SA(0, 0), a2, voffA);
            PG8_WAIT_V(8); PG8_WAIT_L(0); PG8_BAR; PG8_MMA(1, 0, At, B0); PG8_MMA(1, 1, At, B1); PG8_BAR; PG8_SCHED;
            PG8_LDB(B0, 1, 0); PG8_LDB(B1, 1, 1); PG8_SCHED; PG8_LDA(At, 1, 0); PG8_STAGE(PG8_SA(0, 1), a2 + hstep, voffA);
            PG8_WAIT_V(8); PG8_WAIT_L(0); PG8_BAR; PG8_MMA(0, 0, At, B0); PG8_MMA(0, 1, At, B1); PG8_BAR; PG8_SCHED;
            PG8_LDA(At, 1, 1); PG8_STAGE(PG8_SB(1, 0), b3, voffB); PG8_STAGE(PG8_SB(1, 1), b3 + hstep, voffB); PG8_STAGE(PG8_SA(1, 0), a3, voffA);
            PG8_WAIT_V(8); PG8_WAIT_L(0); PG8_BAR; PG8_MMA(1, 0, At, B0); PG8_MMA(1, 1, At, B1); PG8_BAR; PG8_SCHED;
            } else {
            PG8_LDB(B0, 0, 0); PG8_SCHED; PG8_LDA(At, 0, 0); PG8_STAGE(PG8_SA(1, 1), a1 + hstep, voffA);
            PG8_WAIT_L(8); PG8_BAR; PG8_WAIT_L(0); PG8_MMA(0, 0, At, B0); PG8_BAR; PG8_SCHED;
            PG8_LDB(B1, 0, 1); PG8_STAGE(PG8_SB(0, 0), b2, voffB);
            PG8_BAR; PG8_WAIT_L(0); PG8_MMA(0, 1, At, B1); PG8_BAR;
            PG8_LDA(At, 0, 1); PG8_STAGE(PG8_SA(0, 0), a2, voffA);
            PG8_BAR; PG8_WAIT_L(0); PG8_MMA(1, 0, At, B0); PG8_BAR; PG8_SCHED;
            PG8_STAGE(PG8_SB(0, 1), b2 + hstep, voffB);
            PG8_WAIT_V(6); PG8_BAR; PG8_MMA(1, 1, At, B1); PG8_BAR;
            PG8_LDB(B0, 1, 0); PG8_SCHED; PG8_LDA(At, 1, 0); PG8_STAGE(PG8_SA(0, 1), a2 + hstep, voffA);
            PG8_WAIT_L(8); PG8_BAR; PG8_WAIT_L(0); PG8_MMA(0, 0, At, B0); PG8_BAR; PG8_SCHED;
            PG8_LDB(B1, 1, 1); PG8_STAGE(PG8_SB(1, 0), b3, voffB);
            PG8_BAR; PG8_WAIT_L(0); PG8_MMA(0, 1, At, B1); PG8_BAR;
            PG8_LDA(At, 1, 1); PG8_STAGE(PG8_SA(1, 0), a3, voffA);
            PG8_BAR; PG8_WAIT_L(0); PG8_MMA(1, 0, At, B0); PG8_BAR; PG8_SCHED;
            PG8_STAGE(PG8_SB(1, 1), b3 + hstep, voffB);
            PG8_WAIT_V(6); PG8_BAR; PG8_MMA(1, 1, At, B1); PG8_BAR;
            }
        }
        if constexpr (ALIGN_EPI) { if (wr == 0) PG8_BAR; }
        if constexpr (!Epi::AFTER_DRAIN) { E(acc, cur, wr, wc, fr, fq); S.done(cur); }
        if (!has_next) break;
#pragma unroll
        for (int a = 0; a < 2; ++a)
#pragma unroll
            for (int b = 0; b < 2; ++b)
#pragma unroll
                for (int m = 0; m < 4; ++m)
#pragma unroll
                    for (int n = 0; n < 2; ++n) acc[a][b][m][n] = (f32x4){0.f, 0.f, 0.f, 0.f};
        cur = nxt; cA = nA; cB = nB; ++ui;
        if constexpr (ALIGN_EPI) { if (wr == 1) PG8_BAR; }
    }
    PG8_WAIT_V(0);
    if constexpr (!ALIGN_EPI) { if (wr == 0) PG8_BAR; }
    PG8_BAR;
    if constexpr (Epi::AFTER_DRAIN) { E.fused(acc, cur, wr, wc, fr, fq, lds, wid, lane); S.done(cur); }
#undef PG8_SA
#undef PG8_SB
#undef PG8_STAGE
#undef PG8_LDA
#undef PG8_LDB
#undef PG8_MMA
#undef PG8_WAIT_V
#undef PG8_WAIT_L
#undef PG8_BAR
#undef PG8_SCHED
}
}
#define FAST_ATTN 1
#define FAST_FFT 1
#define LAS __attribute__((address_space(3)))
__device__ __forceinline__ float wave_sum(float v) {
#pragma unroll
    for (int o = 1; o < 64; o <<= 1) v += __shfl_xor(v, o);
    return v;
}
__device__ __forceinline__ void tr_write(const LAS float* scr, bf16_t* Bt, int ldk, int k0, int P0, int P1, int P2, int P3, int lane) {
    const int c = lane & 7, nl = lane >> 3;
#pragma unroll
    for (int j = 0; j < 4; ++j) { const int n = nl + 8 * j; const LAS float* s = scr + (8 * c) * 33 + n; const int P = j == 0 ? P0 : j == 1 ? P1 : j == 2 ? P2 : P3;
        uint4 o; o.x = pk2(s[0], s[33]); o.y = pk2(s[2 * 33], s[3 * 33]); o.z = pk2(s[4 * 33], s[5 * 33]); o.w = pk2(s[6 * 33], s[7 * 33]);
        *(uint4*)(Bt + (size_t)P * ldk + k0 + 8 * c) = o; }
    asm volatile("s_waitcnt lgkmcnt(0)" ::: "memory");
}
__device__ __forceinline__ void tr_load(LAS float* scr, const float* W, int ldw, int k0, int col0, int lane) {
#pragma unroll 8
    for (int i = 0; i < 32; ++i) { const int kk = 2 * i + (lane >> 5); scr[kk * 33 + (lane & 31)] = W[(size_t)(k0 + kk) * ldw + col0 + (lane & 31)]; }
    asm volatile("s_waitcnt lgkmcnt(0)" ::: "memory");
}
__device__ __forceinline__ int perm_gu(int j, int t) { const int jj = j & 127; return 256 * (j >> 7) + 128 * t + 32 * (jj >> 5) + 16 * ((jj & 7) >> 2) + 4 * ((jj & 31) >> 3) + (jj & 3); }
__device__ __forceinline__ int perm_in(int u, int d) { return 256 * (u >> 2) + 32 * (u & 3) + 128 * (d >> 5) + (d & 31); }

__device__ __forceinline__ void prologue_phase(KP P, LAS unsigned char* lds) {
    int tid_ = threadIdx.x, bid_ = blockIdx.x; asm volatile("" : "+v"(tid_)); asm volatile("" : "+s"(bid_));
    const int tid = tid_, lane = tid & 63, wave = tid >> 6, bid = bid_;
    float* MOD = (float*)(P->ws + WS_MOD); float* TAB = (float*)(P->ws + WS_TAB);
    {
        const int i = bid * 512 + tid;
        if (i < 8192) TAB[TAB_COS + i] = cospif((float)i / 4096.f);
        else if (i < 8192 + 3072) { const int e = i - 8192, p = e / 16, k = e % 16; const float inv = powf(10000.f, -(float)(2 * k) / 32.f);
            const float ang = (float)(p < 128 ? p : p - 128) * inv; TAB[TAB_ROPE + e * 2] = cosf(ang); TAB[TAB_ROPE + e * 2 + 1] = sinf(ang); }
        else if (i < 8192 + 3072 + 16384) { const int e = i - 8192 - 3072, mrow = e >> 7, kcol = e & 127; const int k1 = mrow >> 1, ro = mrow & 1, l1 = kcol >> 1, ri = kcol & 1;
            const int j = (k1 * l1) & 63; const float cv = cospif((float)j / 32.f), sv = sinpif((float)j / 32.f);
            const float v = (ro == ri) ? cv : (ro == 0 ? sv : -sv);
            ((bf16_t*)(P->ws + WS_TAB + TAB_D1_BYTES))[e] = f2bf(v); }
        else if (i < 8192 + 3072 + 16384 + 32768) { const int e = i - 8192 - 3072 - 16384, k2 = e >> 8, kcol = e & 255, l2 = kcol >> 1, ri = kcol & 1;
            const int j = (k2 * l2) & 127; const float v = ri == 0 ? cospif((float)j / 64.f) : sinpif((float)j / 64.f);
            ((bf16_t*)(P->ws + WS_TAB + TAB_D3_BYTES))[e] = f2bf(v); }
    }
    {
        LAS float* sv = (LAS float*)lds;
        LAS float* red = (LAS float*)(lds + 12288);
        if (bid < 288) {
            for (int i = tid; i < 1024; i += 512) { sv[i] = silu_f(P->c[i]); sv[1024 + i] = silu_f(P->c[1024 + i]); sv[2048 + i] = silu_f(P->cctx[i]); }
            __syncthreads();
            for (int it = bid; it < 288; it += gridDim.x) {
                const int l = it / 144, n0 = (it % 144) * 64;
                const float* W = P->w_ada + (size_t)l * 1024 * NMOD + n0 + lane;
                float a0 = 0.f, a1 = 0.f, a2 = 0.f;
#pragma unroll 16
                for (int k = wave * 128; k < wave * 128 + 128; ++k) { const float w = W[(size_t)k * NMOD]; a0 += sv[k] * w; a1 += sv[1024 + k] * w; a2 += sv[2048 + k] * w; }
                red[(wave * 3 + 0) * 64 + lane] = a0; red[(wave * 3 + 1) * 64 + lane] = a1; red[(wave * 3 + 2) * 64 + lane] = a2;
                __syncthreads();
                if (tid < 192) { const int w = tid >> 6; float s = P->b_ada[l * NMOD + n0 + lane];
#pragma unroll
                    for (int q = 0; q < 8; ++q) s += red[(q * 3 + w) * 64 + lane];
                    MOD[(size_t)(l * 3 + w) * NMOD + n0 + lane] = s; }
                __syncthreads();
            }
        }
        __syncthreads();
    }
    {
        LAS float* scr = (LAS float*)(lds + wave * 8448);
        const int gw = bid * 8 + wave, NGW = gridDim.x * 8;
        constexpr int NA = 4 * 1408, NBd = 2 * 1408, NC = 640, ND = 256, NE = 384, NF = 128, NL = NA + NBd + NC + ND + NE + NF;
        for (int it = gw; it < 2 * NL; it += NGW) {
            const int l = it / NL; int r = it - l * NL;
            bf16_t* WT = (bf16_t*)(P->ws + WS_WT) + (size_t)l * WT_L;
            const int nl = lane >> 3;
            if (r < NA) { const int f = r / 2816, t = (r / 1408) & 1, q = r % 1408, kb = q / 88, nb = q % 88;
                const float* W = (f == 0 ? (t == 0 ? P->w1g : P->w1u) : (t == 0 ? P->w2g : P->w2u)) + (size_t)l * 1024 * DFF;
                tr_load(scr, W, DFF, kb * 64, nb * 32, lane);
                const int j = nb * 32 + nl;
                tr_write(scr, WT + WT_GU + (size_t)f * 5632 * 1024, 1024, kb * 64, perm_gu(j, t), perm_gu(j + 8, t), perm_gu(j + 16, t), perm_gu(j + 24, t), lane);
                continue; }
            r -= NA;
            if (r < NBd) { const int f = r / 1408, q = r % 1408, kb = q / 32, nb = q % 32;
                const float* W = (f == 0 ? P->w1d : P->w2d) + (size_t)l * DFF * 1024;
                tr_load(scr, W, 1024, kb * 64, nb * 32, lane);
                const int j = nb * 32 + nl;
                tr_write(scr, WT + WT_DN + (size_t)f * 1024 * DFF, DFF, kb * 64, j, j + 8, j + 16, j + 24, lane);
                continue; }
            r -= NBd;
            if (r < NC) { const int kb = r / 40, nb = r % 40;
                tr_load(scr, P->w_in + (size_t)l * 1024 * DIN, DIN, kb * 64, nb * 32, lane);
                const int u = nb >> 1, d = (nb & 1) * 32 + nl;
                tr_write(scr, WT + WT_IN, 1024, kb * 64, perm_in(u, d), perm_in(u, d + 8), perm_in(u, d + 16), perm_in(u, d + 24), lane);
                continue; }
            r -= NC;
            if (r < ND) {
                const int kb = r / 16, ob = r % 16;
                const int u = 20 + (ob >> 1), g = (u - 20) >> 1, half = (u - 20) & 1, q = (ob & 1) * 32 + (lane & 31);
                const int dch = 32 * half + (q >> 1), ri = q & 1;
                const float* W = P->w_in + (size_t)l * 1024 * DIN + 1280 + g * 64;
                for (int i = 0; i < 32; ++i) { const int kk = 2 * i + (lane >> 5); const float* wr_ = W + (size_t)(kb * 64 + kk) * DIN; float a = 0.f;
                    for (int cc = 0; cc < 64; ++cc) { const int j = (cc * dch) & 63; const float tw = ri == 0 ? TAB[TAB_COS + j * 128] : -TAB[TAB_COS + (((j - 16) & 63) * 128)]; a += wr_[cc] * tw; }
                    scr[kk * 33 + (lane & 31)] = a; }
                asm volatile("s_waitcnt lgkmcnt(0)" ::: "memory");
                const int d = (ob & 1) * 32 + nl;
                tr_write(scr, WT + WT_IN, 1024, kb * 64, perm_in(u, d), perm_in(u, d + 8), perm_in(u, d + 16), perm_in(u, d + 24), lane);
                continue; }
            r -= ND;
            if (r < NE) { const int kb = r / 32, nb = r % 32;
                tr_load(scr, P->w_out + (size_t)l * 1024 * 1024, 1024, kb * 64, nb * 32, lane);
                const int j = nb * 32 + nl;
                tr_write(scr, WT + WT_OUT, 1024, kb * 64, j, j + 8, j + 16, j + 24, lane);
                continue; }
            r -= NE;
            {
                const int g = r / 32, nb = r % 32;
                const float* wo = P->w_out + (size_t)l * 1024 * 1024 + (size_t)(768 + g * 64) * 1024 + nb * 32 + (lane & 31);
                const float* wf = P->w_four + (size_t)(l * 4 + g) * 4096;
                for (int i = 0; i < 32; ++i) { const int kk = 2 * i + (lane >> 5); float a = 0.f;
                    for (int d = 0; d < 64; ++d) a += wf[kk * 64 + d] * wo[(size_t)d * 1024];
                    scr[kk * 33 + (lane & 31)] = a; }
                asm volatile("s_waitcnt lgkmcnt(0)" ::: "memory");
                const int j = nb * 32 + nl;
                tr_write(scr, WT + WT_OUT, 1024, 768 + g * 64, j, j + 8, j + 16, j + 24, lane);
            }
        }
    }
}
__device__ __forceinline__ void norm_phase(KP P, const float* g, const float* MODl, int shc, int scc, bool from_input) {
    int tid_ = threadIdx.x, bid_ = blockIdx.x; asm volatile("" : "+v"(tid_)); asm volatile("" : "+s"(bid_));
    const int lane = tid_ & 63, gw = bid_ * 8 + (tid_ >> 6), NGW = gridDim.x * 8;
    float* H = (float*)(P->ws + WS_H); bf16_t* XN = (bf16_t*)(P->ws + WS_XN);
    for (int row = gw; row < M; row += NGW) {
        const int b = row / RPB, t = row - b * RPB, w = t >= SEQ ? 2 : b;
        const float4* h = from_input ? (t < SEQ ? (const float4*)(P->x + ((size_t)b * SEQ + t) * DM) : (const float4*)(P->ctx + ((size_t)b * CTXL + (t - SEQ)) * DM)) : (const float4*)(H + (size_t)row * DM);
        float4 v[4]; float ss = 0.f;
#pragma unroll
        for (int j = 0; j < 4; ++j) { v[j] = h[lane + 64 * j]; ss += v[j].x * v[j].x + v[j].y * v[j].y + v[j].z * v[j].z + v[j].w * v[j].w; }
        if (from_input) {
#pragma unroll
            for (int j = 0; j < 4; ++j) ((float4*)(H + (size_t)row * DM))[lane + 64 * j] = v[j]; }
        const float r = rsqrtf(wave_sum(ss) * (1.f / DM) + 1e-6f);
        const float* sh = MODl + w * NMOD + shc * 1024; const float* sc = MODl + w * NMOD + scc * 1024;
#pragma unroll
        for (int j = 0; j < 4; ++j) { const int c = (lane + 64 * j) * 4; const float4 gg = *(const float4*)(g + c), s4 = *(const float4*)(sh + c), c4 = *(const float4*)(sc + c);
            uint2 o; o.x = pk2(v[j].x * r * gg.x * (1.f + c4.x) + s4.x, v[j].y * r * gg.y * (1.f + c4.y) + s4.y);
            o.y = pk2(v[j].z * r * gg.z * (1.f + c4.z) + s4.z, v[j].w * r * gg.w * (1.f + c4.w) + s4.w);
            *(uint2*)(XN + (size_t)row * DM + c) = o; }
    }
}
__device__ __forceinline__ void final_phase(KP P) {
    int tid_ = threadIdx.x, bid_ = blockIdx.x; asm volatile("" : "+v"(tid_)); asm volatile("" : "+s"(bid_));
    const int lane = tid_ & 63, gw = bid_ * 8 + (tid_ >> 6), NGW = gridDim.x * 8;
    const float* H = (const float*)(P->ws + WS_H);
    for (int orow = gw; orow < NB * SEQ; orow += NGW) {
        const int b = orow / SEQ, t = orow - b * SEQ;
        const float4* h = (const float4*)(H + (size_t)(b * RPB + t) * DM);
        float4 v[4]; float ss = 0.f;
#pragma unroll
        for (int j = 0; j < 4; ++j) { v[j] = h[lane + 64 * j]; ss += v[j].x * v[j].x + v[j].y * v[j].y + v[j].z * v[j].z + v[j].w * v[j].w; }
        const float r = rsqrtf(wave_sum(ss) * (1.f / DM) + 1e-6f);
#pragma unroll
        for (int j = 0; j < 4; ++j) { const int c = (lane + 64 * j) * 4; const float4 gg = *(const float4*)(P->g_final + c);
            float4 o; o.x = v[j].x * r * gg.x; o.y = v[j].y * r * gg.y; o.z = v[j].z * r * gg.z; o.w = v[j].w * r * gg.w;
            *(float4*)(P->out + (size_t)orow * DM + c) = o; }
    }
}
template <class Epi> __device__ __forceinline__ void run_gemm(LAS unsigned char* lds, const bf16_t* A, const bf16_t* Bt, int N, int K, const Epi& E) {
    pg8::Gemm g{A, Bt, M, N, K}; pg8::StaticOrder S; S.init(M, N, (int)gridDim.x, (int)blockIdx.x);
    pg8::gemm_phase<Epi, pg8::StaticOrder, true, true>(lds, g, S, E);
}

typedef float f32x16 __attribute__((ext_vector_type(16)));
typedef short bf16x8_t __attribute__((ext_vector_type(8)));
typedef short s16x4_t __attribute__((ext_vector_type(4)));
typedef unsigned u32x4_t __attribute__((ext_vector_type(4)));
typedef unsigned u32x2_t __attribute__((ext_vector_type(2)));
constexpr int AT_KBUF = 0, AT_VBUF = 32768, AT_VSTRIDE = 264, AT_VBYTES = 64 * AT_VSTRIDE, AT_COMB = AT_VBUF + 2 * AT_VBYTES, AT_COMB_PAIR = 34 * 64 * 4;
static_assert(AT_COMB + 4 * AT_COMB_PAIR <= 131072, "attention LDS map");
__device__ __forceinline__ unsigned cvtpk(float lo, float hi) { unsigned r; asm volatile("v_cvt_pk_bf16_f32 %0, %1, %2" : "=v"(r) : "v"(lo), "v"(hi)); return r; }

__device__ __forceinline__ void attn_unit(KP P, LAS unsigned char* lds, int l, int tid, int b, int hh, int q0, bool lat) {
    unsigned char* ws = P->ws;
    const int lane = tid & 63, r32 = lane & 31, hi = lane >> 5, wid = __builtin_amdgcn_readfirstlane(tid >> 6), g = wid >> 2, wq = wid & 3;
    const bool isB = hh >= 6; const int h = isB ? hh - 6 : hh, kvh = h / 3;
    const bf16_t* Q = (const bf16_t*)(ws + (isB ? WS_QB : WS_QA)) + ((size_t)b * RPB + q0 + 32 * wq + r32) * 384 + h * 64;
    const bf16_t* Kg = (const bf16_t*)(ws + (isB ? WS_KB : WS_KA)) + (size_t)b * RPB * 128 + kvh * 64;
    const bf16_t* Vg = (const bf16_t*)(ws + (isB ? WS_VTB : WS_VTA)) + ((size_t)(b * 2 + kvh) * 64) * RPB;
    int npre, kb_lo, nsteps;
    if (!lat) { npre = 2; kb_lo = 0; nsteps = 2; }
    else if (isB) { npre = 0; kb_lo = 0; nsteps = 66; }
    else { const int qb = q0 >> 7; kb_lo = qb > 0 ? qb - 1 : 0; const int kb_hi = qb < 63 ? qb + 1 : 63; npre = 2; nsteps = 2 + (kb_hi - kb_lo + 1); }
    const int kkey0 = tid >> 3, kc = tid & 7;
    const unsigned kdst0 = (unsigned)(kkey0 * 128 + ((kc ^ ((kkey0 >> 1) & 7)) * 16));
    const int vd0 = tid >> 4, vc = tid & 15;
    const unsigned vdst0 = (unsigned)(vd0 * AT_VSTRIDE + vc * 16);
    const bf16_t* kg0 = Kg + (size_t)kkey0 * 128 + kc * 8;
    const bf16_t* vg0 = Vg + (size_t)vd0 * RPB + vc * 8;
    u32x4_t pk0, pk1, pv0, pv1;
#define AT_KP0(s) ((s) < npre ? SEQ + 128 * (s) : 128 * (kb_lo + (s) - npre))
#define AT_LOAD(s) do { const int kp0_ = AT_KP0(s); pk0 = *(const u32x4_t*)(kg0 + (size_t)kp0_ * 128); pk1 = *(const u32x4_t*)(kg0 + (size_t)(kp0_ + 64) * 128); \
        pv0 = *(const u32x4_t*)(vg0 + kp0_); pv1 = *(const u32x4_t*)(vg0 + (size_t)32 * RPB + kp0_); } while (0)
#define AT_STORE(buf) do { LAS unsigned char* kb_ = lds + AT_KBUF + (buf) * 16384; LAS unsigned char* vb_ = lds + AT_VBUF + (buf) * AT_VBYTES; \
        *(LAS u32x4_t*)(kb_ + kdst0) = pk0; *(LAS u32x4_t*)(kb_ + kdst0 + 8192) = pk1; \
        *(LAS u32x2_t*)(vb_ + vdst0) = (u32x2_t){pv0.x, pv0.y}; *(LAS u32x2_t*)(vb_ + vdst0 + 8) = (u32x2_t){pv0.z, pv0.w}; \
        *(LAS u32x2_t*)(vb_ + vdst0 + 32 * AT_VSTRIDE) = (u32x2_t){pv1.x, pv1.y}; *(LAS u32x2_t*)(vb_ + vdst0 + 32 * AT_VSTRIDE + 8) = (u32x2_t){pv1.z, pv1.w}; } while (0)
    AT_LOAD(0);
    bf16x8_t qf[4];
#pragma unroll
    for (int d0 = 0; d0 < 4; ++d0) qf[d0] = *(const bf16x8_t*)(Q + 16 * d0 + 8 * hi);
    const int key0 = 64 * g + r32; const int swz = (key0 >> 1) & 7;
    unsigned koff[4];
#pragma unroll
    for (int d0 = 0; d0 < 4; ++d0) koff[d0] = (unsigned)(key0 * 128 + (((2 * d0 + hi) ^ swz) * 16));
    const unsigned voff = (unsigned)(r32 * AT_VSTRIDE + 128 * g + 8 * hi);
    f32x16 O0 = {}, O1 = {};
    float m = -1e30f, lsum = 0.f;
    const int qp = q0 + 32 * wq + r32;
    AT_STORE(0);
    __syncthreads();
    for (int s = 0; s < nsteps; ++s) {
        if (s + 1 < nsteps) AT_LOAD(s + 1);
        const LAS unsigned char* kb = lds + AT_KBUF + (s & 1) * 16384; const LAS unsigned char* vb = lds + AT_VBUF + (s & 1) * AT_VBYTES;
        f32x16 S0 = {}, S1 = {};
#pragma unroll
        for (int d0 = 0; d0 < 4; ++d0) {
            const bf16x8_t a0 = *(const LAS bf16x8_t*)(kb + koff[d0]); const bf16x8_t a1 = *(const LAS bf16x8_t*)(kb + koff[d0] + 4096);
            S0 = __builtin_amdgcn_mfma_f32_32x32x16_bf16(a0, qf[d0], S0, 0, 0, 0);
            S1 = __builtin_amdgcn_mfma_f32_32x32x16_bf16(a1, qf[d0], S1, 0, 0, 0);
        }
        if (lat && !isB && s >= npre) {
            const int kpb = AT_KP0(s) + 64 * g + 4 * hi - qp;
#pragma unroll
            for (int r = 0; r < 16; ++r) { const int dlt = kpb + (r & 3) + 8 * (r >> 2);
                if (dlt > 128 || dlt < -128) S0[r] = -1e30f;
                if (dlt + 32 > 128 || dlt + 32 < -128) S1[r] = -1e30f; }
        }
        float rm = fmaxf(S0[0], S1[0]);
#pragma unroll
        for (int r = 1; r < 16; ++r) rm = fmaxf(rm, fmaxf(S0[r], S1[r]));
        rm = fmaxf(rm, __shfl_xor(rm, 32));
        const float mn = fmaxf(m, rm), alpha = __builtin_amdgcn_exp2f(m - mn); m = mn;
        float ps = 0.f;
#pragma unroll
        for (int r = 0; r < 16; ++r) { S0[r] = __builtin_amdgcn_exp2f(S0[r] - mn); S1[r] = __builtin_amdgcn_exp2f(S1[r] - mn); ps += S0[r] + S1[r]; }
        lsum = lsum * alpha + ps;
        if (__any(alpha != 1.f)) {
#pragma unroll
            for (int r = 0; r < 16; ++r) { O0[r] *= alpha; O1[r] *= alpha; } }
#pragma unroll
        for (int sl = 0; sl < 4; ++sl) {
            bf16x8_t pf;
            { const int rb = 8 * (sl & 1); unsigned w0, w1, w2, w3;
              if (sl < 2) { w0 = cvtpk(S0[rb], S0[rb + 1]); w1 = cvtpk(S0[rb + 2], S0[rb + 3]); w2 = cvtpk(S0[rb + 4], S0[rb + 5]); w3 = cvtpk(S0[rb + 6], S0[rb + 7]); }
              else { w0 = cvtpk(S1[rb], S1[rb + 1]); w1 = cvtpk(S1[rb + 2], S1[rb + 3]); w2 = cvtpk(S1[rb + 4], S1[rb + 5]); w3 = cvtpk(S1[rb + 6], S1[rb + 7]); }
              const u32x4_t w = {w0, w1, w2, w3}; pf = __builtin_bit_cast(bf16x8_t, w); }
#pragma unroll
            for (int dd = 0; dd < 2; ++dd) {
                const u32x2_t lo = *(const LAS u32x2_t*)(vb + voff + dd * 32 * AT_VSTRIDE + 32 * sl), hi8 = *(const LAS u32x2_t*)(vb + voff + dd * 32 * AT_VSTRIDE + 32 * sl + 16);
                const u32x4_t vw = {lo.x, lo.y, hi8.x, hi8.y}; const bf16x8_t vf = __builtin_bit_cast(bf16x8_t, vw);
                if (dd == 0) O0 = __builtin_amdgcn_mfma_f32_32x32x16_bf16(vf, pf, O0, 0, 0, 0); else O1 = __builtin_amdgcn_mfma_f32_32x32x16_bf16(vf, pf, O1, 0, 0, 0);
            }
        }
        if (s + 1 < nsteps) AT_STORE((s + 1) & 1);
        __syncthreads();
    }
    float ltot = lsum + __shfl_xor(lsum, 32);
    LAS float* comb = (LAS float*)(lds + AT_COMB + wq * AT_COMB_PAIR);
    if (g == 1) {
        comb[lane] = m; comb[64 + lane] = ltot;
#pragma unroll
        for (int r = 0; r < 16; ++r) { comb[(2 + r) * 64 + lane] = O0[r]; comb[(18 + r) * 64 + lane] = O1[r]; }
    }
    __syncthreads();
    if (g == 0) {
        const float m1 = comb[lane], l1 = comb[64 + lane];
        float mf = fmaxf(m, m1); float sk = 0.f;
        if (!isB) { const float s2 = P->sink[l * 6 + h] * LOG2E; mf = fmaxf(mf, s2); sk = __builtin_amdgcn_exp2f(s2 - mf); }
        const float a0 = __builtin_amdgcn_exp2f(m - mf), a1 = __builtin_amdgcn_exp2f(m1 - mf);
        const float inv = 1.f / (ltot * a0 + l1 * a1 + sk);
        const float c0 = a0 * inv, c1 = a1 * inv;
        bf16_t* dst = (bf16_t*)(ws + WS_XN) + ((size_t)b * RPB + q0 + 32 * wq + r32) * DM + (isB ? 384 : 0) + h * 64 + 4 * hi;
#pragma unroll
        for (int rq = 0; rq < 4; ++rq) {
            float o[8];
#pragma unroll
            for (int i = 0; i < 4; ++i) { o[i] = O0[4 * rq + i] * c0 + comb[(2 + 4 * rq + i) * 64 + lane] * c1; o[4 + i] = O1[4 * rq + i] * c0 + comb[(18 + 4 * rq + i) * 64 + lane] * c1; }
            *(u32x2_t*)(dst + 8 * rq) = (u32x2_t){cvtpk(o[0], o[1]), cvtpk(o[2], o[3])};
            *(u32x2_t*)(dst + 32 + 8 * rq) = (u32x2_t){cvtpk(o[4], o[5]), cvtpk(o[6], o[7])};
        }
    }
    __syncthreads();
#undef AT_KP0
#undef AT_LOAD
#undef AT_STORE
}
__device__ __forceinline__ void attn_phase(KP P, LAS unsigned char* lds, int l) {
    int tid_ = threadIdx.x, bid_ = blockIdx.x; asm volatile("" : "+v"(tid_)); asm volatile("" : "+s"(bid_));
    const int G = gridDim.x; const int NU = 1536 + (l == 0 ? 48 : 0);
    for (int idx = bid_; idx < NU; idx += G) {
        int b, hh, q0; bool lat = true;
        if (idx < 768) { b = idx / 384; hh = 6 + (idx % 384) / 64; q0 = (idx & 63) * 128; }
        else if (idx < 1536) { const int u = idx - 768; b = u / 384; hh = (u % 384) / 64; q0 = (u & 63) * 128; }
        else { const int u = idx - 1536; b = u / 24; hh = (u % 24) >> 1; q0 = SEQ + 128 * (u & 1); lat = false; }
        attn_unit(P, lds, l, tid_, b, hh, q0, lat);
    }
}

__device__ __forceinline__ void fft1_phase(KP P, int l) {
    int tid_ = threadIdx.x, bid_ = blockIdx.x; asm volatile("" : "+v"(tid_)); asm volatile("" : "+s"(bid_));
    unsigned char* ws = P->ws;
    const int lane = tid_ & 63, r32 = lane & 31, hi = lane >> 5, w = tid_ >> 6;
    const bf16_t* D1 = (const bf16_t*)(ws + WS_TAB + TAB_D1_BYTES); const float* TAB = (const float*)(ws + WS_TAB);
    for (int it = bid_; it < 256; it += gridDim.x) {
        const int b = it >> 7, l2 = it & 127, ch = 32 * w + r32;
        const bf16_t* vsrc = (const bf16_t*)(ws + WS_VS) + ((size_t)(b * 128 + l2) * 256 + ch) * 128 + 8 * hi;
        f32x16 acc[4] = {};
#pragma unroll
        for (int s = 0; s < 8; ++s) {
            const bf16x8_t bf = *(const bf16x8_t*)(vsrc + 16 * s);
#pragma unroll
            for (int mt = 0; mt < 4; ++mt) { const bf16x8_t af = *(const bf16x8_t*)(D1 + (32 * mt + r32) * 128 + 16 * s + 8 * hi);
                acc[mt] = __builtin_amdgcn_mfma_f32_32x32x16_bf16(af, bf, acc[mt], 0, 0, 0); }
        }
        unsigned* zs = (unsigned*)(ws + WS_ZS);
#pragma unroll
        for (int mt = 0; mt < 4; ++mt)
#pragma unroll
            for (int rq = 0; rq < 4; ++rq)
#pragma unroll
                for (int e = 0; e < 2; ++e) {
                    const int k1 = 16 * mt + 4 * rq + 2 * hi + e; const int idx = k1 * l2;
                    const float ct = TAB[TAB_COS + idx], st = TAB[TAB_COS + ((idx - 2048) & 8191)];
                    const float yr = acc[mt][4 * rq + 2 * e], yi = acc[mt][4 * rq + 2 * e + 1];
                    zs[((size_t)(b * 64 + k1) * 256 + ch) * 128 + l2] = cvtpk(yr * ct + yi * st, yi * ct - yr * st);
                }
    }
    if (l == 0) {
        const unsigned* VC = (const unsigned*)(ws + WS_VC); bf16_t* OM = (bf16_t*)(ws + WS_XN);
        for (int gt = bid_ * 512 + tid_; gt < NB * CTXL * 256; gt += gridDim.x * 512) {
            const int ch = gt & 255, k = (gt >> 8) & 255, b = gt >> 16;
            const unsigned* vp = VC + (size_t)(b * 256) * 256 + ch; float a = 0.f;
#pragma unroll 8
            for (int j = 0; j < 256; ++j) { const unsigned pk = vp[(size_t)j * 256]; const float vr = __uint_as_float(pk << 16), vi = __uint_as_float(pk & 0xffff0000u);
                const int ix = ((k * j) & 255) * 32; a += vr * TAB[TAB_COS + ix] + vi * TAB[TAB_COS + ((ix - 2048) & 8191)]; }
            OM[(size_t)(b * RPB + SEQ + k) * DM + 768 + ch] = f2bf(a * (1.f / 128.f));
        }
    }
}
__device__ __forceinline__ void fft3_phase(KP P, LAS unsigned char* lds, int l) {
    int tid_ = threadIdx.x, bid_ = blockIdx.x; asm volatile("" : "+v"(tid_)); asm volatile("" : "+s"(bid_));
    unsigned char* ws = P->ws;
    const int lane = tid_ & 63, r32 = lane & 31, hi = lane >> 5, w = tid_ >> 6;
    const bf16_t* D3 = (const bf16_t*)(ws + WS_TAB + TAB_D3_BYTES); bf16_t* OM = (bf16_t*)(ws + WS_XN);
    for (int it = bid_; it < 256; it += gridDim.x) {
        const int b = it >> 7, k1 = (it & 127) >> 1, chh = it & 1, ch = 32 * (4 * chh + (w & 3)) + r32, mh = w >> 2;
        const bf16_t* zsrc = (const bf16_t*)(ws + WS_ZS) + ((size_t)(b * 64 + k1) * 256 + ch) * 256 + 8 * hi;
        f32x16 acc[2] = {};
#pragma unroll
        for (int s = 0; s < 16; ++s) {
            const bf16x8_t bf = *(const bf16x8_t*)(zsrc + 16 * s);
#pragma unroll
            for (int mi = 0; mi < 2; ++mi) { const bf16x8_t af = *(const bf16x8_t*)(D3 + (32 * (2 * mh + mi) + r32) * 256 + 16 * s + 8 * hi);
                acc[mi] = __builtin_amdgcn_mfma_f32_32x32x16_bf16(af, bf, acc[mi], 0, 0, 0); }
        }
#pragma unroll
        for (int mi = 0; mi < 2; ++mi)
#pragma unroll
            for (int r = 0; r < 16; ++r) { const int k2 = 32 * (2 * mh + mi) + (r & 3) + 8 * (r >> 2) + 4 * hi;
                OM[((size_t)b * RPB + k1 + 64 * k2) * DM + 768 + ch] = f2bf(acc[mi][r] * 0.0013810679320049757f); }
    }
}

constexpr int LDS_BYTES = 132096;
constexpr int PH_FINAL = 25, PH_END = 26;
__global__ void __launch_bounds__(512, 2) mega(Params Pk, int ph_lo, int ph_hi) {
#if defined(__HIP_DEVICE_COMPILE__)
    extern __shared__ __attribute__((aligned(16))) unsigned char lds_raw[];
    LAS unsigned char* lds = (LAS unsigned char*)lds_raw;
    for (int ph = ph_lo; ph < ph_hi; ++ph) {
        KP P = (KP)__builtin_amdgcn_kernarg_segment_ptr(); asm volatile("" : "+s"(P));
        unsigned char* ws = P->ws;
        float* H = (float*)(ws + WS_H); bf16_t* XN = (bf16_t*)(ws + WS_XN); bf16_t* MID = (bf16_t*)(ws + WS_MID);
        if (ph == 0) prologue_phase(P, lds);
        else if (ph == PH_FINAL) final_phase(P);
        else {
            const int l = (ph - 1) / 12, s = (ph - 1) % 12;
            const float* MODl = (const float*)(ws + WS_MOD) + (size_t)l * 3 * NMOD;
            const bf16_t* WT = (const bf16_t*)(ws + WS_WT) + (size_t)l * WT_L;
            if (s == 0 || s == 3 || s == 8) {
                const float* g = (s == 0 ? P->g_ffn1 : s == 3 ? P->g_mix : P->g_ffn2) + l * 1024; const int shc = s == 0 ? 0 : s == 3 ? 3 : 6;
                norm_phase(P, g, MODl, shc, shc + 1, ph == 1);
            } else if (s == 1 || s == 2 || s == 4 || s == 7 || s == 9 || s == 10) {
                const int mode = (s == 1 || s == 9) ? 0 : (s == 4 ? 2 : 1);
                pg8::EpiAll E{ws, P->g_qn + l * 64, P->g_kn + l * 64, mode, l, s == 2 ? 2 : s == 7 ? 5 : 8, s == 7 ? 1.0f : 0.5f};
                const bf16_t* A = (s == 2 || s == 10) ? MID : XN;
                const bf16_t* Bt = WT + (mode == 0 ? WT_GU + (size_t)(s == 9 ? 1 : 0) * 5632 * 1024 : mode == 2 ? WT_IN : s == 7 ? WT_OUT : WT_DN + (size_t)(s == 10 ? 1 : 0) * 1024 * DFF);
                const int N = mode == 0 ? 5632 : mode == 2 ? NIN : 1024, K = (s == 2 || s == 10) ? DFF : 1024;
                run_gemm(lds, A, Bt, N, K, E);
            }
            else if (s == 5) {
#if FAST_FFT
                fft1_phase(P, l);
#endif
#if FAST_ATTN
                attn_phase(P, lds, l);
#endif
            }
#if FAST_FFT
            else if (s == 6) fft3_phase(P, lds, l);
#endif
        }
        if (ph + 1 < ph_hi) cg::this_grid().sync();
    }
#endif
}

__global__ void __launch_bounds__(64) attn_naive(const bf16_t* QA, const bf16_t* QB, const bf16_t* KA, const bf16_t* KB, const bf16_t* VTA, const bf16_t* VTB,
                                                   const float* sink, bf16_t* OM, int do_ctx) {
    const int rb = blockIdx.x, hh = blockIdx.y;
    const int row = rb * 64 + threadIdx.x, b = row / RPB, t = row - b * RPB; const bool lat = t < SEQ;
    if (!lat && !do_ctx) return;
    const bool isB = hh >= 6; const int h = isB ? hh - 6 : hh, kvh = h / 3;
    const bf16_t* Q = (isB ? QB : QA) + (size_t)row * 384 + h * 64;
    const bf16_t* K = (isB ? KB : KA) + (size_t)b * RPB * 128 + kvh * 64;
    const bf16_t* VT = (isB ? VTB : VTA) + ((size_t)(b * 2 + kvh) * 64) * RPB;
    float q[64], o[64];
#pragma unroll
    for (int d = 0; d < 64; ++d) { q[d] = bf2f(Q[d]); o[d] = 0.f; }
    float m = -1e30f, l = 0.f;
    const int t0 = (rb * 64) % RPB;
    int lo1, hi1; bool band = false;
    if (!lat) { lo1 = SEQ; hi1 = RPB; } else if (isB) { lo1 = 0; hi1 = RPB; } else { lo1 = max(0, t0 - 128); hi1 = min(SEQ, t0 + 64 + 128); band = true; }
    for (int seg = 0; seg < 2; ++seg) {
        int lo = seg == 0 ? lo1 : SEQ, hi = seg == 0 ? hi1 : RPB;
        if (seg == 1 && !(lat && !isB)) break;
        for (int key = lo; key < hi; ++key) {
            const bf16_t* kp = K + (size_t)key * 128; float s = 0.f;
#pragma unroll
            for (int d = 0; d < 64; ++d) s += q[d] * bf2f(kp[d]);
            bool valid = !(band && seg == 0) || (abs(key - t) <= 128);
            if (valid) {
                if (s > m) { float al = exp2f(m - s); l *= al;
#pragma unroll
                    for (int d = 0; d < 64; ++d) o[d] *= al;
                    m = s; }
                float p = exp2f(s - m); l += p;
#pragma unroll
                for (int d = 0; d < 64; ++d) o[d] += p * bf2f(VT[(size_t)d * RPB + key]);
            }
        }
    }
    if (!isB) { float s2 = sink[h] * LOG2E; float mf = fmaxf(m, s2); float al = exp2f(m - mf); l = l * al + exp2f(s2 - mf);
#pragma unroll
        for (int d = 0; d < 64; ++d) o[d] *= al; }
    float il = 1.f / l;
    bf16_t* op = OM + (size_t)row * DM + (isB ? 384 : 0) + h * 64;
#pragma unroll
    for (int d = 0; d < 64; ++d) op[d] = f2bf(o[d] * il);
}
__global__ void __launch_bounds__(256) fourier_lat_naive(const bf16_t* VS, const float* TAB, bf16_t* OM) {
    __shared__ float ct[8192];
    for (int i = threadIdx.x; i < 8192; i += 256) ct[i] = TAB[TAB_COS + i];
    __syncthreads();
    const int b = blockIdx.x / SEQ, k = blockIdx.x % SEQ, ch = threadIdx.x;
    float acc = 0.f;
    for (int l2 = 0; l2 < 128; ++l2) {
        const unsigned* vp = (const unsigned*)VS + ((size_t)(b * 128 + l2) * 256 + ch) * 64;
        for (int l1 = 0; l1 < 64; ++l1) { unsigned pk = vp[l1]; float vr = bf2f((bf16_t)(pk & 0xffff)), vi = bf2f((bf16_t)(pk >> 16));
            int l = l1 * 128 + l2; int j = (k * l) & 8191; acc += vr * ct[j] + vi * ct[(j - 2048) & 8191]; }
    }
    OM[(size_t)(b * RPB + k) * DM + 768 + ch] = f2bf(acc * 0.0013810679320049757f);
}
__global__ void __launch_bounds__(256) fourier_ctx_naive(const bf16_t* VC, const float* TAB, bf16_t* OM) {
    const int b = blockIdx.x / CTXL, k = blockIdx.x % CTXL, ch = threadIdx.x;
    const unsigned* vp = (const unsigned*)VC + (size_t)(b * 256) * 256 + ch;
    float acc = 0.f;
    for (int j = 0; j < 256; ++j) { unsigned pk = vp[(size_t)j * 256]; float vr = bf2f((bf16_t)(pk & 0xffff)), vi = bf2f((bf16_t)(pk >> 16));
        int a = ((k * j) & 255) * 32; acc += vr * TAB[TAB_COS + a] + vi * TAB[TAB_COS + ((a - 2048) & 8191)]; }
    OM[(size_t)(b * RPB + SEQ + k) * DM + 768 + ch] = f2bf(acc * (1.f / 128.f));
}

extern "C" void kernel_launch(void* const* d_in, const int* in_sizes, int n_in, void* d_out, int out_size, void* d_ws, size_t ws_size, hipStream_t stream) {
    static int grid = 0;
    if (grid == 0) {
        if (ws_size < WS_END) { fprintf(stderr, "ws too small %zu\n", ws_size); grid = -1; return; }
        hipFuncSetAttribute((const void*)mega, hipFuncAttributeMaxDynamicSharedMemorySize, LDS_BYTES);
        int dev = 0, cus = 0, per_cu = 0; hipGetDevice(&dev); hipDeviceGetAttribute(&cus, hipDeviceAttributeMultiprocessorCount, dev);
        hipOccupancyMaxActiveBlocksPerMultiprocessor(&per_cu, (const void*)mega, 512, LDS_BYTES);
        if (per_cu < 1) { fprintf(stderr, "occupancy query says %d\n", per_cu); grid = -1; return; }
        grid = cus;
    }
    if (grid < 0) return;
    Params P{};
    const float** pp = (const float**)&P;
    for (int i = 0; i < 22; ++i) pp[i] = (const float*)d_in[i];
    P.out = (float*)d_out; P.ws = (unsigned char*)d_ws;
    unsigned char* ws = P.ws;
    bf16_t* OM = (bf16_t*)(ws + WS_XN); const float* TAB = (const float*)(ws + WS_TAB);
#define RUN(lo, hi) hipLaunchKernelGGL(mega, dim3(grid), dim3(512), LDS_BYTES, stream, P, (int)(lo), (int)(hi))
    RUN(0, 1);
    for (int l = 0; l < 2; ++l) {
        const int base = 1 + 12 * l;
        for (int s = 0; s <= 4; ++s) RUN(base + s, base + s + 1);
#if FAST_ATTN || FAST_FFT
        RUN(base + 5, base + 6);
#endif
#if FAST_FFT
        RUN(base + 6, base + 7);
#endif
#if !FAST_ATTN
        attn_naive<<<dim3(M / 64, 12), 64, 0, stream>>>((bf16_t*)(ws + WS_QA), (bf16_t*)(ws + WS_QB), (bf16_t*)(ws + WS_KA), (bf16_t*)(ws + WS_KB), (bf16_t*)(ws + WS_VTA), (bf16_t*)(ws + WS_VTB),
                                                         P.sink + l * 6, OM, l == 0 ? 1 : 0);
#endif
#if !FAST_FFT
        fourier_lat_naive<<<NB * SEQ, 256, 0, stream>>>((bf16_t*)(ws + WS_VS), TAB, OM);
        if (l == 0) fourier_ctx_naive<<<NB * CTXL, 256, 0, stream>>>((bf16_t*)(ws + WS_VC), TAB, OM);
#endif
        for (int s = 7; s <= 10; ++s) RUN(base + s, base + s + 1);
    }
    RUN(PH_FINAL, PH_END);
}
```

```cpp
#include <hip/hip_runtime.h>
#include <hip/hip_cooperative_groups.h>
#include <stdint.h>
#include <cstdio>
namespace cg = cooperative_groups;

typedef unsigned short bf16_t;
__device__ __forceinline__ float bf2f(bf16_t v) { return __uint_as_float(((unsigned)v) << 16); }
__device__ __forceinline__ bf16_t f2bf(float f) { unsigned u = __float_as_uint(f); return (bf16_t)((u + 0x7fffu + ((u >> 16) & 1u)) >> 16); }
__device__ __forceinline__ unsigned pk2(float lo, float hi) { return (unsigned)f2bf(lo) | ((unsigned)f2bf(hi) << 16); }

constexpr int MIDP = 2880;
constexpr int DM = 1024, NB = 2, SEQ = 8192, CTXL = 256, RPB = SEQ + CTXL, M = NB * RPB, DFF = 2816, DIN = 1536, NMOD = 9216, NIN = 1792;
constexpr float QSCALE = 0.125f * 1.4426950408889634f;
constexpr float LOG2E = 1.4426950408889634f;
constexpr size_t MiB = 1u << 20;
constexpr size_t WS_H = 0, WS_XN = 66 * MiB, WS_MID = 99 * MiB;
constexpr size_t WS_QA = 99 * MiB, WS_QB = 112 * MiB, WS_KA = 125 * MiB, WS_KB = 130 * MiB, WS_VTA = 135 * MiB, WS_VTB = 140 * MiB, WS_VS = 145 * MiB, WS_ZS = 161 * MiB, WS_VC = 177 * MiB;
constexpr size_t WS_MOD = 201129984, WS_TAB = WS_MOD + 294912, WS_WT = WS_MOD + 524288, WS_PART = 270 * MiB, WS_END = 290 * MiB;
constexpr int TAB_COS = 0, TAB_ROPE = 8192;
constexpr size_t TAB_D1_BYTES = 65536, TAB_D3_BYTES = 65536 + 32768;
constexpr size_t WT_GU = 0, WT_DN = 2ull * 5632 * 1024, WT_IN = WT_DN + 2ull * 1024 * MIDP, WT_OUT = WT_IN + 1792ull * 1024, WT_L = WT_OUT + 1024ull * 1024;
static_assert(WS_WT + 2 * WT_L * 2 <= WS_PART, "ws map");

__device__ __forceinline__ float silu_f(float x) { return x * __builtin_amdgcn_rcpf(1.f + __expf(-x)); }
__device__ __forceinline__ int row_w(int row) { int b = row / RPB, t = row - b * RPB; return t >= SEQ ? 2 : b; }

struct Params {
    const float *x, *c, *ctx, *cctx, *w_ada, *b_ada, *g_ffn1, *g_mix, *g_ffn2, *w_in, *g_qn, *g_kn, *sink, *w_four, *w_out, *w1g, *w1u, *w1d, *w2g, *w2u, *w2d, *g_final;
    float* out; unsigned char* ws;
};
typedef const __attribute__((address_space(4))) Params* KP;

namespace pg8 {
#define PG8_LAS __attribute__((address_space(3)))
typedef unsigned short bf16_t;
typedef short bf16x8 __attribute__((ext_vector_type(8)));
typedef float f32x4 __attribute__((ext_vector_type(4)));
typedef unsigned u32x4 __attribute__((ext_vector_type(4)));
constexpr int BM = 256, BK = 64, HALF = 128, HTB = HALF * BK * 2  , STAGE_BYTES = 8 * HTB, NXCD = 8, WGM = 8;

__host__ __device__ __forceinline__ int lds_byte(int r, int c) { const int st = (r >> 4) * 2 + (c >> 5), rr = r & 15, cc = c & 31, ob = rr * 64 + cc * 2; return st * 1024 + (ob ^ (((ob >> 9) & 1) << 5)); }
__host__ __device__ __forceinline__ void stage_rc(int b, int& R, int& C) { const int st = b / 1024, sb = b % 1024, swz = sb ^ (((sb >> 9) & 1) << 5); R = (st >> 1) * 16 + swz / 64; C = (st & 1) * 32 + (swz % 64) / 2; }
__host__ __device__ __forceinline__ int perm32(int rho) { const int n = rho >> 4, i = rho & 15; return 8 * (i >> 2) + 4 * n + (i & 3); }

struct Unit { int pm, pn, ko; };
struct Gemm { const bf16_t* A; const bf16_t* Bt; int M, N, K, ld, blocked; };

struct StaticOrder {
    int nM, nN, nwg, G, c;
    __host__ __device__ void init(int M, int N, int G_, int c_) { nM = M / BM; nN = N / BM; nwg = nM * nN; G = G_; c = c_; }
    __host__ __device__ bool next(int i, Unit& u) const {
        const long L = (long)i * G + c; if (L >= nwg) return false;
        int wgid = (int)L; { const int q = nwg / NXCD, r = nwg % NXCD, xcd = wgid % NXCD, off = wgid / NXCD; wgid = (xcd < r ? xcd * (q + 1) : r * (q + 1) + (xcd - r) * q) + off; }
        const int nig = WGM * nN, gid = wgid / nig, fm = gid * WGM, gsz = (nM - fm) < WGM ? (nM - fm) : WGM;
        u.pm = fm + ((wgid % nig) % gsz); u.pn = (wgid % nig) / gsz; return true;
    }
    __device__ __forceinline__ void a_ready(const Unit&) const {}
    __device__ __forceinline__ void done(const Unit&) const {}
};

struct SplitOrder {
    int mode, nchunk, kchunk; StaticOrder S;
    __device__ void init(int mode_, int Mrows, int N, int G, int c, int nchunk_, int kchunk_) { mode = mode_; nchunk = nchunk_; kchunk = kchunk_; S.init(mode_ == 1 ? 64 * BM : Mrows, N, G, c); }
    __device__ bool next(int i, Unit& u) const {
        if (mode == 2) { const long L = (long)i * S.G + S.c; if (L >= 8 * nchunk) return false; const int un = (int)L / nchunk, ch = (int)L - un * nchunk;
            u.pm = (un >> 2) ? 65 : 32; u.pn = un & 3; u.ko = ch * kchunk; return true; }
        if (!S.next(i, u)) return false;
        u.ko = 0; if (mode == 1) u.pm += u.pm >> 5;
        return true;
    }
    __device__ __forceinline__ void a_ready(const Unit&) const {}
    __device__ __forceinline__ void done(const Unit&) const {}
};

__device__ __forceinline__ unsigned cvt_pk_bf16(float lo, float hi) { unsigned r; asm("v_cvt_pk_bf16_f32 %0, %1, %2" : "=v"(r) : "v"(lo), "v"(hi)); return r; }
__device__ __forceinline__ int tile_w(int pm) { const int b = pm / 33, wi = pm - b * 33; return wi == 32 ? 2 : b; }
struct EpiSwiglu {
    static constexpr bool PERM = false, AFTER_DRAIN = false;
    bf16_t* O;
    __device__ __forceinline__ void operator()(const f32x4 (&acc)[2][2][4][2], const Unit& u, int wr, int wc, int fr, int fq) const {
        const int row0 = u.pm * BM + wr * 64 + fr, col = u.pn * 128 + wc * 32 + fq * 8;
#pragma unroll
        for (int ai = 0; ai < 2; ++ai)
#pragma unroll
            for (int m = 0; m < 4; ++m) {
                const f32x4 g0 = acc[ai][0][m][0], u0 = acc[ai][1][m][0], g1 = acc[ai][0][m][1], u1 = acc[ai][1][m][1];
                u32x4 w;
                w.x = cvt_pk_bf16(silu_f(g0[0]) * u0[0], silu_f(g0[1]) * u0[1]); w.y = cvt_pk_bf16(silu_f(g0[2]) * u0[2], silu_f(g0[3]) * u0[3]);
                w.z = cvt_pk_bf16(silu_f(g1[0]) * u1[0], silu_f(g1[1]) * u1[1]); w.w = cvt_pk_bf16(silu_f(g1[2]) * u1[2], silu_f(g1[3]) * u1[3]);
                *(u32x4*)(O + (size_t)u.pm * BM * DFF + (size_t)(col >> 6) * (BM * 64) + (size_t)(wr * 64 + fr + ai * HALF + m * 16) * 64 + (col & 63)) = w;
            }
    }
};
struct EpiRes {
    static constexpr bool PERM = false, AFTER_DRAIN = false;
    float* H; const float* MODl; int gate_chunk; float coef; float* PART;
    __device__ __forceinline__ void operator()(const f32x4 (&acc)[2][2][4][2], const Unit& u, int wr, int wc, int fr, int fq) const {
        const float* gate = MODl + tile_w(u.pm) * NMOD + gate_chunk * 1024;
        const bool part = u.ko != 0;
        float* base = part ? PART + ((size_t)((u.ko >> 8) - 1) * 512 + (u.pm == 32 ? 0 : 256) + wr * 64 + fr) * DM : H + (size_t)(u.pm * BM + wr * 64 + fr) * DM;
#pragma unroll
        for (int bj = 0; bj < 2; ++bj)
#pragma unroll
            for (int n = 0; n < 2; ++n) {
                const int col = u.pn * BM + bj * HALF + wc * 32 + n * 16 + fq * 4;
                const f32x4 gv = *(const f32x4*)(gate + col) * coef;
                f32x4 old[2][4];
#pragma unroll
                for (int ai = 0; ai < 2; ++ai)
#pragma unroll
                    for (int m = 0; m < 4; ++m) old[ai][m] = part ? (f32x4){0.f, 0.f, 0.f, 0.f} : *(const f32x4*)(base + (size_t)(ai * HALF + m * 16) * DM + col);
#pragma unroll
                for (int ai = 0; ai < 2; ++ai)
#pragma unroll
                    for (int m = 0; m < 4; ++m) *(f32x4*)(base + (size_t)(ai * HALF + m * 16) * DM + col) = old[ai][m] + gv * acc[ai][bj][m][n];
            }
    }
};
struct EpiWin {
    static constexpr bool PERM = false, AFTER_DRAIN = false;
    const float* gqn; const float* gkn; const float* ROPE;
    bf16_t *QA, *QB, *KA, *KB, *VTA, *VTB; unsigned *VS, *VC;
    __device__ __forceinline__ void operator()(const f32x4 (&acc)[2][2][4][2], const Unit& u, int wr, int wc, int fr, int fq) const {
        const int unit = u.pn * 4 + wc;
        const int b = u.pm / 33, wi = u.pm - b * 33; const bool lat = wi < 32; const int t0 = wi * 256;
        if (unit < 20) {
            const bool isB = unit >= 10; const int ul = isB ? unit - 10 : unit;
            const bool isq = ul < 6, isk = ul >= 6 && ul < 8;
            f32x4 gg[2][2];
            if (isB && (isq || isk)) { const float* g = isq ? gqn : gkn;
#pragma unroll
                for (int bj = 0; bj < 2; ++bj)
#pragma unroll
                    for (int n = 0; n < 2; ++n) gg[bj][n] = *(const f32x4*)(g + 32 * bj + 16 * n + 4 * fq); }
#pragma unroll
            for (int ai = 0; ai < 2; ++ai)
#pragma unroll
                for (int m = 0; m < 4; ++m) {
                    const int t = t0 + ai * HALF + wr * 64 + m * 16 + fr; const size_t row = (size_t)b * RPB + t;
                    f32x4 v[2][2];
#pragma unroll
                    for (int bj = 0; bj < 2; ++bj)
#pragma unroll
                        for (int n = 0; n < 2; ++n) v[bj][n] = acc[ai][bj][m][n];
                    if (isB && (isq || isk)) {
                        float ss = 0.f;
#pragma unroll
                        for (int bj = 0; bj < 2; ++bj)
#pragma unroll
                            for (int n = 0; n < 2; ++n) ss += (v[bj][n][0] * v[bj][n][0] + v[bj][n][1] * v[bj][n][1]) + (v[bj][n][2] * v[bj][n][2] + v[bj][n][3] * v[bj][n][3]);
                        ss += __shfl_xor(ss, 16); ss += __shfl_xor(ss, 32);
                        const float r = rsqrtf(ss * (1.f / 64.f) + 1e-6f);
#pragma unroll
                        for (int bj = 0; bj < 2; ++bj)
#pragma unroll
                            for (int n = 0; n < 2; ++n) v[bj][n] = v[bj][n] * r * gg[bj][n];
                    }
                    if (lat && (isq || isk)) {
#pragma unroll
                        for (int bj = 0; bj < 2; ++bj) {
                            const int p = bj == 0 ? (t >> 6) : 128 + (t & 63);
                            const f32x4 cs0 = *(const f32x4*)(ROPE + (p * 16 + 4 * fq) * 2), cs1 = *(const f32x4*)(ROPE + (p * 16 + 4 * fq) * 2 + 4);
                            const f32x4 cv = {cs0[0], cs0[2], cs1[0], cs1[2]}, sv = {cs0[1], cs0[3], cs1[1], cs1[3]};
                            const f32x4 a = v[bj][0], bb = v[bj][1];
                            v[bj][0] = a * cv - bb * sv; v[bj][1] = bb * cv + a * sv;
                        }
                    }
                    if (isq || isk) {
                        const float sc = isq ? QSCALE : 1.f;
                        bf16_t* dst = isq ? ((isB ? QB : QA) + row * 384 + ul * 64) : ((isB ? KB : KA) + row * 128 + (ul - 6) * 64);
#pragma unroll
                        for (int bj = 0; bj < 2; ++bj)
#pragma unroll
                            for (int n = 0; n < 2; ++n) { const f32x4 x = v[bj][n] * sc; uint2 w; w.x = cvt_pk_bf16(x[0], x[1]); w.y = cvt_pk_bf16(x[2], x[3]);
                                *(uint2*)(dst + 32 * bj + 16 * n + 4 * fq) = w; }
                    } else {
                        bf16_t* dst = (isB ? VTB : VTA) + ((size_t)(b * 2 + (ul - 8)) * 64) * RPB + t;
#pragma unroll
                        for (int bj = 0; bj < 2; ++bj)
#pragma unroll
                            for (int n = 0; n < 2; ++n)
#pragma unroll
                                for (int i = 0; i < 4; ++i) dst[(size_t)(32 * bj + 16 * n + 4 * fq + i) * RPB] = f2bf(v[bj][n][i]);
                    }
                }
        } else {
            const int chb = ((unit - 20) >> 1) * 64 + 32 * ((unit - 20) & 1);
#pragma unroll
            for (int ai = 0; ai < 2; ++ai)
#pragma unroll
                for (int m = 0; m < 4; ++m) {
                    const int t = t0 + ai * HALF + wr * 64 + m * 16 + fr;
#pragma unroll
                    for (int bj = 0; bj < 2; ++bj)
#pragma unroll
                        for (int n = 0; n < 2; ++n) {
                            const f32x4 x = acc[ai][bj][m][n]; const int ch = chb + 16 * bj + 8 * n + 2 * fq;
                            const unsigned w0 = cvt_pk_bf16(x[0], x[1]), w1 = cvt_pk_bf16(x[2], x[3]);
                            if (lat) { unsigned* d = VS + ((size_t)(b * SEQ + t) * 256 + ch); d[0] = w0; d[1] = w1; }
                            else { unsigned* d = VC + ((size_t)(b * 256 + (t - SEQ)) * 256 + ch); d[0] = w0; d[1] = w1; }
                        }
                }
        }
    }
};

struct EpiAll {
    static constexpr bool PERM = false, AFTER_DRAIN = false;
    unsigned char* ws; const float* gqn; const float* gkn; int mode, l, chunk; float coef;
    __device__ __forceinline__ void operator()(const f32x4 (&acc)[2][2][4][2], const Unit& u, int wr, int wc, int fr, int fq) const {
        if (mode == 0) { EpiSwiglu E{(bf16_t*)(ws + WS_MID)}; E(acc, u, wr, wc, fr, fq); }
        else if (mode == 1) { EpiRes E{(float*)(ws + WS_H), (const float*)(ws + WS_MOD) + (size_t)l * 3 * NMOD, chunk, coef, (float*)(ws + WS_PART)}; E(acc, u, wr, wc, fr, fq); }
        else { EpiWin E{gqn, gkn, (const float*)(ws + WS_TAB) + TAB_ROPE, (bf16_t*)(ws + WS_QA), (bf16_t*)(ws + WS_QB), (bf16_t*)(ws + WS_KA), (bf16_t*)(ws + WS_KB),
                        (bf16_t*)(ws + WS_VTA), (bf16_t*)(ws + WS_VTB), (unsigned*)(ws + WS_VS), (unsigned*)(ws + WS_VC)}; E(acc, u, wr, wc, fr, fq); }
    }
};

template <class Epi, class Sched, bool ALIGN_EPI = false, bool SP2 = false>
__device__ __forceinline__ void gemm_phase(PG8_LAS unsigned char* lds, const Gemm g, const Sched& S, const Epi& E) {
    int tid_ = threadIdx.x; asm volatile("" : "+v"(tid_)); const int tid = tid_, wid = __builtin_amdgcn_readfirstlane(tid >> 6), lane = tid & 63, wr = wid >> 2, wc = wid & 3, fr = lane & 15, fq = lane >> 4;
    const int K = g.K, nt = K / BK, LD = g.blocked ? BK : g.ld;
    unsigned voffA[2], voffB[2];
#pragma unroll
    for (int i = 0; i < 2; ++i) { int R, C; stage_rc(tid * 16 + i * 8192, R, C); const int Rb = Epi::PERM ? ((R & ~31) + perm32(R & 31)) : R;
        voffA[i] = (unsigned)(R * LD + C) * 2u; voffB[i] = (unsigned)(Rb * LD + C) * 2u; }
    const size_t kstep = g.blocked ? (size_t)(BM * BK * 2) : (size_t)(BK * 2);
    const size_t hstep = (size_t)HALF * LD * 2;
    const size_t tstep = g.blocked ? (size_t)BM * g.ld * 2 : 2 * hstep;
    const unsigned ldsw = (unsigned)wid * 1024u;
    const int aoff = lds_byte(wr * 64 + fr, fq * 8), boff = lds_byte(wc * 32 + fr, fq * 8);
#define PG8_SA(b, h) (((b) * 2 + (h)) * HTB)
#define PG8_SB(b, h) ((4 + (b) * 2 + (h)) * HTB)
#define PG8_STAGE(bufoff, gbase, voff) do { _Pragma("unroll") for (int _i = 0; _i < 2; ++_i) \
        __builtin_amdgcn_global_load_lds((const unsigned*)((const char*)(gbase) + (voff)[_i]), (PG8_LAS unsigned*)(lds + (bufoff) + ldsw + _i * 8192), 16, 0, 0); } while (0)
#define PG8_LDA(dst, b, h) do { _Pragma("unroll") for (int m = 0; m < 4; ++m) _Pragma("unroll") for (int k = 0; k < 2; ++k) dst[m][k] = *(const PG8_LAS bf16x8*)(lds + PG8_SA(b, h) + aoff + m * 2048 + k * 1024); } while (0)
#define PG8_LDB(dst, b, h) do { _Pragma("unroll") for (int n = 0; n < 2; ++n) _Pragma("unroll") for (int k = 0; k < 2; ++k) dst[n][k] = *(const PG8_LAS bf16x8*)(lds + PG8_SB(b, h) + boff + n * 2048 + k * 1024); } while (0)
#define PG8_MMA(ai, bj, At, Bt) do { __builtin_amdgcn_s_setprio(1); _Pragma("unroll") for (int m = 0; m < 4; ++m) _Pragma("unroll") for (int n = 0; n < 2; ++n) _Pragma("unroll") for (int k = 0; k < 2; ++k) \
        acc[ai][bj][m][n] = __builtin_amdgcn_mfma_f32_16x16x32_bf16(Bt[n][k], At[m][k], acc[ai][bj][m][n], 0, 0, 0); __builtin_amdgcn_s_setprio(0); } while (0)
#define PG8_WAIT_V(n) asm volatile("s_waitcnt vmcnt(" #n ")" ::: "memory")
#define PG8_WAIT_L(n) asm volatile("s_waitcnt lgkmcnt(" #n ")" ::: "memory")
#define PG8_BAR __builtin_amdgcn_s_barrier()
#define PG8_SCHED __builtin_amdgcn_sched_barrier(0)
    Unit cur, nxt; int ui = 0;
    if (!S.next(0, cur)) return;
    f32x4 acc[2][2][4][2];
#pragma unroll
    for (int a = 0; a < 2; ++a)
#pragma unroll
        for (int b = 0; b < 2; ++b)
#pragma unroll
            for (int m = 0; m < 4; ++m)
#pragma unroll
                for (int n = 0; n < 2; ++n) acc[a][b][m][n] = (f32x4){0.f, 0.f, 0.f, 0.f};
    bf16x8 At[4][2], B0[2][2], B1[2][2];
    const char* cA = (const char*)g.A + (size_t)cur.pm * tstep + (size_t)(cur.ko / BK) * kstep; const char* cB = (const char*)g.Bt + (size_t)cur.pn * tstep + (size_t)(cur.ko / BK) * kstep;
    S.a_ready(cur);
    if constexpr (SP2) {
        PG8_STAGE(PG8_SB(0, 0), cB, voffB); PG8_STAGE(PG8_SB(0, 1), cB + hstep, voffB); PG8_STAGE(PG8_SA(0, 0), cA, voffA); PG8_STAGE(PG8_SA(0, 1), cA + hstep, voffA);
        if (wr == 1) PG8_BAR;
        PG8_WAIT_V(2); PG8_BAR;
        PG8_STAGE(PG8_SB(1, 0), cB + kstep, voffB); PG8_STAGE(PG8_SA(1, 0), cA + kstep, voffA); PG8_STAGE(PG8_SB(1, 1), cB + hstep + kstep, voffB);
        PG8_WAIT_V(6); PG8_BAR;
    } else {
        PG8_STAGE(PG8_SB(0, 0), cB, voffB); PG8_STAGE(PG8_SA(0, 0), cA, voffA); PG8_STAGE(PG8_SB(0, 1), cB + hstep, voffB); PG8_STAGE(PG8_SA(0, 1), cA + hstep, voffA);
        if (wr == 1) PG8_BAR;
        PG8_WAIT_V(4); PG8_BAR;
        PG8_STAGE(PG8_SB(1, 0), cB + kstep, voffB); PG8_STAGE(PG8_SA(1, 0), cA + kstep, voffA); PG8_STAGE(PG8_SB(1, 1), cB + hstep + kstep, voffB);
        PG8_WAIT_V(6); PG8_BAR;
    }
    for (;;) {
        const bool has_next = S.next(ui + 1, nxt);
        const char* nA = has_next ? (const char*)g.A + (size_t)nxt.pm * tstep + (size_t)(nxt.ko / BK) * kstep : cA; const char* nB = has_next ? (const char*)g.Bt + (size_t)nxt.pn * tstep + (size_t)(nxt.ko / BK) * kstep : cB;
        for (int t = 0; t < nt; t += 2) {
            const bool last = (t == nt - 2);
            const char* a1 = cA + (size_t)(t + 1) * kstep;
            const char* a2 = last ? nA : cA + (size_t)(t + 2) * kstep; const char* b2 = last ? nB : cB + (size_t)(t + 2) * kstep;
            const char* a3 = a2 + kstep; const char* b3 = b2 + kstep;
            if (last && has_next) S.a_ready(nxt);
            if constexpr (SP2) {
            PG8_LDB(B0, 0, 0); PG8_LDB(B1, 0, 1); PG8_SCHED; PG8_LDA(At, 0, 0); PG8_STAGE(PG8_SA(1, 1), a1 + hstep, voffA);
            PG8_WAIT_V(8); PG8_WAIT_L(0); PG8_BAR; PG8_MMA(0, 0, At, B0); PG8_MMA(0, 1, At, B1); PG8_BAR; PG8_SCHED;
            PG8_LDA(At, 0, 1); PG8_STAGE(PG8_SB(0, 0), b2, voffB); PG8_STAGE(PG8_SB(0, 1), b2 + hstep, voffB); PG8_STAGE(PG8_SA(0, 0), a2, voffA);
            PG8_WAIT_V(8); PG8_WAIT_L(0); PG8_BAR; PG8_MMA(1, 0, At, B0); PG8_MMA(1, 1, At, B1); PG8_BAR; PG8_SCHED;
            PG8_LDB(B0, 1, 0); PG8_LDB(B1, 1, 1); PG8_SCHED; PG8_LDA(At, 1, 0); PG8_STAGE(PG8_SA(0, 1), a2 + hstep, voffA);
            PG8_WAIT_V(8); PG8_WAIT_L(0); PG8_BAR; PG8_MMA(0, 0, At, B0); PG8_MMA(0, 1, At, B1); PG8_BAR; PG8_SCHED;
            PG8_LDA(At, 1, 1); PG8_STAGE(PG8_SB(1, 0), b3, voffB); PG8_STAGE(PG8_SB(1, 1), b3 + hstep, voffB); PG8_STAGE(PG8_SA(1, 0), a3, voffA);
            PG8_WAIT_V(8); PG8_WAIT_L(0); PG8_BAR; PG8_MMA(1, 0, At, B0); PG8_MMA(1, 1, At, B1); PG8_BAR; PG8_SCHED;
            } else {
            PG8_LDB(B0, 0, 0); PG8_SCHED; PG8_LDA(At, 0, 0); PG8_STAGE(PG8_SA(1, 1), a1 + hstep, voffA);
            PG8_WAIT_L(8); PG8_BAR; PG8_WAIT_L(0); PG8_MMA(0, 0, At, B0); PG8_BAR; PG8_SCHED;
            PG8_LDB(B1, 0, 1); PG8_STAGE(PG8_SB(0, 0), b2, voffB);
            PG8_BAR; PG8_WAIT_L(0); PG8_MMA(0, 1, At, B1); PG8_BAR;
            PG8_LDA(At, 0, 1); PG8_STAGE(PG8_SA(0, 0), a2, voffA);
            PG8_BAR; PG8_WAIT_L(0); PG8_MMA(1, 0, At, B0); PG8_BAR; PG8_SCHED;
            PG8_STAGE(PG8_SB(0, 1), b2 + hstep, voffB);
            PG8_WAIT_V(6); PG8_BAR; PG8_MMA(1, 1, At, B1); PG8_BAR;
            PG8_LDB(B0, 1, 0); PG8_SCHED; PG8_LDA(At, 1, 0); PG8_STAGE(PG8_SA(0, 1), a2 + hstep, voffA);
            PG8_WAIT_L(8); PG8_BAR; PG8_WAIT_L(0); PG8_MMA(0, 0, At, B0); PG8_BAR; PG8_SCHED;
            PG8_LDB(B1, 1, 1); PG8_STAGE(PG8_SB(1, 0), b3, voffB);
            PG8_BAR; PG8_WAIT_L(0); PG8_MMA(0, 1, At, B1); PG8_BAR;
            PG8_LDA(At, 1, 1); PG8_STAGE(PG8_SA(1, 0), a3, voffA);
            PG8_BAR; PG8_WAIT_L(0); PG8_MMA(1, 0, At, B0); PG8_BAR; PG8_SCHED;
            PG8_STAGE(PG8_SB(1, 1), b3 + hstep, voffB);
            PG8_WAIT_V(6); PG8_BAR; PG8_MMA(1, 1, At, B1); PG8_BAR;
            }
        }
        if constexpr (ALIGN_EPI) { if (wr == 0) PG8_BAR; }
        if constexpr (!Epi::AFTER_DRAIN) { E(acc, cur, wr, wc, fr, fq); S.done(cur); }
        if (!has_next) break;
#pragma unroll
        for (int a = 0; a < 2; ++a)
#pragma unroll
            for (int b = 0; b < 2; ++b)
#pragma unroll
                for (int m = 0; m < 4; ++m)
#pragma unroll
                    for (int n = 0; n < 2; ++n) acc[a][b][m][n] = (f32x4){0.f, 0.f, 0.f, 0.f};
        cur = nxt; cA = nA; cB = nB; ++ui;
        if constexpr (ALIGN_EPI) { if (wr == 1) PG8_BAR; }
    }
    PG8_WAIT_V(0);
    if constexpr (!ALIGN_EPI) { if (wr == 0) PG8_BAR; }
    PG8_BAR;
    if constexpr (Epi::AFTER_DRAIN) { E.fused(acc, cur, wr, wc, fr, fq, lds, wid, lane); S.done(cur); }
#undef PG8_SA
#undef PG8_SB
#undef PG8_STAGE
#undef PG8_LDA
#undef PG8_LDB
#undef PG8_MMA
#undef PG8_WAIT_V
#undef PG8_WAIT_L
#undef PG8_BAR
#undef PG8_SCHED
}
}
#define FAST_ATTN 1
#define FAST_FFT 1
#define LAS __attribute__((address_space(3)))
__device__ __forceinline__ float wave_sum(float v) {
#pragma unroll
    for (int o = 1; o < 64; o <<= 1) v += __shfl_xor(v, o);
    return v;
}
__device__ __forceinline__ void tr_write(const LAS float* scr, bf16_t* Bt, int ldk, int k0, int P0, int P1, int P2, int P3, int lane) {
    const int c = lane & 7, nl = lane >> 3;
#pragma unroll
    for (int j = 0; j < 4; ++j) { const int n = nl + 8 * j; const LAS float* s = scr + (8 * c) * 33 + n; const int P = j == 0 ? P0 : j == 1 ? P1 : j == 2 ? P2 : P3;
        uint4 o; o.x = pk2(s[0], s[33]); o.y = pk2(s[2 * 33], s[3 * 33]); o.z = pk2(s[4 * 33], s[5 * 33]); o.w = pk2(s[6 * 33], s[7 * 33]);
        *(uint4*)(Bt + (size_t)P * ldk + k0 + 8 * c) = o; }
    asm volatile("s_waitcnt lgkmcnt(0)" ::: "memory");
}
__device__ __forceinline__ void tr_load(LAS float* scr, const float* W, int ldw, int k0, int col0, int lane) {
    float v[32];
#pragma unroll
    for (int i = 0; i < 32; ++i) v[i] = W[(size_t)(k0 + 2 * i + (lane >> 5)) * ldw + col0 + (lane & 31)];
#pragma unroll
    for (int i = 0; i < 32; ++i) scr[(2 * i + (lane >> 5)) * 33 + (lane & 31)] = v[i];
    asm volatile("s_waitcnt lgkmcnt(0)" ::: "memory");
}
__device__ __forceinline__ int perm_gu(int j, int t) { const int jj = j & 127; return 256 * (j >> 7) + 128 * t + 32 * (jj >> 5) + 16 * ((jj & 7) >> 2) + 4 * ((jj & 31) >> 3) + (jj & 3); }
__device__ __forceinline__ int perm_in(int u, int d) { return 256 * (u >> 2) + 32 * (u & 3) + 128 * (d >> 5) + (d & 31); }

__device__ __forceinline__ void prologue_phase(KP P, LAS unsigned char* lds) {
    int tid_ = threadIdx.x, bid_ = blockIdx.x; asm volatile("" : "+v"(tid_)); asm volatile("" : "+s"(bid_));
    const int tid = tid_, lane = tid & 63, wave = tid >> 6, bid = bid_, G = gridDim.x;
    float* MOD = (float*)(P->ws + WS_MOD); float* TAB = (float*)(P->ws + WS_TAB);
    LAS float* cs64 = (LAS float*)(lds + 8 * 8448);
    LAS unsigned* ctr = (LAS unsigned*)(lds + 8 * 8448 + 256);
    if (tid < 64) cs64[tid] = cospif((float)tid / 32.f);
    if (tid == 64) ctr[0] = 0u;
    {
        const int i = bid * 512 + tid;
        if (i < 8192) TAB[TAB_COS + i] = cospif((float)i / 4096.f);
        else if (i < 8192 + 3072) { const int e = i - 8192, p = e / 16, k = e % 16; const float inv = powf(10000.f, -(float)(2 * k) / 32.f);
            const float ang = (float)(p < 128 ? p : p - 128) * inv; TAB[TAB_ROPE + e * 2] = cosf(ang); TAB[TAB_ROPE + e * 2 + 1] = sinf(ang); }
        else if (i < 8192 + 3072 + 16384) { const int e = i - 8192 - 3072, mrow = e >> 7, kcol = e & 127; const int k1 = mrow >> 1, ro = mrow & 1, l1 = kcol >> 1, ri = kcol & 1;
            const int j = (k1 * l1) & 63; const float cv = cospif((float)j / 32.f), sv = sinpif((float)j / 32.f);
            const float v = (ro == ri) ? cv : (ro == 0 ? sv : -sv);
            ((bf16_t*)(P->ws + WS_TAB + TAB_D1_BYTES))[e] = f2bf(v); }
        else if (i < 8192 + 3072 + 16384 + 32768) { const int e = i - 8192 - 3072 - 16384, k2 = e >> 8, kcol = e & 255, l2 = kcol >> 1, ri = kcol & 1;
            const int j = (k2 * l2) & 127; const float v = ri == 0 ? cospif((float)j / 64.f) : sinpif((float)j / 64.f);
            ((bf16_t*)(P->ws + WS_TAB + TAB_D3_BYTES))[e] = f2bf(v); }
    }
    {
        LAS float* sv = (LAS float*)lds;
        LAS float* red = (LAS float*)(lds + 12288);
        for (int i = tid; i < 1024; i += 512) { sv[i] = silu_f(P->c[i]); sv[1024 + i] = silu_f(P->c[1024 + i]); sv[2048 + i] = silu_f(P->cctx[i]); }
        __syncthreads();
        for (int it = bid; it < 256; it += G) {
            const int l = it >> 7, n0 = (it & 127) * 72;
            const float* W = P->w_ada + (size_t)l * 1024 * NMOD + n0;
            float a0 = 0.f, a1 = 0.f, a2 = 0.f, e0 = 0.f, e1 = 0.f, e2 = 0.f;
            const int ks = wave * 128 + 16 * (lane >> 3);
#pragma unroll
            for (int j = 0; j < 16; ++j) { const float w = W[(size_t)(ks + j) * NMOD + 64 + (lane & 7)]; e0 += sv[ks + j] * w; e1 += sv[1024 + ks + j] * w; e2 += sv[2048 + ks + j] * w; }
#pragma unroll 32
            for (int k = wave * 128; k < wave * 128 + 128; ++k) { const float w = W[(size_t)k * NMOD + lane]; a0 += sv[k] * w; a1 += sv[1024 + k] * w; a2 += sv[2048 + k] * w; }
#pragma unroll
            for (int o = 8; o < 64; o <<= 1) { e0 += __shfl_xor(e0, o); e1 += __shfl_xor(e1, o); e2 += __shfl_xor(e2, o); }
            red[(wave * 3 + 0) * 72 + lane] = a0; red[(wave * 3 + 1) * 72 + lane] = a1; red[(wave * 3 + 2) * 72 + lane] = a2;
            if (lane < 8) { red[(wave * 3 + 0) * 72 + 64 + lane] = e0; red[(wave * 3 + 1) * 72 + 64 + lane] = e1; red[(wave * 3 + 2) * 72 + 64 + lane] = e2; }
            __syncthreads();
            if (tid < 216) { const int w = tid / 72, cc = tid - w * 72; float s = P->b_ada[l * NMOD + n0 + cc];
#pragma unroll
                for (int q = 0; q < 8; ++q) s += red[(q * 3 + w) * 72 + cc];
                MOD[(size_t)(l * 3 + w) * NMOD + n0 + cc] = s; }
            __syncthreads();
        }
    }
    {
        LAS float* scr = (LAS float*)(lds + wave * 8448);
        const int nl = lane >> 3;
        for (int hid = bid + G * wave; hid < 768 && wave < 8; hid += 8 * G) {
            const int l = hid / 384; int r = hid - l * 384;
            bf16_t* WT = (bf16_t*)(P->ws + WS_WT) + (size_t)l * WT_L;
            if (r < 256) {
                const int kb = r / 16, ob = r % 16;
                const int u = 20 + (ob >> 1), g = (u - 20) >> 1, half = (u - 20) & 1, q = (ob & 1) * 32 + (lane & 31);
                const int dch = 32 * half + (q >> 1), ri = q & 1;
                const float* W = P->w_in + (size_t)l * 1024 * DIN + 1280 + g * 64;
                float tw[64];
#pragma unroll
                for (int cc = 0; cc < 64; ++cc) { const int j = (cc * dch) & 63; tw[cc] = ri == 0 ? cs64[j] : -cs64[(j - 16) & 63]; }
                for (int i = 0; i < 32; ++i) { const int kk = 2 * i + (lane >> 5); const float4* w4 = (const float4*)(W + (size_t)(kb * 64 + kk) * DIN); float a = 0.f;
#pragma unroll
                    for (int c4 = 0; c4 < 16; ++c4) { const float4 wv = w4[c4]; a += wv.x * tw[4 * c4] + wv.y * tw[4 * c4 + 1] + wv.z * tw[4 * c4 + 2] + wv.w * tw[4 * c4 + 3]; }
                    scr[kk * 33 + (lane & 31)] = a; }
                asm volatile("s_waitcnt lgkmcnt(0)" ::: "memory");
                const int d = (ob & 1) * 32 + nl;
                tr_write(scr, WT + WT_IN, 1024, kb * 64, perm_in(u, d), perm_in(u, d + 8), perm_in(u, d + 16), perm_in(u, d + 24), lane);
            } else {
                r -= 256; const int g = r / 32, nb = r % 32;
                const float* wo = P->w_out + (size_t)l * 1024 * 1024 + (size_t)(768 + g * 64) * 1024 + nb * 32 + (lane & 31);
                const float* wf = P->w_four + (size_t)(l * 4 + g) * 4096;
                float wov[64];
#pragma unroll
                for (int d = 0; d < 64; ++d) wov[d] = wo[(size_t)d * 1024];
                for (int i = 0; i < 32; ++i) { const int kk = 2 * i + (lane >> 5); const float4* f4 = (const float4*)(wf + kk * 64); float a = 0.f;
#pragma unroll
                    for (int d4 = 0; d4 < 16; ++d4) { const float4 fv = f4[d4]; a += fv.x * wov[4 * d4] + fv.y * wov[4 * d4 + 1] + fv.z * wov[4 * d4 + 2] + fv.w * wov[4 * d4 + 3]; }
                    scr[kk * 33 + (lane & 31)] = a; }
                asm volatile("s_waitcnt lgkmcnt(0)" ::: "memory");
                const int j = nb * 32 + nl;
                tr_write(scr, WT + WT_OUT, 1024, 768 + g * 64, j, j + 8, j + 16, j + 24, lane);
            }
        }
        constexpr int NA = 4 * 1408, NBd = 2 * 1408, NC = 640, NE = 384, NL = NA + NBd + NC + NE;
        const int lo = (int)(((long)bid * (2 * NL)) / G), hi = (int)(((long)(bid + 1) * (2 * NL)) / G);
        for (;;) {
            unsigned iu = 0u; if (lane == 0) iu = __hip_atomic_fetch_add(ctr, 1u, __ATOMIC_RELAXED, __HIP_MEMORY_SCOPE_WORKGROUP);
            const int it = lo + (int)__builtin_amdgcn_readfirstlane(iu);
            if (it >= hi) break;
            const int l = it / NL; int r = it - l * NL;
            bf16_t* WT = (bf16_t*)(P->ws + WS_WT) + (size_t)l * WT_L;
            if (r < NA) { const int f = r / 2816, t = (r / 1408) & 1, q = r % 1408, kb = q / 88, nb = q % 88;
                const float* W = (f == 0 ? (t == 0 ? P->w1g : P->w1u) : (t == 0 ? P->w2g : P->w2u)) + (size_t)l * 1024 * DFF;
                tr_load(scr, W, DFF, kb * 64, nb * 32, lane);
                const int j = nb * 32 + nl;
                tr_write(scr, WT + WT_GU + (size_t)f * 5632 * 1024, 1024, kb * 64, perm_gu(j, t), perm_gu(j + 8, t), perm_gu(j + 16, t), perm_gu(j + 24, t), lane);
                continue; }
            r -= NA;
            if (r < NBd) { const int f = r / 1408, q = r % 1408, kb = q / 32, nb = q % 32;
                const float* W = (f == 0 ? P->w1d : P->w2d) + (size_t)l * DFF * 1024;
                tr_load(scr, W, 1024, kb * 64, nb * 32, lane);
                const int j = nb * 32 + nl;
                { bf16_t* Bd = WT + WT_DN + (size_t)f * 1024 * MIDP + (size_t)(j >> 8) * 256 * DFF + (size_t)kb * (256 * 64);
                  tr_write(scr, Bd, 64, 0, j & 255, (j + 8) & 255, (j + 16) & 255, (j + 24) & 255, lane); }
                continue; }
            r -= NBd;
            if (r < NC) { const int kb = r / 40, nb = r % 40;
                tr_load(scr, P->w_in + (size_t)l * 1024 * DIN, DIN, kb * 64, nb * 32, lane);
                const int u = nb >> 1, d = (nb & 1) * 32 + nl;
                tr_write(scr, WT + WT_IN, 1024, kb * 64, perm_in(u, d), perm_in(u, d + 8), perm_in(u, d + 16), perm_in(u, d + 24), lane);
                continue; }
            r -= NC;
            { const int kb = r / 32, nb = r % 32;
                tr_load(scr, P->w_out + (size_t)l * 1024 * 1024, 1024, kb * 64, nb * 32, lane);
                const int j = nb * 32 + nl;
                tr_write(scr, WT + WT_OUT, 1024, kb * 64, j, j + 8, j + 16, j + 24, lane); }
        }
    }
}
__device__ __forceinline__ void norm_phase(KP P, const float* g, const float* MODl, int shc, int scc, bool from_input, int npart) {
    int tid_ = threadIdx.x, bid_ = blockIdx.x; asm volatile("" : "+v"(tid_)); asm volatile("" : "+s"(bid_));
    const int lane = tid_ & 63, gw = bid_ * 8 + (tid_ >> 6), NGW = gridDim.x * 8;
    float* H = (float*)(P->ws + WS_H); bf16_t* XN = (bf16_t*)(P->ws + WS_XN);
    constexpr int RU = 3;
    for (int row0 = gw; row0 < M; row0 += RU * NGW) {
        float4 v[RU][4]; float ss[RU];
#pragma unroll
        for (int u = 0; u < RU; ++u) { const int row = row0 + u * NGW; ss[u] = 0.f;
            if (row < M) { const int b = row / RPB, t = row - b * RPB;
                const float4* h = from_input ? (t < SEQ ? (const float4*)(P->x + ((size_t)b * SEQ + t) * DM) : (const float4*)(P->ctx + ((size_t)b * CTXL + (t - SEQ)) * DM)) : (const float4*)(H + (size_t)row * DM);
#pragma unroll
                for (int j = 0; j < 4; ++j) v[u][j] = h[lane + 64 * j]; } }
#pragma unroll
        for (int u = 0; u < RU; ++u) { const int row = row0 + u * NGW;
            if (row < M) { const int b = row / RPB, t = row - b * RPB, w = t >= SEQ ? 2 : b;
                if (t >= SEQ && npart > 0) {
                    const float4* pp = (const float4*)(P->ws + WS_PART) + (size_t)(b * CTXL + (t - SEQ)) * 256 + lane;
                    for (int q = 0; q < npart; ++q) {
#pragma unroll
                        for (int j = 0; j < 4; ++j) { const float4 a = pp[(size_t)q * 512 * 256 + 64 * j]; v[u][j].x += a.x; v[u][j].y += a.y; v[u][j].z += a.z; v[u][j].w += a.w; } } }
#pragma unroll
                for (int j = 0; j < 4; ++j) ss[u] += v[u][j].x * v[u][j].x + v[u][j].y * v[u][j].y + v[u][j].z * v[u][j].z + v[u][j].w * v[u][j].w;
                if (from_input || (t >= SEQ && npart > 0)) {
#pragma unroll
                    for (int j = 0; j < 4; ++j) ((float4*)(H + (size_t)row * DM))[lane + 64 * j] = v[u][j]; }
                const float r = rsqrtf(wave_sum(ss[u]) * (1.f / DM) + 1e-6f);
                const float* sh = MODl + w * NMOD + shc * 1024; const float* sc = MODl + w * NMOD + scc * 1024;
#pragma unroll
                for (int j = 0; j < 4; ++j) { const int c = (lane + 64 * j) * 4; const float4 gg = *(const float4*)(g + c), s4 = *(const float4*)(sh + c), c4 = *(const float4*)(sc + c);
                    uint2 o; o.x = pk2(v[u][j].x * r * gg.x * (1.f + c4.x) + s4.x, v[u][j].y * r * gg.y * (1.f + c4.y) + s4.y);
                    o.y = pk2(v[u][j].z * r * gg.z * (1.f + c4.z) + s4.z, v[u][j].w * r * gg.w * (1.f + c4.w) + s4.w);
                    *(uint2*)(XN + (size_t)row * DM + c) = o; } } }
    }
}
__device__ __forceinline__ void final_phase(KP P) {
    int tid_ = threadIdx.x, bid_ = blockIdx.x; asm volatile("" : "+v"(tid_)); asm volatile("" : "+s"(bid_));
    const int lane = tid_ & 63, gw = bid_ * 8 + (tid_ >> 6), NGW = gridDim.x * 8;
    const float* H = (const float*)(P->ws + WS_H);
    for (int orow = gw; orow < NB * SEQ; orow += NGW) {
        const int b = orow / SEQ, t = orow - b * SEQ;
        const float4* h = (const float4*)(H + (size_t)(b * RPB + t) * DM);
        float4 v[4]; float ss = 0.f;
#pragma unroll
        for (int j = 0; j < 4; ++j) { v[j] = h[lane + 64 * j]; ss += v[j].x * v[j].x + v[j].y * v[j].y + v[j].z * v[j].z + v[j].w * v[j].w; }
        const float r = rsqrtf(wave_sum(ss) * (1.f / DM) + 1e-6f);
#pragma unroll
        for (int j = 0; j < 4; ++j) { const int c = (lane + 64 * j) * 4; const float4 gg = *(const float4*)(P->g_final + c);
            float4 o; o.x = v[j].x * r * gg.x; o.y = v[j].y * r * gg.y; o.z = v[j].z * r * gg.z; o.w = v[j].w * r * gg.w;
            *(float4*)(P->out + (size_t)orow * DM + c) = o; }
    }
}
template <class Epi> __device__ __forceinline__ void run_gemm(LAS unsigned char* lds, const bf16_t* A, const bf16_t* Bt, int N, int K, int lda, int blocked, int no_ctx, Epi E) {
    const int npass = (N == 1024 && !no_ctx) ? 2 : 1;
    for (int pass = 0; pass < npass; ++pass) {
        pg8::Gemm g{A, Bt, M, N, pass ? 256 : K, lda, blocked}; pg8::SplitOrder S; S.init((N == 1024 || no_ctx) ? 1 + pass : 0, M, N, (int)gridDim.x, (int)blockIdx.x, K / 256, 256);
        pg8::gemm_phase<Epi, pg8::SplitOrder, true, true>(lds, g, S, E);
    }
}

typedef float f32x16 __attribute__((ext_vector_type(16)));
typedef short bf16x8_t __attribute__((ext_vector_type(8)));
typedef short s16x4_t __attribute__((ext_vector_type(4)));
typedef unsigned u32x4_t __attribute__((ext_vector_type(4)));
typedef unsigned u32x2_t __attribute__((ext_vector_type(2)));
constexpr int AT_KBUF = 0, AT_VBUF = 32768, AT_VSTRIDE = 264, AT_VBYTES = 64 * AT_VSTRIDE, AT_COMB = AT_VBUF + 3 * AT_VBYTES, AT_COMB_PAIR = 34 * 64 * 4;
static_assert(AT_COMB + 4 * AT_COMB_PAIR <= 131072, "attention LDS map");
__device__ __forceinline__ unsigned cvtpk(float lo, float hi) { unsigned r; asm volatile("v_cvt_pk_bf16_f32 %0, %1, %2" : "=v"(r) : "v"(lo), "v"(hi)); return r; }

__device__ __forceinline__ void attn_unit(KP P, LAS unsigned char* lds, int l, int tid, int b, int hh, int q0, bool lat) {
    unsigned char* ws = P->ws;
    const int lane = tid & 63, r32 = lane & 31, hi = lane >> 5, wid = __builtin_amdgcn_readfirstlane(tid >> 6), g = wid >> 2, wq = wid & 3;
    const bool isB = hh >= 6; const int h = isB ? hh - 6 : hh, kvh = h / 3;
    const bf16_t* Q = (const bf16_t*)(ws + (isB ? WS_QB : WS_QA)) + ((size_t)b * RPB + q0 + 32 * wq + r32) * 384 + h * 64;
    const bf16_t* Kg = (const bf16_t*)(ws + (isB ? WS_KB : WS_KA)) + (size_t)b * RPB * 128 + kvh * 64;
    const bf16_t* Vg = (const bf16_t*)(ws + (isB ? WS_VTB : WS_VTA)) + ((size_t)(b * 2 + kvh) * 64) * RPB;
    int npre, kb_lo, nsteps;
    if (!lat) { npre = 2; kb_lo = 0; nsteps = 2; }
    else if (isB) { npre = 0; kb_lo = 0; nsteps = 66; }
    else { const int qb = q0 >> 7; kb_lo = qb > 0 ? qb - 1 : 0; const int kb_hi = qb < 63 ? qb + 1 : 63; npre = 2; nsteps = 2 + (kb_hi - kb_lo + 1); }
    const int kkey0 = tid >> 3, kc = tid & 7;
    const unsigned kdst0 = (unsigned)(kkey0 * 128 + ((kc ^ ((kkey0 >> 1) & 7)) * 16));
    const int vd0 = tid >> 4, vc = tid & 15;
    const unsigned vdst0 = (unsigned)(vd0 * AT_VSTRIDE + vc * 16);
    const bf16_t* kg0 = Kg + (size_t)kkey0 * 128 + kc * 8;
    const bf16_t* vg0 = Vg + (size_t)vd0 * RPB + vc * 8;
    u32x4_t pk0, pk1, pv0, pv1;
#define AT_KP0(s) ((s) < npre ? SEQ + 128 * (s) : 128 * (kb_lo + (s) - npre))
#define AT_LOADK(s) do { const int kp0_ = AT_KP0(s); pk0 = *(const u32x4_t*)(kg0 + (size_t)kp0_ * 128); pk1 = *(const u32x4_t*)(kg0 + (size_t)(kp0_ + 64) * 128); } while (0)
#define AT_LOADV(s) do { const int kp0_ = AT_KP0(s); pv0 = *(const u32x4_t*)(vg0 + kp0_); pv1 = *(const u32x4_t*)(vg0 + (size_t)32 * RPB + kp0_); } while (0)
#define AT_STOREK(buf) do { LAS unsigned char* kb_ = lds + AT_KBUF + (buf) * 16384; *(LAS u32x4_t*)(kb_ + kdst0) = pk0; *(LAS u32x4_t*)(kb_ + kdst0 + 8192) = pk1; } while (0)
#define AT_STOREV(buf) do { LAS unsigned char* vb_ = lds + AT_VBUF + (buf) * AT_VBYTES; \
        *(LAS u32x2_t*)(vb_ + vdst0) = (u32x2_t){pv0.x, pv0.y}; *(LAS u32x2_t*)(vb_ + vdst0 + 8) = (u32x2_t){pv0.z, pv0.w}; \
        *(LAS u32x2_t*)(vb_ + vdst0 + 32 * AT_VSTRIDE) = (u32x2_t){pv1.x, pv1.y}; *(LAS u32x2_t*)(vb_ + vdst0 + 32 * AT_VSTRIDE + 8) = (u32x2_t){pv1.z, pv1.w}; } while (0)
#define AT_QK_LD(buf) do { const LAS unsigned char* kb_ = lds + AT_KBUF + (buf) * 16384; \
        _Pragma("unroll") for (int d0 = 0; d0 < 4; ++d0) { kf[2 * d0] = *(const LAS bf16x8_t*)(kb_ + koff[d0]); kf[2 * d0 + 1] = *(const LAS bf16x8_t*)(kb_ + koff[d0] + 4096); } } while (0)
#define AT_QK_MMA(S0_, S1_) do { S0_ = __builtin_amdgcn_mfma_f32_32x32x16_bf16(kf[0], qf[0], negm, 0, 0, 0); S1_ = __builtin_amdgcn_mfma_f32_32x32x16_bf16(kf[1], qf[0], negm, 0, 0, 0); \
        _Pragma("unroll") for (int d0 = 1; d0 < 4; ++d0) { \
            S0_ = __builtin_amdgcn_mfma_f32_32x32x16_bf16(kf[2 * d0], qf[d0], S0_, 0, 0, 0); S1_ = __builtin_amdgcn_mfma_f32_32x32x16_bf16(kf[2 * d0 + 1], qf[d0], S1_, 0, 0, 0); } } while (0)
#define AT_QK(S0_, S1_, buf) do { AT_QK_LD(buf); __builtin_amdgcn_sched_barrier(0); AT_QK_MMA(S0_, S1_); } while (0)
    AT_LOADK(0); AT_LOADV(0);
    bf16x8_t qf[4], kf[8], vfr[8];
#pragma unroll
    for (int d0 = 0; d0 < 4; ++d0) qf[d0] = *(const bf16x8_t*)(Q + 16 * d0 + 8 * hi);
    const int key0 = 64 * g + r32; const int swz = (key0 >> 1) & 7;
    unsigned koff[4];
#pragma unroll
    for (int d0 = 0; d0 < 4; ++d0) koff[d0] = (unsigned)(key0 * 128 + (((2 * d0 + hi) ^ swz) * 16));
    const unsigned voff = (unsigned)(r32 * AT_VSTRIDE + 128 * g + 8 * hi);
    f32x16 O0 = {}, O1 = {};
    float m = 0.f, lsum = 0.f, pend = 0.f;
    f32x16 negm = {};
    constexpr float AT_THR = 8.f;
    const int qp = q0 + 32 * wq + r32;
    AT_STOREK(0); AT_STOREV(0);
    AT_LOADK(1);
    AT_STOREK(1);
    __syncthreads();
    f32x16 S0, S1;
    AT_QK(S0, S1, 0);
    __syncthreads();
#define AT_PV_LD(vs) do { const LAS unsigned char* vb_ = lds + AT_VBUF + (vs) * AT_VBYTES; \
        _Pragma("unroll") for (int sl = 0; sl < 4; ++sl) _Pragma("unroll") for (int dd = 0; dd < 2; ++dd) { \
            const u32x2_t lo = *(const LAS u32x2_t*)(vb_ + voff + dd * 32 * AT_VSTRIDE + 32 * sl), hi8 = *(const LAS u32x2_t*)(vb_ + voff + dd * 32 * AT_VSTRIDE + 32 * sl + 16); \
            const u32x4_t vw = {lo.x, lo.y, hi8.x, hi8.y}; vfr[2 * sl + dd] = __builtin_bit_cast(bf16x8_t, vw); } } while (0)
#define AT_PV_MMA() do { _Pragma("unroll") for (int sl = 0; sl < 4; ++sl) { const bf16x8_t pf = __builtin_bit_cast(bf16x8_t, pp[sl]); \
            O0 = __builtin_amdgcn_mfma_f32_32x32x16_bf16(vfr[2 * sl], pf, O0, 0, 0, 0); O1 = __builtin_amdgcn_mfma_f32_32x32x16_bf16(vfr[2 * sl + 1], pf, O1, 0, 0, 0); } } while (0)
#define AT_PV(vs) do { AT_PV_LD(vs); __builtin_amdgcn_sched_barrier(0); AT_PV_MMA(); } while (0)
    u32x4_t pp[4] = {};
    int vs_prev = 0, vs_cur = 0, vs_next = 1;
    for (int s = 0; s < nsteps; ++s) {
        if (s + 2 < nsteps) AT_LOADK(s + 2);
        if (s + 1 < nsteps) AT_LOADV(s + 1);
        f32x16 N0, N1;
        if (lat && !isB && s >= npre) {
            const int kpb = AT_KP0(s) + 64 * g + 4 * hi - qp;
#pragma unroll
            for (int r = 0; r < 16; ++r) { const int dlt = kpb + (r & 3) + 8 * (r >> 2);
                if (dlt > 128 || dlt < -128) S0[r] = -1e30f;
                if (dlt + 32 > 128 || dlt + 32 < -128) S1[r] = -1e30f; }
        }
        if (__any(pend != 0.f)) { S0 = S0 - pend; S1 = S1 - pend; }
        AT_QK_LD((s + 1) & 1);
        __builtin_amdgcn_sched_barrier(0);
        AT_QK_MMA(N0, N1);
        AT_PV_LD(vs_prev);
        __builtin_amdgcn_sched_barrier(0);
        AT_PV_MMA();
        __builtin_amdgcn_sched_barrier(0);
        float rm = __builtin_fmaxf(__builtin_fmaxf(S0[0], S1[0]), S0[1]);
#pragma unroll
        for (int r = 1; r < 16; ++r) rm = __builtin_fmaxf(__builtin_fmaxf(rm, S1[r]), r < 15 ? S0[r + 1] : S1[r]);
        rm = fmaxf(rm, __shfl_xor(rm, 32));
        float alpha = 1.f; pend = 0.f;
        if (s == 0 || __any(rm > AT_THR)) {
            const float dl = s == 0 ? rm : fmaxf(rm, 0.f);
            S0 = S0 - dl; S1 = S1 - dl; negm = negm - dl; m += dl; pend = dl;
            alpha = __builtin_amdgcn_exp2f(-dl); lsum *= alpha;
        }
        float ps = 0.f;
#pragma unroll
        for (int r = 0; r < 16; ++r) { S0[r] = __builtin_amdgcn_exp2f(S0[r]); S1[r] = __builtin_amdgcn_exp2f(S1[r]); ps += S0[r] + S1[r]; }
        lsum += ps;
#pragma unroll
        for (int sl = 0; sl < 4; ++sl) { const int rb = 8 * (sl & 1);
            if (sl < 2) pp[sl] = (u32x4_t){cvtpk(S0[rb], S0[rb + 1]), cvtpk(S0[rb + 2], S0[rb + 3]), cvtpk(S0[rb + 4], S0[rb + 5]), cvtpk(S0[rb + 6], S0[rb + 7])};
            else pp[sl] = (u32x4_t){cvtpk(S1[rb], S1[rb + 1]), cvtpk(S1[rb + 2], S1[rb + 3]), cvtpk(S1[rb + 4], S1[rb + 5]), cvtpk(S1[rb + 6], S1[rb + 7])}; }
        __builtin_amdgcn_sched_barrier(0);
        if (__any(alpha != 1.f)) {
#pragma unroll
            for (int r = 0; r < 16; ++r) { O0[r] *= alpha; O1[r] *= alpha; } }
        if (s + 2 < nsteps) AT_STOREK(s & 1);
        if (s + 1 < nsteps) AT_STOREV(vs_next);
        __syncthreads();
        S0 = N0; S1 = N1;
        vs_prev = vs_cur; vs_cur = vs_next; vs_next = vs_next == 2 ? 0 : vs_next + 1;
    }
    AT_PV(vs_prev);
#undef AT_PV
#undef AT_PV_LD
#undef AT_PV_MMA
#undef AT_QK_LD
#undef AT_QK_MMA
#undef AT_LOADK
#undef AT_LOADV
#undef AT_STOREK
#undef AT_STOREV
#undef AT_QK
    float ltot = lsum + __shfl_xor(lsum, 32);
    LAS float* comb = (LAS float*)(lds + AT_COMB + wq * AT_COMB_PAIR);
    if (g == 1) {
        comb[lane] = m; comb[64 + lane] = ltot;
#pragma unroll
        for (int r = 0; r < 16; ++r) { comb[(2 + r) * 64 + lane] = O0[r]; comb[(18 + r) * 64 + lane] = O1[r]; }
    }
    __syncthreads();
    if (g == 0) {
        const float m1 = comb[lane], l1 = comb[64 + lane];
        float mf = fmaxf(m, m1); float sk = 0.f;
        if (!isB) { const float s2 = P->sink[l * 6 + h] * LOG2E; mf = fmaxf(mf, s2); sk = __builtin_amdgcn_exp2f(s2 - mf); }
        const float a0 = __builtin_amdgcn_exp2f(m - mf), a1 = __builtin_amdgcn_exp2f(m1 - mf);
        const float inv = 1.f / (ltot * a0 + l1 * a1 + sk);
        const float c0 = a0 * inv, c1 = a1 * inv;
        bf16_t* dst = (bf16_t*)(ws + WS_XN) + ((size_t)b * RPB + q0 + 32 * wq + r32) * DM + (isB ? 384 : 0) + h * 64 + 4 * hi;
#pragma unroll
        for (int rq = 0; rq < 4; ++rq) {
            float o[8];
#pragma unroll
            for (int i = 0; i < 4; ++i) { o[i] = O0[4 * rq + i] * c0 + comb[(2 + 4 * rq + i) * 64 + lane] * c1; o[4 + i] = O1[4 * rq + i] * c0 + comb[(18 + 4 * rq + i) * 64 + lane] * c1; }
            *(u32x2_t*)(dst + 8 * rq) = (u32x2_t){cvtpk(o[0], o[1]), cvtpk(o[2], o[3])};
            *(u32x2_t*)(dst + 32 + 8 * rq) = (u32x2_t){cvtpk(o[4], o[5]), cvtpk(o[6], o[7])};
        }
    }
    __syncthreads();
#undef AT_KP0
}
__device__ __forceinline__ void attn_phase(KP P, LAS unsigned char* lds, int l) {
    int tid_ = threadIdx.x, bid_ = blockIdx.x; asm volatile("" : "+v"(tid_)); asm volatile("" : "+s"(bid_));
    const int G = gridDim.x;
    const bool xcd = (G == 256);
    const int NU = 1536 + (l == 0 ? 48 : 0);
    for (int it = 0;; ++it) {
        int idx;
        if (xcd) { if (it >= 7) break; idx = it < 6 ? (it / 3) * 768 + (bid_ & 7) * 96 + (it % 3) * 32 + (bid_ >> 3) : 1536 + bid_; if (idx >= NU) break; }
        else { idx = bid_ + it * G; if (idx >= NU) break; }
        int b, hh, q0; bool lat = true;
        if (idx < 768) { b = idx / 384; hh = 6 + (idx % 384) / 64; q0 = (idx & 63) * 128; }
        else if (idx < 1536) { const int u = idx - 768; b = u / 384; hh = (u % 384) / 64; q0 = (u & 63) * 128; }
        else { const int u = idx - 1536; b = u / 24; hh = (u % 24) >> 1; q0 = SEQ + 128 * (u & 1); lat = false; }
        attn_unit(P, lds, l, tid_, b, hh, q0, lat);
    }
}

__device__ __forceinline__ void fft1_phase(KP P, int l) {
    int tid_ = threadIdx.x, bid_ = blockIdx.x; asm volatile("" : "+v"(tid_)); asm volatile("" : "+s"(bid_));
    unsigned char* ws = P->ws;
    const int lane = tid_ & 63, r32 = lane & 31, hi = lane >> 5, w = tid_ >> 6;
    const bf16_t* D1 = (const bf16_t*)(ws + WS_TAB + TAB_D1_BYTES); const float* TAB = (const float*)(ws + WS_TAB);
    for (int it = bid_; it < 256; it += gridDim.x) {
        const int b = it >> 7, l2 = it & 127, ch = 32 * w + r32;
        const unsigned* vsrc = (const unsigned*)(ws + WS_VS) + ((size_t)(b * SEQ + l2 + 512 * hi)) * 256 + ch;
        u32x4_t bfr[8];
#pragma unroll
        for (int s = 0; s < 8; ++s)
#pragma unroll
            for (int j = 0; j < 4; ++j) bfr[s][j] = vsrc[(size_t)(128 * (8 * s + j)) * 256];
        f32x16 acc[4] = {};
#pragma unroll
        for (int s = 0; s < 8; ++s) {
            const bf16x8_t bf = __builtin_bit_cast(bf16x8_t, bfr[s]);
#pragma unroll
            for (int mt = 0; mt < 4; ++mt) { const bf16x8_t af = *(const bf16x8_t*)(D1 + (32 * mt + r32) * 128 + 16 * s + 8 * hi);
                acc[mt] = __builtin_amdgcn_mfma_f32_32x32x16_bf16(af, bf, acc[mt], 0, 0, 0); }
        }
        unsigned* zs = (unsigned*)(ws + WS_ZS);
#pragma unroll
        for (int mt = 0; mt < 4; ++mt)
#pragma unroll
            for (int rq = 0; rq < 4; ++rq)
#pragma unroll
                for (int e = 0; e < 2; ++e) {
                    const int k1 = 16 * mt + 4 * rq + 2 * hi + e; const int idx = k1 * l2;
                    const float ct = TAB[TAB_COS + idx], st = TAB[TAB_COS + ((idx - 2048) & 8191)];
                    const float yr = acc[mt][4 * rq + 2 * e], yi = acc[mt][4 * rq + 2 * e + 1];
                    zs[((size_t)(b * 64 + k1) * 128 + l2) * 256 + ch] = cvtpk(yr * ct + yi * st, yi * ct - yr * st);
                }
    }
    if (l == 0) {
        const unsigned* VC = (const unsigned*)(ws + WS_VC); bf16_t* OM = (bf16_t*)(ws + WS_XN);
        for (int gt = bid_ * 512 + tid_; gt < NB * CTXL * 256; gt += gridDim.x * 512) {
            const int ch = gt & 255, k = (gt >> 8) & 255, b = gt >> 16;
            const unsigned* vp = VC + (size_t)(b * 256) * 256 + ch; float a = 0.f;
#pragma unroll 8
            for (int j = 0; j < 256; ++j) { const unsigned pk = vp[(size_t)j * 256]; const float vr = __uint_as_float(pk << 16), vi = __uint_as_float(pk & 0xffff0000u);
                const int ix = ((k * j) & 255) * 32; a += vr * TAB[TAB_COS + ix] + vi * TAB[TAB_COS + ((ix - 2048) & 8191)]; }
            OM[(size_t)(b * RPB + SEQ + k) * DM + 768 + ch] = f2bf(a * (1.f / 128.f));
        }
    }
}
__device__ __forceinline__ void fft3_phase(KP P, LAS unsigned char* lds, int l) {
    int tid_ = threadIdx.x, bid_ = blockIdx.x; asm volatile("" : "+v"(tid_)); asm volatile("" : "+s"(bid_));
    unsigned char* ws = P->ws;
    const int lane = tid_ & 63, r32 = lane & 31, hi = lane >> 5, w = tid_ >> 6;
    const bf16_t* D3 = (const bf16_t*)(ws + WS_TAB + TAB_D3_BYTES); bf16_t* OM = (bf16_t*)(ws + WS_XN);
    for (int it = bid_; it < 256; it += gridDim.x) {
        const int b = it >> 7, k1 = (it & 127) >> 1, chh = it & 1, ch = 32 * (4 * chh + (w & 3)) + r32, mh = w >> 2;
        const unsigned* zsrc = (const unsigned*)(ws + WS_ZS) + ((size_t)(b * 64 + k1) * 128 + 4 * hi) * 256 + ch;
        f32x16 acc[2] = {};
#pragma unroll
        for (int sh = 0; sh < 2; ++sh) {
            u32x4_t bfr[8];
#pragma unroll
            for (int s = 0; s < 8; ++s)
#pragma unroll
                for (int j = 0; j < 4; ++j) bfr[s][j] = zsrc[(size_t)(8 * (8 * sh + s) + j) * 256];
#pragma unroll
            for (int s = 0; s < 8; ++s) {
                const bf16x8_t bf = __builtin_bit_cast(bf16x8_t, bfr[s]);
#pragma unroll
                for (int mi = 0; mi < 2; ++mi) { const bf16x8_t af = *(const bf16x8_t*)(D3 + (32 * (2 * mh + mi) + r32) * 256 + 16 * (8 * sh + s) + 8 * hi);
                    acc[mi] = __builtin_amdgcn_mfma_f32_32x32x16_bf16(af, bf, acc[mi], 0, 0, 0); }
            }
        }
#pragma unroll
        for (int mi = 0; mi < 2; ++mi)
#pragma unroll
            for (int r = 0; r < 16; ++r) { const int k2 = 32 * (2 * mh + mi) + (r & 3) + 8 * (r >> 2) + 4 * hi;
                OM[((size_t)b * RPB + k1 + 64 * k2) * DM + 768 + ch] = f2bf(acc[mi][r] * 0.0013810679320049757f); }
    }
}

#define GAS __attribute__((address_space(1)))
#define XB_TMO      128
#define XB_XCNT(j)  (256  + 64 * (j))
#define XB_XSUB(j)  (1280 + 64 * (j))
#define XB_XGEN(j)  (2304 + 64 * (j))
#define XB_TOP      3328
#define XB_TOPGEN   3392
#define XCD_BAR_WORDS 3456
#define XB_SPIN_CAP (1u << 18)

__device__ __forceinline__ unsigned xb_ld(unsigned* p)              { return __hip_atomic_load(p, __ATOMIC_RELAXED, __HIP_MEMORY_SCOPE_AGENT); }
__device__ __forceinline__ unsigned xb_add(unsigned* p, unsigned v) { return __hip_atomic_fetch_add(p, v, __ATOMIC_RELAXED, __HIP_MEMORY_SCOPE_AGENT); }
__device__ __forceinline__ unsigned xb_xcc_id() { return (unsigned)__builtin_amdgcn_s_getreg((3 << 11) | 20) & 0xFu; }
#define XB_SPIN(cond, bar) do { unsigned _sp = 0; while (cond) { __builtin_amdgcn_s_sleep(1); \
    if ((++_sp & 255u) == 0u) { if (xb_ld(&(bar)[XB_TMO])) break; if (_sp > XB_SPIN_CAP) { atomicAdd(&(bar)[XB_TMO], 1u); break; } } } } while (0)

struct XcdBarrier {
    unsigned* bar; unsigned x;
    volatile LAS unsigned* st;
};

__device__ __forceinline__ XcdBarrier xcd_barrier_post(unsigned* bar, volatile LAS unsigned* st) {
    XcdBarrier b; b.bar = bar; b.x = xb_xcc_id(); b.st = st;
    if (threadIdx.x == 0) (void)xb_add(&bar[XB_XCNT(b.x)], 1u);
    return b;
}
__device__ __forceinline__ void xcd_barrier_complete(unsigned* bar, unsigned x, unsigned& nloc, unsigned& nx) {
    const unsigned G = gridDim.x * gridDim.y * gridDim.z;
    unsigned sum, cnt, mine, sp = 0u;
    for (;;) {
        sum = 0u; cnt = 0u; mine = 0u;
#pragma unroll
        for (unsigned j = 0; j < 16; ++j) { const unsigned c = xb_ld(&bar[XB_XCNT(j)]); sum += c; cnt += (c > 0u) ? 1u : 0u; mine = (j == x) ? c : mine; }
        if (sum == G) break;
        __builtin_amdgcn_s_sleep(1);
        if ((++sp & 255u) == 0u) { if (xb_ld(&bar[XB_TMO])) break; if (sp > XB_SPIN_CAP) { atomicAdd(&bar[XB_TMO], 1u); break; } }
    }
    nloc = mine > 0u ? mine : 1u; nx = cnt > 0u ? cnt : 1u;
}

__device__ __forceinline__ void xcd_barrier(const XcdBarrier& b) {
    asm volatile("s_waitcnt vmcnt(0)" ::: "memory");
    __syncthreads();
    if (threadIdx.x == 0) {
        unsigned* bar = b.bar;
        __builtin_amdgcn_s_waitcnt(0);
        unsigned nloc = b.st[0], nx = b.st[1];
        if (nloc == 0u) { xcd_barrier_complete(bar, b.x, nloc, nx); b.st[0] = nloc; b.st[1] = nx; }
        const unsigned old = xb_add(&bar[XB_XSUB(b.x)], 1u);
        const unsigned gen = old / nloc;
        if (old + 1u == (gen + 1u) * nloc) {
            __builtin_amdgcn_fence(__ATOMIC_RELEASE, "agent");
            asm volatile("s_waitcnt vmcnt(0)" ::: "memory");
            const unsigned og = xb_add(&bar[XB_TOP], 1u);
            const unsigned tg = og / nx;
            if (og + 1u == (tg + 1u) * nx) xb_add(&bar[XB_TOPGEN], 1u);
            else XB_SPIN(xb_ld(&bar[XB_TOPGEN]) == tg, bar);
            __builtin_amdgcn_fence(__ATOMIC_ACQUIRE, "agent");
            xb_add(&bar[XB_XGEN(b.x)], 1u);
            asm volatile("s_waitcnt vmcnt(0)" ::: "memory");
        } else {
            XB_SPIN(xb_ld(&bar[XB_XGEN(b.x)]) == gen, bar);
            __builtin_amdgcn_fence(__ATOMIC_ACQUIRE, "agent");
            asm volatile("s_waitcnt vmcnt(0)" ::: "memory");
        }
    }
    __syncthreads();
}

constexpr int LDS_BYTES = 132096;
constexpr int PH_FINAL = 25, PH_END = 26;
constexpr size_t WS_BAR = WS_MOD + 262144;
constexpr int MISC_OFF = 131072;
__global__ void __launch_bounds__(512, 2) mega(Params Pk, int ph_lo, int ph_hi) {
#if defined(__HIP_DEVICE_COMPILE__)
    extern __shared__ __attribute__((aligned(16))) unsigned char lds_raw[];
    LAS unsigned char* lds = (LAS unsigned char*)lds_raw;
    volatile LAS unsigned* MISC = (volatile LAS unsigned*)(lds + MISC_OFF);
    if (threadIdx.x < 32) MISC[threadIdx.x] = 0u;
    __syncthreads();
    XcdBarrier bar; bar.bar = nullptr; bar.x = 0; bar.st = nullptr;
    for (int ph = ph_lo; ph < ph_hi; ++ph) {
        KP P = (KP)__builtin_amdgcn_kernarg_segment_ptr(); asm volatile("" : "+s"(P));
        if (ph == 0 && blockIdx.x == 0) { unsigned* bw = (unsigned*)(P->ws + WS_BAR); for (int i = threadIdx.x; i < XCD_BAR_WORDS; i += 512) bw[i] = 0u; }
        unsigned char* ws = P->ws;
        float* H = (float*)(ws + WS_H); bf16_t* XN = (bf16_t*)(ws + WS_XN); bf16_t* MID = (bf16_t*)(ws + WS_MID);
        if (ph == 0) prologue_phase(P, lds);
        else if (ph == PH_FINAL) final_phase(P);
        else {
            const int l = (ph - 1) / 12, s = (ph - 1) % 12;
            const float* MODl = (const float*)(ws + WS_MOD) + (size_t)l * 3 * NMOD;
            const bf16_t* WT = (const bf16_t*)(ws + WS_WT) + (size_t)l * WT_L;
            if (s == 0 || s == 3 || s == 8) {
                const float* g = (s == 0 ? P->g_ffn1 : s == 3 ? P->g_mix : P->g_ffn2) + l * 1024; const int shc = s == 0 ? 0 : s == 3 ? 3 : 6;
                norm_phase(P, g, MODl, shc, shc + 1, ph == 1, ph == 1 ? 0 : (s == 8 ? (l == 1 ? 0 : 3) : 10));
            } else if (s == 1 || s == 2 || s == 4 || s == 7 || s == 9 || s == 10) {
                const int mode = (s == 1 || s == 9) ? 0 : (s == 4 ? 2 : 1);
                pg8::EpiAll E{ws, P->g_qn + l * 64, P->g_kn + l * 64, mode, l, s == 2 ? 2 : s == 7 ? 5 : 8, s == 7 ? 1.0f : 0.5f};
                const bf16_t* A = (s == 2 || s == 10) ? MID : XN;
                const bf16_t* Bt = WT + (mode == 0 ? WT_GU + (size_t)(s == 9 ? 1 : 0) * 5632 * 1024 : mode == 2 ? WT_IN : s == 7 ? WT_OUT : WT_DN + (size_t)(s == 10 ? 1 : 0) * 1024 * MIDP);
                const int N = mode == 0 ? 5632 : mode == 2 ? NIN : 1024, K = (s == 2 || s == 10) ? DFF : 1024;
                run_gemm(lds, A, Bt, N, K, (s == 2 || s == 10) ? DFF : 1024, (s == 2 || s == 10) ? 1 : 0, (l == 1 && s >= 7) ? 1 : 0, E);
            }
            else if (s == 5) {
#if FAST_FFT
                fft1_phase(P, l);
#endif
#if FAST_ATTN
                attn_phase(P, lds, l);
#endif
            }
#if FAST_FFT
            else if (s == 6) fft3_phase(P, lds, l);
#endif
        }
        if (ph + 1 < ph_hi) {
            if (ph == 0) { cg::this_grid().sync(); bar = xcd_barrier_post((unsigned*)(P->ws + WS_BAR), MISC + 8); }
            else xcd_barrier(bar);
        }
    }
#endif
}

extern "C" void kernel_launch(void* const* d_in, const int* in_sizes, int n_in, void* d_out, int out_size, void* d_ws, size_t ws_size, hipStream_t stream) {
    static int grid = 0;
    if (grid == 0) {
        if (ws_size < WS_END || n_in < 22) { fprintf(stderr, "kernel_launch: ws too small (%zu) or n_in %d\n", ws_size, n_in); grid = -1; return; }
        if (hipFuncSetAttribute((const void*)mega, hipFuncAttributeMaxDynamicSharedMemorySize, LDS_BYTES) != hipSuccess) { fprintf(stderr, "kernel_launch: hipFuncSetAttribute failed\n"); grid = -1; return; }
        int dev = 0, cus = 0, per_cu = 0; hipGetDevice(&dev); hipDeviceGetAttribute(&cus, hipDeviceAttributeMultiprocessorCount, dev);
        if (hipOccupancyMaxActiveBlocksPerMultiprocessor(&per_cu, (const void*)mega, 512, LDS_BYTES) != hipSuccess || per_cu < 1) { fprintf(stderr, "kernel_launch: occupancy query says %d\n", per_cu); grid = -1; return; }
        grid = cus;
    }
    if (grid < 0) return;
    Params P{};
    const float** pp = (const float**)&P;
    for (int i = 0; i < 22; ++i) pp[i] = (const float*)d_in[i];
    P.out = (float*)d_out; P.ws = (unsigned char*)d_ws;
    int lo = 0, hi = PH_END;
    void* args[] = {&P, &lo, &hi};
    hipError_t e = hipLaunchCooperativeKernel((const void*)mega, dim3(grid), dim3(512), args, LDS_BYTES, stream);
    if (e != hipSuccess) fprintf(stderr, "kernel_launch: cooperative launch failed: %s (grid %d)\n", hipGetErrorString(e), grid);
}
```

```cpp
#include <hip/hip_runtime.h>
#include <hip/hip_cooperative_groups.h>
#include <stdint.h>
#include <cstdio>
namespace cg = cooperative_groups;

typedef unsigned short bf16_t;
__device__ __forceinline__ float bf2f(bf16_t v) { return __uint_as_float(((unsigned)v) << 16); }
__device__ __forceinline__ bf16_t f2bf(float f) { unsigned u = __float_as_uint(f); return (bf16_t)((u + 0x7fffu + ((u >> 16) & 1u)) >> 16); }
__device__ __forceinline__ unsigned pk2(float lo, float hi) { return (unsigned)f2bf(lo) | ((unsigned)f2bf(hi) << 16); }

constexpr int MIDP = 2880;
constexpr int DM = 1024, NB = 2, SEQ = 8192, CTXL = 256, RPB = SEQ + CTXL, M = NB * RPB, DFF = 2816, DIN = 1536, NMOD = 9216, NIN = 1792;
constexpr float QSCALE = 0.125f * 1.4426950408889634f;
constexpr float LOG2E = 1.4426950408889634f;
constexpr size_t MiB = 1u << 20;
constexpr size_t WS_H = 0, WS_XN = 66 * MiB, WS_MID = 99 * MiB;
constexpr size_t WS_QA = 99 * MiB, WS_QB = 112 * MiB, WS_KA = 125 * MiB, WS_KB = 130 * MiB, WS_VTA = 135 * MiB, WS_VTB = 140 * MiB, WS_VS = 145 * MiB, WS_ZS = 161 * MiB, WS_VC = 177 * MiB;
constexpr size_t WS_MOD = 201129984, WS_TAB = WS_MOD + 294912, WS_WT = WS_MOD + 524288, WS_PART = 270 * MiB, WS_END = 290 * MiB;
constexpr int TAB_COS = 0, TAB_ROPE = 8192;
constexpr size_t TAB_D1_BYTES = 65536, TAB_D3_BYTES = 65536 + 32768;
constexpr size_t WT_GU = 0, WT_DN = 2ull * 5632 * 1024, WT_IN = WT_DN + 2ull * 1024 * MIDP, WT_OUT = WT_IN + 1792ull * 1024, WT_L = WT_OUT + 1024ull * 1024;
static_assert(WS_WT + 2 * WT_L * 2 <= WS_PART, "ws map");

__device__ __forceinline__ float silu_f(float x) { return x * __builtin_amdgcn_rcpf(1.f + __expf(-x)); }
__device__ __forceinline__ int row_w(int row) { int b = row / RPB, t = row - b * RPB; return t >= SEQ ? 2 : b; }

struct Params {
    const float *x, *c, *ctx, *cctx, *w_ada, *b_ada, *g_ffn1, *g_mix, *g_ffn2, *w_in, *g_qn, *g_kn, *sink, *w_four, *w_out, *w1g, *w1u, *w1d, *w2g, *w2u, *w2d, *g_final;
    float* out; unsigned char* ws;
};
typedef const __attribute__((address_space(4))) Params* KP;

namespace pg8 {
#define PG8_LAS __attribute__((address_space(3)))
typedef unsigned short bf16_t;
typedef short bf16x8 __attribute__((ext_vector_type(8)));
typedef float f32x4 __attribute__((ext_vector_type(4)));
typedef unsigned u32x4 __attribute__((ext_vector_type(4)));
constexpr int BM = 256, BK = 64, HALF = 128, HTB = HALF * BK * 2  , STAGE_BYTES = 8 * HTB, NXCD = 8, WGM = 8;

__host__ __device__ __forceinline__ int lds_byte(int r, int c) { const int st = (r >> 4) * 2 + (c >> 5), rr = r & 15, cc = c & 31, ob = rr * 64 + cc * 2; return st * 1024 + (ob ^ (((ob >> 9) & 1) << 5)); }
__host__ __device__ __forceinline__ void stage_rc(int b, int& R, int& C) { const int st = b / 1024, sb = b % 1024, swz = sb ^ (((sb >> 9) & 1) << 5); R = (st >> 1) * 16 + swz / 64; C = (st & 1) * 32 + (swz % 64) / 2; }
__host__ __device__ __forceinline__ int perm32(int rho) { const int n = rho >> 4, i = rho & 15; return 8 * (i >> 2) + 4 * n + (i & 3); }

struct Unit { int pm, pn, ko; };
struct Gemm { const bf16_t* A; const bf16_t* Bt; int M, N, K, ld, blocked; };

struct StaticOrder {
    int nM, nN, nwg, G, c;
    __host__ __device__ void init(int M, int N, int G_, int c_) { nM = M / BM; nN = N / BM; nwg = nM * nN; G = G_; c = c_; }
    __host__ __device__ bool next(int i, Unit& u) const {
        const long L = (long)i * G + c; if (L >= nwg) return false;
        int wgid = (int)L; { const int q = nwg / NXCD, r = nwg % NXCD, xcd = wgid % NXCD, off = wgid / NXCD; wgid = (xcd < r ? xcd * (q + 1) : r * (q + 1) + (xcd - r) * q) + off; }
        const int nig = WGM * nN, gid = wgid / nig, fm = gid * WGM, gsz = (nM - fm) < WGM ? (nM - fm) : WGM;
        u.pm = fm + ((wgid % nig) % gsz); u.pn = (wgid % nig) / gsz; return true;
    }
    __device__ __forceinline__ void a_ready(const Unit&) const {}
    __device__ __forceinline__ void done(const Unit&) const {}
};

struct SplitOrder {
    int mode, nchunk, kchunk; StaticOrder S;
    __device__ void init(int mode_, int Mrows, int N, int G, int c, int nchunk_, int kchunk_) { mode = mode_; nchunk = nchunk_; kchunk = kchunk_; S.init(mode_ == 1 ? 64 * BM : Mrows, N, G, c); }
    __device__ bool next(int i, Unit& u) const {
        if (mode == 2) { const long L = (long)i * S.G + S.c; if (L >= 8 * nchunk) return false; const int un = (int)L / nchunk, ch = (int)L - un * nchunk;
            u.pm = (un >> 2) ? 65 : 32; u.pn = un & 3; u.ko = ch * kchunk; return true; }
        if (!S.next(i, u)) return false;
        u.ko = 0; if (mode == 1) u.pm += u.pm >> 5;
        return true;
    }
    __device__ __forceinline__ void a_ready(const Unit&) const {}
    __device__ __forceinline__ void done(const Unit&) const {}
};

__device__ __forceinline__ unsigned cvt_pk_bf16(float lo, float hi) { unsigned r; asm("v_cvt_pk_bf16_f32 %0, %1, %2" : "=v"(r) : "v"(lo), "v"(hi)); return r; }
__device__ __forceinline__ int tile_w(int pm) { const int b = pm / 33, wi = pm - b * 33; return wi == 32 ? 2 : b; }
struct EpiSwiglu {
    static constexpr bool PERM = false, AFTER_DRAIN = false;
    bf16_t* O;
    __device__ __forceinline__ void operator()(const f32x4 (&acc)[2][2][4][2], const Unit& u, int wr, int wc, int fr, int fq) const {
        const int row0 = u.pm * BM + wr * 64 + fr, col = u.pn * 128 + wc * 32 + fq * 8;
#pragma unroll
        for (int ai = 0; ai < 2; ++ai)
#pragma unroll
            for (int m = 0; m < 4; ++m) {
                const f32x4 g0 = acc[ai][0][m][0], u0 = acc[ai][1][m][0], g1 = acc[ai][0][m][1], u1 = acc[ai][1][m][1];
                u32x4 w;
                w.x = cvt_pk_bf16(silu_f(g0[0]) * u0[0], silu_f(g0[1]) * u0[1]); w.y = cvt_pk_bf16(silu_f(g0[2]) * u0[2], silu_f(g0[3]) * u0[3]);
                w.z = cvt_pk_bf16(silu_f(g1[0]) * u1[0], silu_f(g1[1]) * u1[1]); w.w = cvt_pk_bf16(silu_f(g1[2]) * u1[2], silu_f(g1[3]) * u1[3]);
                *(u32x4*)(O + (size_t)u.pm * BM * DFF + (size_t)(col >> 6) * (BM * 64) + (size_t)(wr * 64 + fr + ai * HALF + m * 16) * 64 + (col & 63)) = w;
            }
    }
};
struct EpiRes {
    static constexpr bool PERM = false, AFTER_DRAIN = false;
    float* H; const float* MODl; int gate_chunk; float coef; float* PART;
    __device__ __forceinline__ void operator()(const f32x4 (&acc)[2][2][4][2], const Unit& u, int wr, int wc, int fr, int fq) const {
        const float* gate = MODl + tile_w(u.pm) * NMOD + gate_chunk * 1024;
        const bool part = u.ko != 0;
        float* base = part ? PART + ((size_t)((u.ko >> 8) - 1) * 512 + (u.pm == 32 ? 0 : 256) + wr * 64 + fr) * DM : H + (size_t)(u.pm * BM + wr * 64 + fr) * DM;
#pragma unroll
        for (int bj = 0; bj < 2; ++bj)
#pragma unroll
            for (int n = 0; n < 2; ++n) {
                const int col = u.pn * BM + bj * HALF + wc * 32 + n * 16 + fq * 4;
                const f32x4 gv = *(const f32x4*)(gate + col) * coef;
                f32x4 old[2][4];
#pragma unroll
                for (int ai = 0; ai < 2; ++ai)
#pragma unroll
                    for (int m = 0; m < 4; ++m) old[ai][m] = part ? (f32x4){0.f, 0.f, 0.f, 0.f} : *(const f32x4*)(base + (size_t)(ai * HALF + m * 16) * DM + col);
#pragma unroll
                for (int ai = 0; ai < 2; ++ai)
#pragma unroll
                    for (int m = 0; m < 4; ++m) *(f32x4*)(base + (size_t)(ai * HALF + m * 16) * DM + col) = old[ai][m] + gv * acc[ai][bj][m][n];
            }
    }
};
struct EpiWin {
    static constexpr bool PERM = false, AFTER_DRAIN = false;
    const float* gqn; const float* gkn; const float* ROPE;
    bf16_t *QA, *QB, *KA, *KB, *VTA, *VTB; unsigned *VS, *VC;
    __device__ __forceinline__ void operator()(const f32x4 (&acc)[2][2][4][2], const Unit& u, int wr, int wc, int fr, int fq) const {
        const int unit = u.pn * 4 + wc;
        const int b = u.pm / 33, wi = u.pm - b * 33; const bool lat = wi < 32; const int t0 = wi * 256;
        if (unit < 20) {
            const bool isB = unit >= 10; const int ul = isB ? unit - 10 : unit;
            const bool isq = ul < 6, isk = ul >= 6 && ul < 8;
            f32x4 gg[2][2];
            if (isB && (isq || isk)) { const float* g = isq ? gqn : gkn;
#pragma unroll
                for (int bj = 0; bj < 2; ++bj)
#pragma unroll
                    for (int n = 0; n < 2; ++n) gg[bj][n] = *(const f32x4*)(g + 32 * bj + 16 * n + 4 * fq); }
#pragma unroll
            for (int ai = 0; ai < 2; ++ai)
#pragma unroll
                for (int m = 0; m < 4; ++m) {
                    const int t = t0 + ai * HALF + wr * 64 + m * 16 + fr; const size_t row = (size_t)b * RPB + t;
                    f32x4 v[2][2];
#pragma unroll
                    for (int bj = 0; bj < 2; ++bj)
#pragma unroll
                        for (int n = 0; n < 2; ++n) v[bj][n] = acc[ai][bj][m][n];
                    if (isB && (isq || isk)) {
                        float ss = 0.f;
#pragma unroll
                        for (int bj = 0; bj < 2; ++bj)
#pragma unroll
                            for (int n = 0; n < 2; ++n) ss += (v[bj][n][0] * v[bj][n][0] + v[bj][n][1] * v[bj][n][1]) + (v[bj][n][2] * v[bj][n][2] + v[bj][n][3] * v[bj][n][3]);
                        ss += __shfl_xor(ss, 16); ss += __shfl_xor(ss, 32);
                        const float r = rsqrtf(ss * (1.f / 64.f) + 1e-6f);
#pragma unroll
                        for (int bj = 0; bj < 2; ++bj)
#pragma unroll
                            for (int n = 0; n < 2; ++n) v[bj][n] = v[bj][n] * r * gg[bj][n];
                    }
                    if (lat && (isq || isk)) {
#pragma unroll
                        for (int bj = 0; bj < 2; ++bj) {
                            const int p = bj == 0 ? (t >> 6) : 128 + (t & 63);
                            const f32x4 cs0 = *(const f32x4*)(ROPE + (p * 16 + 4 * fq) * 2), cs1 = *(const f32x4*)(ROPE + (p * 16 + 4 * fq) * 2 + 4);
                            const f32x4 cv = {cs0[0], cs0[2], cs1[0], cs1[2]}, sv = {cs0[1], cs0[3], cs1[1], cs1[3]};
                            const f32x4 a = v[bj][0], bb = v[bj][1];
                            v[bj][0] = a * cv - bb * sv; v[bj][1] = bb * cv + a * sv;
                        }
                    }
                    if (isq || isk) {
                        const float sc = isq ? QSCALE : 1.f;
                        bf16_t* dst = isq ? ((isB ? QB : QA) + row * 384 + ul * 64) : ((isB ? KB : KA) + row * 128 + (ul - 6) * 64);
#pragma unroll
                        for (int bj = 0; bj < 2; ++bj)
#pragma unroll
                            for (int n = 0; n < 2; ++n) { const f32x4 x = v[bj][n] * sc; uint2 w; w.x = cvt_pk_bf16(x[0], x[1]); w.y = cvt_pk_bf16(x[2], x[3]);
                                *(uint2*)(dst + 32 * bj + 16 * n + 4 * fq) = w; }
                    } else {
                        bf16_t* dst = (isB ? VTB : VTA) + ((size_t)(b * 2 + (ul - 8)) * 64) * RPB + t;
#pragma unroll
                        for (int bj = 0; bj < 2; ++bj)
#pragma unroll
                            for (int n = 0; n < 2; ++n)
#pragma unroll
                                for (int i = 0; i < 4; ++i) dst[(size_t)(32 * bj + 16 * n + 4 * fq + i) * RPB] = f2bf(v[bj][n][i]);
                    }
                }
        } else {
            const int chb = ((unit - 20) >> 1) * 64 + 32 * ((unit - 20) & 1);
#pragma unroll
            for (int ai = 0; ai < 2; ++ai)
#pragma unroll
                for (int m = 0; m < 4; ++m) {
                    const int t = t0 + ai * HALF + wr * 64 + m * 16 + fr;
#pragma unroll
                    for (int bj = 0; bj < 2; ++bj)
#pragma unroll
                        for (int n = 0; n < 2; ++n) {
                            const f32x4 x = acc[ai][bj][m][n]; const int ch = chb + 16 * bj + 8 * n + 2 * fq;
                            const unsigned w0 = cvt_pk_bf16(x[0], x[1]), w1 = cvt_pk_bf16(x[2], x[3]);
                            if (lat) { unsigned* d = VS + ((size_t)(b * SEQ + t) * 256 + ch); d[0] = w0; d[1] = w1; }
                            else { unsigned* d = VC + ((size_t)(b * 256 + (t - SEQ)) * 256 + ch); d[0] = w0; d[1] = w1; }
                        }
                }
        }
    }
};

struct EpiAll {
    static constexpr bool PERM = false, AFTER_DRAIN = false;
    unsigned char* ws; const float* gqn; const float* gkn; int mode, l, chunk; float coef;
    __device__ __forceinline__ void operator()(const f32x4 (&acc)[2][2][4][2], const Unit& u, int wr, int wc, int fr, int fq) const {
        if (mode == 0) { EpiSwiglu E{(bf16_t*)(ws + WS_MID)}; E(acc, u, wr, wc, fr, fq); }
        else if (mode == 1) { EpiRes E{(float*)(ws + WS_H), (const float*)(ws + WS_MOD) + (size_t)l * 3 * NMOD, chunk, coef, (float*)(ws + WS_PART)}; E(acc, u, wr, wc, fr, fq); }
        else { EpiWin E{gqn, gkn, (const float*)(ws + WS_TAB) + TAB_ROPE, (bf16_t*)(ws + WS_QA), (bf16_t*)(ws + WS_QB), (bf16_t*)(ws + WS_KA), (bf16_t*)(ws + WS_KB),
                        (bf16_t*)(ws + WS_VTA), (bf16_t*)(ws + WS_VTB), (unsigned*)(ws + WS_VS), (unsigned*)(ws + WS_VC)}; E(acc, u, wr, wc, fr, fq); }
    }
};

template <class Epi, class Sched, bool ALIGN_EPI = false, bool SP2 = false>
__device__ __forceinline__ void gemm_phase(PG8_LAS unsigned char* lds, const Gemm g, const Sched& S, const Epi& E) {
    int tid_ = threadIdx.x; asm volatile("" : "+v"(tid_)); const int tid = tid_, wid = __builtin_amdgcn_readfirstlane(tid >> 6), lane = tid & 63, wr = wid >> 2, wc = wid & 3, fr = lane & 15, fq = lane >> 4;
    const int K = g.K, nt = K / BK, LD = g.blocked ? BK : g.ld;
    unsigned voffA[2], voffB[2];
#pragma unroll
    for (int i = 0; i < 2; ++i) { int R, C; stage_rc(tid * 16 + i * 8192, R, C); const int Rb = Epi::PERM ? ((R & ~31) + perm32(R & 31)) : R;
        voffA[i] = (unsigned)(R * LD + C) * 2u; voffB[i] = (unsigned)(Rb * LD + C) * 2u; }
    const size_t kstep = g.blocked ? (size_t)(BM * BK * 2) : (size_t)(BK * 2);
    const size_t hstep = (size_t)HALF * LD * 2;
    const size_t tstep = g.blocked ? (size_t)BM * g.ld * 2 : 2 * hstep;
    const unsigned ldsw = (unsigned)wid * 1024u;
    const int aoff = lds_byte(wr * 64 + fr, fq * 8), boff = lds_byte(wc * 32 + fr, fq * 8);
#define PG8_SA(b, h) (((b) * 2 + (h)) * HTB)
#define PG8_SB(b, h) ((4 + (b) * 2 + (h)) * HTB)
#define PG8_STAGE(bufoff, gbase, voff) do { _Pragma("unroll") for (int _i = 0; _i < 2; ++_i) \
        __builtin_amdgcn_global_load_lds((const unsigned*)((const char*)(gbase) + (voff)[_i]), (PG8_LAS unsigned*)(lds + (bufoff) + ldsw + _i * 8192), 16, 0, 0); } while (0)
#define PG8_LDA(dst, b, h) do { _Pragma("unroll") for (int m = 0; m < 4; ++m) _Pragma("unroll") for (int k = 0; k < 2; ++k) dst[m][k] = *(const PG8_LAS bf16x8*)(lds + PG8_SA(b, h) + aoff + m * 2048 + k * 1024); } while (0)
#define PG8_LDB(dst, b, h) do { _Pragma("unroll") for (int n = 0; n < 2; ++n) _Pragma("unroll") for (int k = 0; k < 2; ++k) dst[n][k] = *(const PG8_LAS bf16x8*)(lds + PG8_SB(b, h) + boff + n * 2048 + k * 1024); } while (0)
#define PG8_MMA(ai, bj, At, Bt) do { __builtin_amdgcn_s_setprio(1); _Pragma("unroll") for (int m = 0; m < 4; ++m) _Pragma("unroll") for (int n = 0; n < 2; ++n) _Pragma("unroll") for (int k = 0; k < 2; ++k) \
        acc[ai][bj][m][n] = __builtin_amdgcn_mfma_f32_16x16x32_bf16(Bt[n][k], At[m][k], acc[ai][bj][m][n], 0, 0, 0); __builtin_amdgcn_s_setprio(0); } while (0)
#define PG8_WAIT_V(n) asm volatile("s_waitcnt vmcnt(" #n ")" ::: "memory")
#define PG8_WAIT_L(n) asm volatile("s_waitcnt lgkmcnt(" #n ")" ::: "memory")
#define PG8_BAR __builtin_amdgcn_s_barrier()
#define PG8_SCHED __builtin_amdgcn_sched_barrier(0)
    Unit cur, nxt; int ui = 0;
    if (!S.next(0, cur)) return;
    f32x4 acc[2][2][4][2];
#pragma unroll
    for (int a = 0; a < 2; ++a)
#pragma unroll
        for (int b = 0; b < 2; ++b)
#pragma unroll
            for (int m = 0; m < 4; ++m)
#pragma unroll
                for (int n = 0; n < 2; ++n) acc[a][b][m][n] = (f32x4){0.f, 0.f, 0.f, 0.f};
    bf16x8 At[4][2], B0[2][2], B1[2][2];
    const char* cA = (const char*)g.A + (size_t)cur.pm * tstep + (size_t)(cur.ko / BK) * kstep; const char* cB = (const char*)g.Bt + (size_t)cur.pn * tstep + (size_t)(cur.ko / BK) * kstep;
    S.a_ready(cur);
    if constexpr (SP2) {
        PG8_STAGE(PG8_SB(0, 0), cB, voffB); PG8_STAGE(PG8_SB(0, 1), cB + hstep, voffB); PG8_STAGE(PG8_SA(0, 0), cA, voffA); PG8_STAGE(PG8_SA(0, 1), cA + hstep, voffA);
        if (wr == 1) PG8_BAR;
        PG8_WAIT_V(2); PG8_BAR;
        PG8_STAGE(PG8_SB(1, 0), cB + kstep, voffB); PG8_STAGE(PG8_SA(1, 0), cA + kstep, voffA); PG8_STAGE(PG8_SB(1, 1), cB + hstep + kstep, voffB);
        PG8_WAIT_V(6); PG8_BAR;
    } else {
        PG8_STAGE(PG8_SB(0, 0), cB, voffB); PG8_STAGE(PG8_SA(0, 0), cA, voffA); PG8_STAGE(PG8_SB(0, 1), cB + hstep, voffB); PG8_STAGE(PG8_SA(0, 1), cA + hstep, voffA);
        if (wr == 1) PG8_BAR;
        PG8_WAIT_V(4); PG8_BAR;
        PG8_STAGE(PG8_SB(1, 0), cB + kstep, voffB); PG8_STAGE(PG8_SA(1, 0), cA + kstep, voffA); PG8_STAGE(PG8_SB(1, 1), cB + hstep + kstep, voffB);
        PG8_WAIT_V(6); PG8_BAR;
    }
    for (;;) {
        const bool has_next = S.next(ui + 1, nxt);
        const char* nA = has_next ? (const char*)g.A + (size_t)nxt.pm * tstep + (size_t)(nxt.ko / BK) * kstep : cA; const char* nB = has_next ? (const char*)g.Bt + (size_t)nxt.pn * tstep + (size_t)(nxt.ko / BK) * kstep : cB;
        for (int t = 0; t < nt; t += 2) {
            const bool last = (t == nt - 2);
            const char* a1 = cA + (size_t)(t + 1) * kstep;
            const char* a2 = last ? nA : cA + (size_t)(t + 2) * kstep; const char* b2 = last ? nB : cB + (size_t)(t + 2) * kstep;
            const char* a3 = a2 + kstep; const char* b3 = b2 + kstep;
            if (last && has_next) S.a_ready(nxt);
            if constexpr (SP2) {
            PG8_LDB(B0, 0, 0); PG8_LDB(B1, 0, 1); PG8_SCHED; PG8_LDA(At, 0, 0); PG8_STAGE(PG8_SA(1, 1), a1 + hstep, voffA);
            PG8_WAIT_V(8); PG8_WAIT_L(0); PG8_BAR; PG8_MMA(0, 0, At, B0); PG8_MMA(0, 1, At, B1); PG8_BAR; PG8_SCHED;
            PG8_LDA(At, 0, 1); PG8_STAGE(PG8_SB(0, 0), b2, voffB); PG8_STAGE(PG8_SB(0, 1), b2 + hstep, voffB); PG8_STAGE(PG8_SA(0, 0), a2, voffA);
            PG8_WAIT_V(8); PG8_WAIT_L(0); PG8_BAR; PG8_MMA(1, 0, At, B0); PG8_MMA(1, 1, At, B1); PG8_BAR; PG8_SCHED;
            PG8_LDB(B0, 1, 0); PG8_LDB(B1, 1, 1); PG8_SCHED; PG8_LDA(At, 1, 0); PG8_STAGE(PG8_SA(0, 1), a2 + hstep, voffA);
            PG8_WAIT_V(8); PG8_WAIT_L(0); PG8_BAR; PG8_MMA(0, 0, At, B0); PG8_MMA(0, 1, At, B1); PG8_BAR; PG8_SCHED;
            PG8_LDA(At, 1, 1); PG8_STAGE(PG8_SB(1, 0), b3, voffB); PG8_STAGE(PG8_SB(1, 1), b3 + hstep, voffB); PG8_STAGE(PG8_SA(1, 0), a3, voffA);
            PG8_WAIT_V(8); PG8_WAIT_L(0); PG8_BAR; PG8_MMA(1, 0, At, B0); PG8_MMA(1, 1, At, B1); PG8_BAR; PG8_SCHED;
            } else {
            PG8_LDB(B0, 0, 0); PG8_SCHED; PG8_LDA(At, 0, 0); PG8_STAGE(PG8_SA(1, 1), a1 + hstep, voffA);
            PG8_WAIT_L(8); PG8_BAR; PG8_WAIT_L(0); PG8_MMA(0, 0, At, B0); PG8_BAR; PG8_SCHED;
            PG8_LDB(B1, 0, 1); PG8_STAGE(PG8_SB(0, 0), b2, voffB);
            PG8_BAR; PG8_WAIT_L(0); PG8_MMA(0, 1, At, B1); PG8_BAR;
            PG8_LDA(At, 0, 1); PG8_STAGE(PG8_SA(0, 0), a2, voffA);
            PG8_BAR; PG8_WAIT_L(0); PG8_MMA(1, 0, At, B0); PG8_BAR; PG8_SCHED;
            PG8_STAGE(PG8_SB(0, 1), b2 + hstep, voffB);
            PG8_WAIT_V(6); PG8_BAR; PG8_MMA(1, 1, At, B1); PG8_BAR;
            PG8_LDB(B0, 1, 0); PG8_SCHED; PG8_LDA(At, 1, 0); PG8_STAGE(PG8_SA(0, 1), a2 + hstep, voffA);
            PG8_WAIT_L(8); PG8_BAR; PG8_WAIT_L(0); PG8_MMA(0, 0, At, B0); PG8_BAR; PG8_SCHED;
            PG8_LDB(B1, 1, 1); PG8_STAGE(PG8_SB(1, 0), b3, voffB);
            PG8_BAR; PG8_WAIT_L(0); PG8_MMA(0, 1, At, B1); PG8_BAR;
            PG8_LDA(At, 1, 1); PG8_STAGE(PG8_SA(1, 0), a3, voffA);
            PG8_BAR; PG8_WAIT_L(0); PG8_MMA(1, 0, At, B0); PG8_BAR; PG8_SCHED;
            PG8_STAGE(PG8_SB(1, 1), b3 + hstep, voffB);
            PG8_WAIT_V(6); PG8_BAR; PG8_MMA(1, 1, At, B1); PG8_BAR;
            }
        }
        if constexpr (ALIGN_EPI) { if (wr == 0) PG8_BAR; }
        if constexpr (!Epi::AFTER_DRAIN) { E(acc, cur, wr, wc, fr, fq); S.done(cur); }
        if (!has_next) break;
#pragma unroll
        for (int a = 0; a < 2; ++a)
#pragma unroll
            for (int b = 0; b < 2; ++b)
#pragma unroll
                for (int m = 0; m < 4; ++m)
#pragma unroll
                    for (int n = 0; n < 2; ++n) acc[a][b][m][n] = (f32x4){0.f, 0.f, 0.f, 0.f};
        cur = nxt; cA = nA; cB = nB; ++ui;
        if constexpr (ALIGN_EPI) { if (wr == 1) PG8_BAR; }
    }
    PG8_WAIT_V(0);
    if constexpr (!ALIGN_EPI) { if (wr == 0) PG8_BAR; }
    PG8_BAR;
    if constexpr (Epi::AFTER_DRAIN) { E.fused(acc, cur, wr, wc, fr, fq, lds, wid, lane); S.done(cur); }
#undef PG8_SA
#undef PG8_SB
#undef PG8_STAGE
#undef PG8_LDA
#undef PG8_LDB
#undef PG8_MMA
#undef PG8_WAIT_V
#undef PG8_WAIT_L
#undef PG8_BAR
#undef PG8_SCHED
}
}
#define FAST_ATTN 1
#define FAST_FFT 1
#define LAS __attribute__((address_space(3)))
__device__ __forceinline__ float wave_sum(float v) {
#pragma unroll
    for (int o = 1; o < 64; o <<= 1) v += __shfl_xor(v, o);
    return v;
}
__device__ __forceinline__ void tr_write(const LAS float* scr, bf16_t* Bt, int ldk, int k0, int P0, int P1, int P2, int P3, int lane) {
    const int c = lane & 7, nl = lane >> 3;
#pragma unroll
    for (int j = 0; j < 4; ++j) { const int n = nl + 8 * j; const LAS float* s = scr + (8 * c) * 33 + n; const int P = j == 0 ? P0 : j == 1 ? P1 : j == 2 ? P2 : P3;
        uint4 o; o.x = pk2(s[0], s[33]); o.y = pk2(s[2 * 33], s[3 * 33]); o.z = pk2(s[4 * 33], s[5 * 33]); o.w = pk2(s[6 * 33], s[7 * 33]);
        *(uint4*)(Bt + (size_t)P * ldk + k0 + 8 * c) = o; }
    asm volatile("s_waitcnt lgkmcnt(0)" ::: "memory");
}
__device__ __forceinline__ void tr_load(LAS float* scr, const float* W, int ldw, int k0, int col0, int lane) {
    float v[32];
#pragma unroll
    for (int i = 0; i < 32; ++i) v[i] = W[(size_t)(k0 + 2 * i + (lane >> 5)) * ldw + col0 + (lane & 31)];
#pragma unroll
    for (int i = 0; i < 32; ++i) scr[(2 * i + (lane >> 5)) * 33 + (lane & 31)] = v[i];
    asm volatile("s_waitcnt lgkmcnt(0)" ::: "memory");
}
__device__ __forceinline__ int perm_gu(int j, int t) { const int jj = j & 127; return 256 * (j >> 7) + 128 * t + 32 * (jj >> 5) + 16 * ((jj & 7) >> 2) + 4 * ((jj & 31) >> 3) + (jj & 3); }
__device__ __forceinline__ int perm_in(int u, int d) { return 256 * (u >> 2) + 32 * (u & 3) + 128 * (d >> 5) + (d & 31); }

__device__ __forceinline__ void prologue_phase(KP P, LAS unsigned char* lds) {
    int tid_ = threadIdx.x, bid_ = blockIdx.x; asm volatile("" : "+v"(tid_)); asm volatile("" : "+s"(bid_));
    const int tid = tid_, lane = tid & 63, wave = tid >> 6, bid = bid_, G = gridDim.x;
    float* MOD = (float*)(P->ws + WS_MOD); float* TAB = (float*)(P->ws + WS_TAB);
    LAS float* cs64 = (LAS float*)(lds + 8 * 8448);
    LAS unsigned* ctr = (LAS unsigned*)(lds + 8 * 8448 + 256);
    if (tid < 64) cs64[tid] = cospif((float)tid / 32.f);
    if (tid == 64) ctr[0] = 0u;
    {
        const int i = bid * 512 + tid;
        if (i < 8192) TAB[TAB_COS + i] = cospif((float)i / 4096.f);
        else if (i < 8192 + 3072) { const int e = i - 8192, p = e / 16, k = e % 16; const float inv = powf(10000.f, -(float)(2 * k) / 32.f);
            const float ang = (float)(p < 128 ? p : p - 128) * inv; TAB[TAB_ROPE + e * 2] = cosf(ang); TAB[TAB_ROPE + e * 2 + 1] = sinf(ang); }
        else if (i < 8192 + 3072 + 16384) { const int e = i - 8192 - 3072, mrow = e >> 7, kcol = e & 127; const int k1 = mrow >> 1, ro = mrow & 1, l1 = kcol >> 1, ri = kcol & 1;
            const int j = (k1 * l1) & 63; const float cv = cospif((float)j / 32.f), sv = sinpif((float)j / 32.f);
            const float v = (ro == ri) ? cv : (ro == 0 ? sv : -sv);
            ((bf16_t*)(P->ws + WS_TAB + TAB_D1_BYTES))[e] = f2bf(v); }
        else if (i < 8192 + 3072 + 16384 + 32768) { const int e = i - 8192 - 3072 - 16384, k2 = e >> 8, kcol = e & 255, l2 = kcol >> 1, ri = kcol & 1;
            const int j = (k2 * l2) & 127; const float v = ri == 0 ? cospif((float)j / 64.f) : sinpif((float)j / 64.f);
            ((bf16_t*)(P->ws + WS_TAB + TAB_D3_BYTES))[e] = f2bf(v); }
    }
    {
        LAS float* sv = (LAS float*)lds;
        LAS float* red = (LAS float*)(lds + 12288);
        for (int i = tid; i < 1024; i += 512) { sv[i] = silu_f(P->c[i]); sv[1024 + i] = silu_f(P->c[1024 + i]); sv[2048 + i] = silu_f(P->cctx[i]); }
        __syncthreads();
        for (int it = bid; it < 256; it += G) {
            const int l = it >> 7, n0 = (it & 127) * 72;
            const float* W = P->w_ada + (size_t)l * 1024 * NMOD + n0;
            float a0 = 0.f, a1 = 0.f, a2 = 0.f, e0 = 0.f, e1 = 0.f, e2 = 0.f;
            const int ks = wave * 128 + 16 * (lane >> 3);
#pragma unroll
            for (int j = 0; j < 16; ++j) { const float w = W[(size_t)(ks + j) * NMOD + 64 + (lane & 7)]; e0 += sv[ks + j] * w; e1 += sv[1024 + ks + j] * w; e2 += sv[2048 + ks + j] * w; }
#pragma unroll 32
            for (int k = wave * 128; k < wave * 128 + 128; ++k) { const float w = W[(size_t)k * NMOD + lane]; a0 += sv[k] * w; a1 += sv[1024 + k] * w; a2 += sv[2048 + k] * w; }
#pragma unroll
            for (int o = 8; o < 64; o <<= 1) { e0 += __shfl_xor(e0, o); e1 += __shfl_xor(e1, o); e2 += __shfl_xor(e2, o); }
            red[(wave * 3 + 0) * 72 + lane] = a0; red[(wave * 3 + 1) * 72 + lane] = a1; red[(wave * 3 + 2) * 72 + lane] = a2;
            if (lane < 8) { red[(wave * 3 + 0) * 72 + 64 + lane] = e0; red[(wave * 3 + 1) * 72 + 64 + lane] = e1; red[(wave * 3 + 2) * 72 + 64 + lane] = e2; }
            __syncthreads();
            if (tid < 216) { const int w = tid / 72, cc = tid - w * 72; float s = P->b_ada[l * NMOD + n0 + cc];
#pragma unroll
                for (int q = 0; q < 8; ++q) s += red[(q * 3 + w) * 72 + cc];
                MOD[(size_t)(l * 3 + w) * NMOD + n0 + cc] = s; }
            __syncthreads();
        }
    }
    {
        LAS float* scr = (LAS float*)(lds + wave * 8448);
        const int nl = lane >> 3;
        for (int hid = bid + G * wave; hid < 768 && wave < 8; hid += 8 * G) {
            const int l = hid / 384; int r = hid - l * 384;
            bf16_t* WT = (bf16_t*)(P->ws + WS_WT) + (size_t)l * WT_L;
            if (r < 256) {
                const int kb = r / 16, ob = r % 16;
                const int u = 20 + (ob >> 1), g = (u - 20) >> 1, half = (u - 20) & 1, q = (ob & 1) * 32 + (lane & 31);
                const int dch = 32 * half + (q >> 1), ri = q & 1;
                const float* W = P->w_in + (size_t)l * 1024 * DIN + 1280 + g * 64;
                float tw[64];
#pragma unroll
                for (int cc = 0; cc < 64; ++cc) { const int j = (cc * dch) & 63; tw[cc] = ri == 0 ? cs64[j] : -cs64[(j - 16) & 63]; }
                for (int i = 0; i < 32; ++i) { const int kk = 2 * i + (lane >> 5); const float4* w4 = (const float4*)(W + (size_t)(kb * 64 + kk) * DIN); float a = 0.f;
#pragma unroll
                    for (int c4 = 0; c4 < 16; ++c4) { const float4 wv = w4[c4]; a += wv.x * tw[4 * c4] + wv.y * tw[4 * c4 + 1] + wv.z * tw[4 * c4 + 2] + wv.w * tw[4 * c4 + 3]; }
                    scr[kk * 33 + (lane & 31)] = a; }
                asm volatile("s_waitcnt lgkmcnt(0)" ::: "memory");
                const int d = (ob & 1) * 32 + nl;
                tr_write(scr, WT + WT_IN, 1024, kb * 64, perm_in(u, d), perm_in(u, d + 8), perm_in(u, d + 16), perm_in(u, d + 24), lane);
            } else {
                r -= 256; const int g = r / 32, nb = r % 32;
                const float* wo = P->w_out + (size_t)l * 1024 * 1024 + (size_t)(768 + g * 64) * 1024 + nb * 32 + (lane & 31);
                const float* wf = P->w_four + (size_t)(l * 4 + g) * 4096;
                float wov[64];
#pragma unroll
                for (int d = 0; d < 64; ++d) wov[d] = wo[(size_t)d * 1024];
                for (int i = 0; i < 32; ++i) { const int kk = 2 * i + (lane >> 5); const float4* f4 = (const float4*)(wf + kk * 64); float a = 0.f;
#pragma unroll
                    for (int d4 = 0; d4 < 16; ++d4) { const float4 fv = f4[d4]; a += fv.x * wov[4 * d4] + fv.y * wov[4 * d4 + 1] + fv.z * wov[4 * d4 + 2] + fv.w * wov[4 * d4 + 3]; }
                    scr[kk * 33 + (lane & 31)] = a; }
                asm volatile("s_waitcnt lgkmcnt(0)" ::: "memory");
                const int j = nb * 32 + nl;
                tr_write(scr, WT + WT_OUT, 1024, 768 + g * 64, j, j + 8, j + 16, j + 24, lane);
            }
        }
        constexpr int NA = 4 * 1408, NBd = 2 * 1408, NC = 640, NE = 384, NL = NA + NBd + NC + NE;
        const int lo = (int)(((long)bid * (2 * NL)) / G), hi = (int)(((long)(bid + 1) * (2 * NL)) / G);
        for (;;) {
            unsigned iu = 0u; if (lane == 0) iu = __hip_atomic_fetch_add(ctr, 1u, __ATOMIC_RELAXED, __HIP_MEMORY_SCOPE_WORKGROUP);
            const int it = lo + (int)__builtin_amdgcn_readfirstlane(iu);
            if (it >= hi) break;
            const int l = it / NL; int r = it - l * NL;
            bf16_t* WT = (bf16_t*)(P->ws + WS_WT) + (size_t)l * WT_L;
            if (r < NA) { const int f = r / 2816, t = (r / 1408) & 1, q = r % 1408, kb = q / 88, nb = q % 88;
                const float* W = (f == 0 ? (t == 0 ? P->w1g : P->w1u) : (t == 0 ? P->w2g : P->w2u)) + (size_t)l * 1024 * DFF;
                tr_load(scr, W, DFF, kb * 64, nb * 32, lane);
                const int j = nb * 32 + nl;
                tr_write(scr, WT + WT_GU + (size_t)f * 5632 * 1024, 1024, kb * 64, perm_gu(j, t), perm_gu(j + 8, t), perm_gu(j + 16, t), perm_gu(j + 24, t), lane);
                continue; }
            r -= NA;
            if (r < NBd) { const int f = r / 1408, q = r % 1408, kb = q / 32, nb = q % 32;
                const float* W = (f == 0 ? P->w1d : P->w2d) + (size_t)l * DFF * 1024;
                tr_load(scr, W, 1024, kb * 64, nb * 32, lane);
                const int j = nb * 32 + nl;
                { bf16_t* Bd = WT + WT_DN + (size_t)f * 1024 * MIDP + (size_t)(j >> 8) * 256 * DFF + (size_t)kb * (256 * 64);
                  tr_write(scr, Bd, 64, 0, j & 255, (j + 8) & 255, (j + 16) & 255, (j + 24) & 255, lane); }
                continue; }
            r -= NBd;
            if (r < NC) { const int kb = r / 40, nb = r % 40;
                tr_load(scr, P->w_in + (size_t)l * 1024 * DIN, DIN, kb * 64, nb * 32, lane);
                const int u = nb >> 1, d = (nb & 1) * 32 + nl;
                tr_write(scr, WT + WT_IN, 1024, kb * 64, perm_in(u, d), perm_in(u, d + 8), perm_in(u, d + 16), perm_in(u, d + 24), lane);
                continue; }
            r -= NC;
            { const int kb = r / 32, nb = r % 32;
                tr_load(scr, P->w_out + (size_t)l * 1024 * 1024, 1024, kb * 64, nb * 32, lane);
                const int j = nb * 32 + nl;
                tr_write(scr, WT + WT_OUT, 1024, kb * 64, j, j + 8, j + 16, j + 24, lane); }
        }
    }
}
__device__ __forceinline__ void norm_phase(KP P, const float* g, const float* MODl, int shc, int scc, bool from_input, int npart) {
    int tid_ = threadIdx.x, bid_ = blockIdx.x; asm volatile("" : "+v"(tid_)); asm volatile("" : "+s"(bid_));
    const int lane = tid_ & 63, gw = bid_ * 8 + (tid_ >> 6), NGW = gridDim.x * 8;
    float* H = (float*)(P->ws + WS_H); bf16_t* XN = (bf16_t*)(P->ws + WS_XN);
    constexpr int RU = 3;
    for (int row0 = gw; row0 < M; row0 += RU * NGW) {
        float4 v[RU][4]; float ss[RU];
#pragma unroll
        for (int u = 0; u < RU; ++u) { const int row = row0 + u * NGW; ss[u] = 0.f;
            if (row < M) { const int b = row / RPB, t = row - b * RPB;
                const float4* h = from_input ? (t < SEQ ? (const float4*)(P->x + ((size_t)b * SEQ + t) * DM) : (const float4*)(P->ctx + ((size_t)b * CTXL + (t - SEQ)) * DM)) : (const float4*)(H + (size_t)row * DM);
#pragma unroll
                for (int j = 0; j < 4; ++j) v[u][j] = h[lane + 64 * j]; } }
#pragma unroll
        for (int u = 0; u < RU; ++u) { const int row = row0 + u * NGW;
            if (row < M) { const int b = row / RPB, t = row - b * RPB, w = t >= SEQ ? 2 : b;
                if (t >= SEQ && npart > 0) {
                    const float4* pp = (const float4*)(P->ws + WS_PART) + (size_t)(b * CTXL + (t - SEQ)) * 256 + lane;
                    for (int q = 0; q < npart; ++q) {
#pragma unroll
                        for (int j = 0; j < 4; ++j) { const float4 a = pp[(size_t)q * 512 * 256 + 64 * j]; v[u][j].x += a.x; v[u][j].y += a.y; v[u][j].z += a.z; v[u][j].w += a.w; } } }
#pragma unroll
                for (int j = 0; j < 4; ++j) ss[u] += v[u][j].x * v[u][j].x + v[u][j].y * v[u][j].y + v[u][j].z * v[u][j].z + v[u][j].w * v[u][j].w;
                if (from_input || (t >= SEQ && npart > 0)) {
#pragma unroll
                    for (int j = 0; j < 4; ++j) ((float4*)(H + (size_t)row * DM))[lane + 64 * j] = v[u][j]; }
                const float r = rsqrtf(wave_sum(ss[u]) * (1.f / DM) + 1e-6f);
                const float* sh = MODl + w * NMOD + shc * 1024; const float* sc = MODl + w * NMOD + scc * 1024;
#pragma unroll
                for (int j = 0; j < 4; ++j) { const int c = (lane + 64 * j) * 4; const float4 gg = *(const float4*)(g + c), s4 = *(const float4*)(sh + c), c4 = *(const float4*)(sc + c);
                    uint2 o; o.x = pk2(v[u][j].x * r * gg.x * (1.f + c4.x) + s4.x, v[u][j].y * r * gg.y * (1.f + c4.y) + s4.y);
                    o.y = pk2(v[u][j].z * r * gg.z * (1.f + c4.z) + s4.z, v[u][j].w * r * gg.w * (1.f + c4.w) + s4.w);
                    *(uint2*)(XN + (size_t)row * DM + c) = o; } } }
    }
}
__device__ __forceinline__ void final_phase(KP P) {
    int tid_ = threadIdx.x, bid_ = blockIdx.x; asm volatile("" : "+v"(tid_)); asm volatile("" : "+s"(bid_));
    const int lane = tid_ & 63, gw = bid_ * 8 + (tid_ >> 6), NGW = gridDim.x * 8;
    const float* H = (const float*)(P->ws + WS_H);
    for (int orow = gw; orow < NB * SEQ; orow += NGW) {
        const int b = orow / SEQ, t = orow - b * SEQ;
        const float4* h = (const float4*)(H + (size_t)(b * RPB + t) * DM);
        float4 v[4]; float ss = 0.f;
#pragma unroll
        for (int j = 0; j < 4; ++j) { v[j] = h[lane + 64 * j]; ss += v[j].x * v[j].x + v[j].y * v[j].y + v[j].z * v[j].z + v[j].w * v[j].w; }
        const float r = rsqrtf(wave_sum(ss) * (1.f / DM) + 1e-6f);
#pragma unroll
        for (int j = 0; j < 4; ++j) { const int c = (lane + 64 * j) * 4; const float4 gg = *(const float4*)(P->g_final + c);
            float4 o; o.x = v[j].x * r * gg.x; o.y = v[j].y * r * gg.y; o.z = v[j].z * r * gg.z; o.w = v[j].w * r * gg.w;
            *(float4*)(P->out + (size_t)orow * DM + c) = o; }
    }
}
template <class Epi> __device__ __forceinline__ void run_gemm(LAS unsigned char* lds, const bf16_t* A, const bf16_t* Bt, int N, int K, int lda, int blocked, int no_ctx, Epi E) {
    const int npass = (N == 1024 && !no_ctx) ? 2 : 1;
    for (int pass = 0; pass < npass; ++pass) {
        pg8::Gemm g{A, Bt, M, N, pass ? 256 : K, lda, blocked}; pg8::SplitOrder S; S.init((N == 1024 || no_ctx) ? 1 + pass : 0, M, N, (int)gridDim.x, (int)blockIdx.x, K / 256, 256);
        pg8::gemm_phase<Epi, pg8::SplitOrder, true, true>(lds, g, S, E);
    }
}

typedef float f32x16 __attribute__((ext_vector_type(16)));
typedef short bf16x8_t __attribute__((ext_vector_type(8)));
typedef short s16x4_t __attribute__((ext_vector_type(4)));
typedef unsigned u32x4_t __attribute__((ext_vector_type(4)));
typedef unsigned u32x2_t __attribute__((ext_vector_type(2)));
constexpr int AT_KBUF = 0, AT_VBUF = 32768, AT_VSTRIDE = 264, AT_VBYTES = 64 * AT_VSTRIDE, AT_COMB = AT_VBUF + 3 * AT_VBYTES, AT_COMB_PAIR = 34 * 64 * 4;
static_assert(AT_COMB + 4 * AT_COMB_PAIR <= 131072, "attention LDS map");
typedef float at_f32x2 __attribute__((ext_vector_type(2))); typedef __bf16 at_bf16x2 __attribute__((ext_vector_type(2)));
__device__ __forceinline__ unsigned cvtpk(float lo, float hi) { const at_f32x2 v = {lo, hi}; const at_bf16x2 b = __builtin_convertvector(v, at_bf16x2); return __builtin_bit_cast(unsigned, b); }

__device__ __forceinline__ void attn_unit(KP P, LAS unsigned char* lds, int l, int tid, int b, int hh, int q0, bool lat) {
    unsigned char* ws = P->ws;
    const int lane = tid & 63, r32 = lane & 31, hi = lane >> 5, wid = __builtin_amdgcn_readfirstlane(tid >> 6), g = wid >> 2, wq = wid & 3;
    const bool isB = hh >= 6; const int h = isB ? hh - 6 : hh, kvh = h / 3;
    const bf16_t* Q = (const bf16_t*)(ws + (isB ? WS_QB : WS_QA)) + ((size_t)b * RPB + q0 + 32 * wq + r32) * 384 + h * 64;
    const bf16_t* Kg = (const bf16_t*)(ws + (isB ? WS_KB : WS_KA)) + (size_t)b * RPB * 128 + kvh * 64;
    const bf16_t* Vg = (const bf16_t*)(ws + (isB ? WS_VTB : WS_VTA)) + ((size_t)(b * 2 + kvh) * 64) * RPB;
    int npre, kb_lo, nsteps;
    if (!lat) { npre = 2; kb_lo = 0; nsteps = 2; }
    else if (isB) { npre = 0; kb_lo = 0; nsteps = 66; }
    else { const int qb = q0 >> 7; kb_lo = qb > 0 ? qb - 1 : 0; const int kb_hi = qb < 63 ? qb + 1 : 63; npre = 2; nsteps = 2 + (kb_hi - kb_lo + 1); }
    const int kkey0 = tid >> 3, kc = tid & 7;
    const unsigned kdst0 = (unsigned)(kkey0 * 128 + ((kc ^ ((kkey0 >> 1) & 7)) * 16));
    const int vd0 = tid >> 4, vc = tid & 15;
    const unsigned vdst0 = (unsigned)(vd0 * AT_VSTRIDE + vc * 16);
    const bf16_t* kg0 = Kg + (size_t)kkey0 * 128 + kc * 8;
    const bf16_t* vg0 = Vg + (size_t)vd0 * RPB + vc * 8;
    u32x4_t pk0, pk1, pv0, pv1;
#define AT_KP0(s) ((s) < npre ? SEQ + 128 * (s) : 128 * (kb_lo + (s) - npre))
#define AT_LOADK(s) do { const int kp0_ = AT_KP0(s); pk0 = *(const u32x4_t*)(kg0 + (size_t)kp0_ * 128); pk1 = *(const u32x4_t*)(kg0 + (size_t)(kp0_ + 64) * 128); } while (0)
#define AT_LOADV(s) do { const int kp0_ = AT_KP0(s); pv0 = *(const u32x4_t*)(vg0 + kp0_); pv1 = *(const u32x4_t*)(vg0 + (size_t)32 * RPB + kp0_); } while (0)
#define AT_STOREK(buf) do { LAS unsigned char* kb_ = lds + AT_KBUF + (buf) * 16384; *(LAS u32x4_t*)(kb_ + kdst0) = pk0; *(LAS u32x4_t*)(kb_ + kdst0 + 8192) = pk1; } while (0)
#define AT_STOREV(buf) do { LAS unsigned char* vb_ = lds + AT_VBUF + (buf) * AT_VBYTES; \
        *(LAS u32x2_t*)(vb_ + vdst0) = (u32x2_t){pv0.x, pv0.y}; *(LAS u32x2_t*)(vb_ + vdst0 + 8) = (u32x2_t){pv0.z, pv0.w}; \
        *(LAS u32x2_t*)(vb_ + vdst0 + 32 * AT_VSTRIDE) = (u32x2_t){pv1.x, pv1.y}; *(LAS u32x2_t*)(vb_ + vdst0 + 32 * AT_VSTRIDE + 8) = (u32x2_t){pv1.z, pv1.w}; } while (0)
#define AT_QK_LD(buf) do { const LAS unsigned char* kb_ = lds + AT_KBUF + (buf) * 16384; \
        _Pragma("unroll") for (int d0 = 0; d0 < 4; ++d0) { kf[2 * d0] = *(const LAS bf16x8_t*)(kb_ + koff[d0]); kf[2 * d0 + 1] = *(const LAS bf16x8_t*)(kb_ + koff[d0] + 4096); } } while (0)
#define AT_QK_MMA(S0_, S1_) do { S0_ = __builtin_amdgcn_mfma_f32_32x32x16_bf16(kf[0], qf[0], negm, 0, 0, 0); S1_ = __builtin_amdgcn_mfma_f32_32x32x16_bf16(kf[1], qf[0], negm, 0, 0, 0); \
        _Pragma("unroll") for (int d0 = 1; d0 < 4; ++d0) { \
            S0_ = __builtin_amdgcn_mfma_f32_32x32x16_bf16(kf[2 * d0], qf[d0], S0_, 0, 0, 0); S1_ = __builtin_amdgcn_mfma_f32_32x32x16_bf16(kf[2 * d0 + 1], qf[d0], S1_, 0, 0, 0); } } while (0)
#define AT_QK(S0_, S1_, buf) do { AT_QK_LD(buf); __builtin_amdgcn_sched_barrier(0); AT_QK_MMA(S0_, S1_); } while (0)
    AT_LOADK(0); AT_LOADV(0);
    bf16x8_t qf[4], kf[8], vfr[8];
#pragma unroll
    for (int d0 = 0; d0 < 4; ++d0) qf[d0] = *(const bf16x8_t*)(Q + 16 * d0 + 8 * hi);
    const int key0 = 64 * g + r32; const int swz = (key0 >> 1) & 7;
    unsigned koff[4];
#pragma unroll
    for (int d0 = 0; d0 < 4; ++d0) koff[d0] = (unsigned)(key0 * 128 + (((2 * d0 + hi) ^ swz) * 16));
    const unsigned voff = (unsigned)(r32 * AT_VSTRIDE + 128 * g + 8 * hi);
    f32x16 O0 = {}, O1 = {};
    float m = 0.f, lsum = 0.f, pend = 0.f;
    f32x16 negm = {};
    constexpr float AT_THR = 8.f;
    const int qp = q0 + 32 * wq + r32;
    AT_STOREK(0); AT_STOREV(0);
    AT_LOADK(1);
    AT_STOREK(1);
    __syncthreads();
    f32x16 S0, S1;
    AT_QK(S0, S1, 0);
    __syncthreads();
#define AT_PV_LD(vs) do { const LAS unsigned char* vb_ = lds + AT_VBUF + (vs) * AT_VBYTES; \
        _Pragma("unroll") for (int sl = 0; sl < 4; ++sl) _Pragma("unroll") for (int dd = 0; dd < 2; ++dd) { \
            const u32x2_t lo = *(const LAS u32x2_t*)(vb_ + voff + dd * 32 * AT_VSTRIDE + 32 * sl), hi8 = *(const LAS u32x2_t*)(vb_ + voff + dd * 32 * AT_VSTRIDE + 32 * sl + 16); \
            const u32x4_t vw = {lo.x, lo.y, hi8.x, hi8.y}; vfr[2 * sl + dd] = __builtin_bit_cast(bf16x8_t, vw); } } while (0)
#define AT_PV_MMA() do { _Pragma("unroll") for (int sl = 0; sl < 4; ++sl) { const bf16x8_t pf = __builtin_bit_cast(bf16x8_t, pp[sl]); \
            O0 = __builtin_amdgcn_mfma_f32_32x32x16_bf16(vfr[2 * sl], pf, O0, 0, 0, 0); O1 = __builtin_amdgcn_mfma_f32_32x32x16_bf16(vfr[2 * sl + 1], pf, O1, 0, 0, 0); } } while (0)
#define AT_PV(vs) do { AT_PV_LD(vs); __builtin_amdgcn_sched_barrier(0); AT_PV_MMA(); } while (0)
    u32x4_t pp[4] = {};
    int vs_prev = 0, vs_cur = 0, vs_next = 1;
    for (int s = 0; s < nsteps; ++s) {
        if (s + 2 < nsteps) AT_LOADK(s + 2);
        if (s + 1 < nsteps) AT_LOADV(s + 1);
        f32x16 N0, N1;
        if (lat && !isB && s >= npre) {
            const int kpb = AT_KP0(s) + 64 * g + 4 * hi - qp;
#pragma unroll
            for (int r = 0; r < 16; ++r) { const int dlt = kpb + (r & 3) + 8 * (r >> 2);
                if (dlt > 128 || dlt < -128) S0[r] = -1e30f;
                if (dlt + 32 > 128 || dlt + 32 < -128) S1[r] = -1e30f; }
        }
        if (__any(pend != 0.f)) { S0 = S0 - pend; S1 = S1 - pend; }
        AT_QK_LD((s + 1) & 1);
        __builtin_amdgcn_sched_barrier(0);
        __builtin_amdgcn_s_setprio(1); AT_QK_MMA(N0, N1); __builtin_amdgcn_s_setprio(0);
        AT_PV_LD(vs_prev);
        __builtin_amdgcn_sched_barrier(0);
        __builtin_amdgcn_s_setprio(1); AT_PV_MMA(); __builtin_amdgcn_s_setprio(0);
        __builtin_amdgcn_sched_barrier(0);
        float rm = __builtin_fmaxf(__builtin_fmaxf(S0[0], S1[0]), S0[1]);
#pragma unroll
        for (int r = 1; r < 16; ++r) rm = __builtin_fmaxf(__builtin_fmaxf(rm, S1[r]), r < 15 ? S0[r + 1] : S1[r]);
        { const auto rr = __builtin_amdgcn_permlane32_swap(__float_as_uint(rm), __float_as_uint(rm), false, false); rm = fmaxf(__uint_as_float(rr[0]), __uint_as_float(rr[1])); }
        float alpha = 1.f; pend = 0.f;
        if (s == 0 || __any(rm > AT_THR)) {
            const float dl = s == 0 ? rm : fmaxf(rm, 0.f);
            S0 = S0 - dl; S1 = S1 - dl; negm = negm - dl; m += dl; pend = dl;
            alpha = __builtin_amdgcn_exp2f(-dl); lsum *= alpha;
        }
        float ps = 0.f;
#pragma unroll
        for (int r = 0; r < 16; ++r) { S0[r] = __builtin_amdgcn_exp2f(S0[r]); S1[r] = __builtin_amdgcn_exp2f(S1[r]); ps += S0[r] + S1[r]; }
        lsum += ps;
#pragma unroll
        for (int sl = 0; sl < 4; ++sl) { const int rb = 8 * (sl & 1);
            if (sl < 2) pp[sl] = (u32x4_t){cvtpk(S0[rb], S0[rb + 1]), cvtpk(S0[rb + 2], S0[rb + 3]), cvtpk(S0[rb + 4], S0[rb + 5]), cvtpk(S0[rb + 6], S0[rb + 7])};
            else pp[sl] = (u32x4_t){cvtpk(S1[rb], S1[rb + 1]), cvtpk(S1[rb + 2], S1[rb + 3]), cvtpk(S1[rb + 4], S1[rb + 5]), cvtpk(S1[rb + 6], S1[rb + 7])}; }
        __builtin_amdgcn_sched_barrier(0);
        if (__any(alpha != 1.f)) {
#pragma unroll
            for (int r = 0; r < 16; ++r) { O0[r] *= alpha; O1[r] *= alpha; } }
        if (s + 2 < nsteps) AT_STOREK(s & 1);
        if (s + 1 < nsteps) AT_STOREV(vs_next);
        __syncthreads();
        S0 = N0; S1 = N1;
        vs_prev = vs_cur; vs_cur = vs_next; vs_next = vs_next == 2 ? 0 : vs_next + 1;
    }
    AT_PV(vs_prev);
#undef AT_PV
#undef AT_PV_LD
#undef AT_PV_MMA
#undef AT_QK_LD
#undef AT_QK_MMA
#undef AT_LOADK
#undef AT_LOADV
#undef AT_STOREK
#undef AT_STOREV
#undef AT_QK
    float ltot = lsum + __shfl_xor(lsum, 32);
    LAS float* comb = (LAS float*)(lds + AT_COMB + wq * AT_COMB_PAIR);
    if (g == 1) {
        comb[lane] = m; comb[64 + lane] = ltot;
#pragma unroll
        for (int r = 0; r < 16; ++r) { comb[(2 + r) * 64 + lane] = O0[r]; comb[(18 + r) * 64 + lane] = O1[r]; }
    }
    __syncthreads();
    if (g == 0) {
        const float m1 = comb[lane], l1 = comb[64 + lane];
        float mf = fmaxf(m, m1); float sk = 0.f;
        if (!isB) { const float s2 = P->sink[l * 6 + h] * LOG2E; mf = fmaxf(mf, s2); sk = __builtin_amdgcn_exp2f(s2 - mf); }
        const float a0 = __builtin_amdgcn_exp2f(m - mf), a1 = __builtin_amdgcn_exp2f(m1 - mf);
        const float inv = 1.f / (ltot * a0 + l1 * a1 + sk);
        const float c0 = a0 * inv, c1 = a1 * inv;
        bf16_t* dst = (bf16_t*)(ws + WS_XN) + ((size_t)b * RPB + q0 + 32 * wq + r32) * DM + (isB ? 384 : 0) + h * 64 + 4 * hi;
#pragma unroll
        for (int rq = 0; rq < 4; ++rq) {
            float o[8];
#pragma unroll
            for (int i = 0; i < 4; ++i) { o[i] = O0[4 * rq + i] * c0 + comb[(2 + 4 * rq + i) * 64 + lane] * c1; o[4 + i] = O1[4 * rq + i] * c0 + comb[(18 + 4 * rq + i) * 64 + lane] * c1; }
            *(u32x2_t*)(dst + 8 * rq) = (u32x2_t){cvtpk(o[0], o[1]), cvtpk(o[2], o[3])};
            *(u32x2_t*)(dst + 32 + 8 * rq) = (u32x2_t){cvtpk(o[4], o[5]), cvtpk(o[6], o[7])};
        }
    }
    __syncthreads();
#undef AT_KP0
}
__device__ __forceinline__ void attn_phase(KP P, LAS unsigned char* lds, int l) {
    int tid_ = threadIdx.x, bid_ = blockIdx.x; asm volatile("" : "+v"(tid_)); asm volatile("" : "+s"(bid_));
    const int G = gridDim.x;
    const bool xcd = (G == 256);
    const int NU = 1536 + (l == 0 ? 48 : 0);
    for (int it = 0;; ++it) {
        int idx;
        if (xcd) { if (it >= 7) break; idx = it < 6 ? (it / 3) * 768 + (bid_ & 7) * 96 + (it % 3) * 32 + (bid_ >> 3) : 1536 + bid_; if (idx >= NU) break; }
        else { idx = bid_ + it * G; if (idx >= NU) break; }
        int b, hh, q0; bool lat = true;
        if (idx < 768) { b = idx / 384; hh = 6 + (idx % 384) / 64; q0 = (idx & 63) * 128; }
        else if (idx < 1536) { const int u = idx - 768; b = u / 384; hh = (u % 384) / 64; q0 = (u & 63) * 128; }
        else { const int u = idx - 1536; b = u / 24; hh = (u % 24) >> 1; q0 = SEQ + 128 * (u & 1); lat = false; }
        attn_unit(P, lds, l, tid_, b, hh, q0, lat);
    }
}

__device__ __forceinline__ void fft1_phase(KP P, int l) {
    int tid_ = threadIdx.x, bid_ = blockIdx.x; asm volatile("" : "+v"(tid_)); asm volatile("" : "+s"(bid_));
    unsigned char* ws = P->ws;
    const int lane = tid_ & 63, r32 = lane & 31, hi = lane >> 5, w = tid_ >> 6;
    const bf16_t* D1 = (const bf16_t*)(ws + WS_TAB + TAB_D1_BYTES); const float* TAB = (const float*)(ws + WS_TAB);
    for (int it = bid_; it < 256; it += gridDim.x) {
        const int b = it >> 7, l2 = it & 127, ch = 32 * w + r32;
        const unsigned* vsrc = (const unsigned*)(ws + WS_VS) + ((size_t)(b * SEQ + l2 + 512 * hi)) * 256 + ch;
        u32x4_t bfr[8];
#pragma unroll
        for (int s = 0; s < 8; ++s)
#pragma unroll
            for (int j = 0; j < 4; ++j) bfr[s][j] = vsrc[(size_t)(128 * (8 * s + j)) * 256];
        f32x16 acc[4] = {};
#pragma unroll
        for (int s = 0; s < 8; ++s) {
            const bf16x8_t bf = __builtin_bit_cast(bf16x8_t, bfr[s]);
#pragma unroll
            for (int mt = 0; mt < 4; ++mt) { const bf16x8_t af = *(const bf16x8_t*)(D1 + (32 * mt + r32) * 128 + 16 * s + 8 * hi);
                acc[mt] = __builtin_amdgcn_mfma_f32_32x32x16_bf16(af, bf, acc[mt], 0, 0, 0); }
        }
        unsigned* zs = (unsigned*)(ws + WS_ZS);
#pragma unroll
        for (int mt = 0; mt < 4; ++mt)
#pragma unroll
            for (int rq = 0; rq < 4; ++rq)
#pragma unroll
                for (int e = 0; e < 2; ++e) {
                    const int k1 = 16 * mt + 4 * rq + 2 * hi + e; const int idx = k1 * l2;
                    const float ct = TAB[TAB_COS + idx], st = TAB[TAB_COS + ((idx - 2048) & 8191)];
                    const float yr = acc[mt][4 * rq + 2 * e], yi = acc[mt][4 * rq + 2 * e + 1];
                    zs[((size_t)(b * 64 + k1) * 128 + l2) * 256 + ch] = cvtpk(yr * ct + yi * st, yi * ct - yr * st);
                }
    }
    if (l == 0) {
        const unsigned* VC = (const unsigned*)(ws + WS_VC); bf16_t* OM = (bf16_t*)(ws + WS_XN);
        for (int gt = bid_ * 512 + tid_; gt < NB * CTXL * 256; gt += gridDim.x * 512) {
            const int ch = gt & 255, k = (gt >> 8) & 255, b = gt >> 16;
            const unsigned* vp = VC + (size_t)(b * 256) * 256 + ch; float a = 0.f;
#pragma unroll 8
            for (int j = 0; j < 256; ++j) { const unsigned pk = vp[(size_t)j * 256]; const float vr = __uint_as_float(pk << 16), vi = __uint_as_float(pk & 0xffff0000u);
                const int ix = ((k * j) & 255) * 32; a += vr * TAB[TAB_COS + ix] + vi * TAB[TAB_COS + ((ix - 2048) & 8191)]; }
            OM[(size_t)(b * RPB + SEQ + k) * DM + 768 + ch] = f2bf(a * (1.f / 128.f));
        }
    }
}
__device__ __forceinline__ void fft3_phase(KP P, LAS unsigned char* lds, int l) {
    int tid_ = threadIdx.x, bid_ = blockIdx.x; asm volatile("" : "+v"(tid_)); asm volatile("" : "+s"(bid_));
    unsigned char* ws = P->ws;
    const int lane = tid_ & 63, r32 = lane & 31, hi = lane >> 5, w = tid_ >> 6;
    const bf16_t* D3 = (const bf16_t*)(ws + WS_TAB + TAB_D3_BYTES); bf16_t* OM = (bf16_t*)(ws + WS_XN);
    for (int it = bid_; it < 256; it += gridDim.x) {
        const int b = it >> 7, k1 = (it & 127) >> 1, chh = it & 1, ch = 32 * (4 * chh + (w & 3)) + r32, mh = w >> 2;
        const unsigned* zsrc = (const unsigned*)(ws + WS_ZS) + ((size_t)(b * 64 + k1) * 128 + 4 * hi) * 256 + ch;
        f32x16 acc[2] = {};
#pragma unroll
        for (int sh = 0; sh < 2; ++sh) {
            u32x4_t bfr[8];
#pragma unroll
            for (int s = 0; s < 8; ++s)
#pragma unroll
                for (int j = 0; j < 4; ++j) bfr[s][j] = zsrc[(size_t)(8 * (8 * sh + s) + j) * 256];
#pragma unroll
            for (int s = 0; s < 8; ++s) {
                const bf16x8_t bf = __builtin_bit_cast(bf16x8_t, bfr[s]);
#pragma unroll
                for (int mi = 0; mi < 2; ++mi) { const bf16x8_t af = *(const bf16x8_t*)(D3 + (32 * (2 * mh + mi) + r32) * 256 + 16 * (8 * sh + s) + 8 * hi);
                    acc[mi] = __builtin_amdgcn_mfma_f32_32x32x16_bf16(af, bf, acc[mi], 0, 0, 0); }
            }
        }
#pragma unroll
        for (int mi = 0; mi < 2; ++mi)
#pragma unroll
            for (int r = 0; r < 16; ++r) { const int k2 = 32 * (2 * mh + mi) + (r & 3) + 8 * (r >> 2) + 4 * hi;
                OM[((size_t)b * RPB + k1 + 64 * k2) * DM + 768 + ch] = f2bf(acc[mi][r] * 0.0013810679320049757f); }
    }
}

#define GAS __attribute__((address_space(1)))
#define XB_TMO      128
#define XB_XCNT(j)  (256  + 64 * (j))
#define XB_XSUB(j)  (1280 + 64 * (j))
#define XB_XGEN(j)  (2304 + 64 * (j))
#define XB_TOP      3328
#define XB_TOPGEN   3392
#define XCD_BAR_WORDS 3456
#define XB_SPIN_CAP (1u << 18)

__device__ __forceinline__ unsigned xb_ld(unsigned* p)              { return __hip_atomic_load(p, __ATOMIC_RELAXED, __HIP_MEMORY_SCOPE_AGENT); }
__device__ __forceinline__ unsigned xb_add(unsigned* p, unsigned v) { return __hip_atomic_fetch_add(p, v, __ATOMIC_RELAXED, __HIP_MEMORY_SCOPE_AGENT); }
__device__ __forceinline__ unsigned xb_xcc_id() { return (unsigned)__builtin_amdgcn_s_getreg((3 << 11) | 20) & 0xFu; }
#define XB_SPIN(cond, bar) do { unsigned _sp = 0; while (cond) { __builtin_amdgcn_s_sleep(1); \
    if ((++_sp & 255u) == 0u) { if (xb_ld(&(bar)[XB_TMO])) break; if (_sp > XB_SPIN_CAP) { atomicAdd(&(bar)[XB_TMO], 1u); break; } } } } while (0)

struct XcdBarrier {
    unsigned* bar; unsigned x;
    volatile LAS unsigned* st;
};

__device__ __forceinline__ XcdBarrier xcd_barrier_post(unsigned* bar, volatile LAS unsigned* st) {
    XcdBarrier b; b.bar = bar; b.x = xb_xcc_id(); b.st = st;
    if (threadIdx.x == 0) (void)xb_add(&bar[XB_XCNT(b.x)], 1u);
    return b;
}
__device__ __forceinline__ void xcd_barrier_complete(unsigned* bar, unsigned x, unsigned& nloc, unsigned& nx) {
    const unsigned G = gridDim.x * gridDim.y * gridDim.z;
    unsigned sum, cnt, mine, sp = 0u;
    for (;;) {
        sum = 0u; cnt = 0u; mine = 0u;
#pragma unroll
        for (unsigned j = 0; j < 16; ++j) { const unsigned c = xb_ld(&bar[XB_XCNT(j)]); sum += c; cnt += (c > 0u) ? 1u : 0u; mine = (j == x) ? c : mine; }
        if (sum == G) break;
        __builtin_amdgcn_s_sleep(1);
        if ((++sp & 255u) == 0u) { if (xb_ld(&bar[XB_TMO])) break; if (sp > XB_SPIN_CAP) { atomicAdd(&bar[XB_TMO], 1u); break; } }
    }
    nloc = mine > 0u ? mine : 1u; nx = cnt > 0u ? cnt : 1u;
}

__device__ __forceinline__ void xcd_barrier(const XcdBarrier& b) {
    asm volatile("s_waitcnt vmcnt(0)" ::: "memory");
    __syncthreads();
    if (threadIdx.x == 0) {
        unsigned* bar = b.bar;
        __builtin_amdgcn_s_waitcnt(0);
        unsigned nloc = b.st[0], nx = b.st[1];
        if (nloc == 0u) { xcd_barrier_complete(bar, b.x, nloc, nx); b.st[0] = nloc; b.st[1] = nx; }
        const unsigned old = xb_add(&bar[XB_XSUB(b.x)], 1u);
        const unsigned gen = old / nloc;
        if (old + 1u == (gen + 1u) * nloc) {
            __builtin_amdgcn_fence(__ATOMIC_RELEASE, "agent");
            asm volatile("s_waitcnt vmcnt(0)" ::: "memory");
            const unsigned og = xb_add(&bar[XB_TOP], 1u);
            const unsigned tg = og / nx;
            if (og + 1u == (tg + 1u) * nx) xb_add(&bar[XB_TOPGEN], 1u);
            else XB_SPIN(xb_ld(&bar[XB_TOPGEN]) == tg, bar);
            __builtin_amdgcn_fence(__ATOMIC_ACQUIRE, "agent");
            xb_add(&bar[XB_XGEN(b.x)], 1u);
            asm volatile("s_waitcnt vmcnt(0)" ::: "memory");
        } else {
            XB_SPIN(xb_ld(&bar[XB_XGEN(b.x)]) == gen, bar);
            __builtin_amdgcn_fence(__ATOMIC_ACQUIRE, "agent");
            asm volatile("s_waitcnt vmcnt(0)" ::: "memory");
        }
    }
    __syncthreads();
}

constexpr int LDS_BYTES = 132096;
constexpr int PH_FINAL = 25, PH_END = 26;
constexpr size_t WS_BAR = WS_MOD + 262144;
constexpr int MISC_OFF = 131072;
__global__ void __launch_bounds__(512, 2) mega(Params Pk, int ph_lo, int ph_hi) {
#if defined(__HIP_DEVICE_COMPILE__)
    extern __shared__ __attribute__((aligned(16))) unsigned char lds_raw[];
    LAS unsigned char* lds = (LAS unsigned char*)lds_raw;
    volatile LAS unsigned* MISC = (volatile LAS unsigned*)(lds + MISC_OFF);
    if (threadIdx.x < 32) MISC[threadIdx.x] = 0u;
    __syncthreads();
    XcdBarrier bar; bar.bar = nullptr; bar.x = 0; bar.st = nullptr;
    for (int ph = ph_lo; ph < ph_hi; ++ph) {
        KP P = (KP)__builtin_amdgcn_kernarg_segment_ptr(); asm volatile("" : "+s"(P));
        if (ph == 0 && blockIdx.x == 0) { unsigned* bw = (unsigned*)(P->ws + WS_BAR); for (int i = threadIdx.x; i < XCD_BAR_WORDS; i += 512) bw[i] = 0u; }
        unsigned char* ws = P->ws;
        float* H = (float*)(ws + WS_H); bf16_t* XN = (bf16_t*)(ws + WS_XN); bf16_t* MID = (bf16_t*)(ws + WS_MID);
        if (ph == 0) prologue_phase(P, lds);
        else if (ph == PH_FINAL) final_phase(P);
        else {
            const int l = (ph - 1) / 12, s = (ph - 1) % 12;
            const float* MODl = (const float*)(ws + WS_MOD) + (size_t)l * 3 * NMOD;
            const bf16_t* WT = (const bf16_t*)(ws + WS_WT) + (size_t)l * WT_L;
            if (s == 0 || s == 3 || s == 8) {
                const float* g = (s == 0 ? P->g_ffn1 : s == 3 ? P->g_mix : P->g_ffn2) + l * 1024; const int shc = s == 0 ? 0 : s == 3 ? 3 : 6;
                norm_phase(P, g, MODl, shc, shc + 1, ph == 1, ph == 1 ? 0 : (s == 8 ? (l == 1 ? 0 : 3) : 10));
            } else if (s == 1 || s == 2 || s == 4 || s == 7 || s == 9 || s == 10) {
                const int mode = (s == 1 || s == 9) ? 0 : (s == 4 ? 2 : 1);
                pg8::EpiAll E{ws, P->g_qn + l * 64, P->g_kn + l * 64, mode, l, s == 2 ? 2 : s == 7 ? 5 : 8, s == 7 ? 1.0f : 0.5f};
                const bf16_t* A = (s == 2 || s == 10) ? MID : XN;
                const bf16_t* Bt = WT + (mode == 0 ? WT_GU + (size_t)(s == 9 ? 1 : 0) * 5632 * 1024 : mode == 2 ? WT_IN : s == 7 ? WT_OUT : WT_DN + (size_t)(s == 10 ? 1 : 0) * 1024 * MIDP);
                const int N = mode == 0 ? 5632 : mode == 2 ? NIN : 1024, K = (s == 2 || s == 10) ? DFF : 1024;
                run_gemm(lds, A, Bt, N, K, (s == 2 || s == 10) ? DFF : 1024, (s == 2 || s == 10) ? 1 : 0, (l == 1 && s >= 7) ? 1 : 0, E);
            }
            else if (s == 5) {
#if FAST_FFT
                fft1_phase(P, l);
#endif
#if FAST_ATTN
                attn_phase(P, lds, l);
#endif
            }
#if FAST_FFT
            else if (s == 6) fft3_phase(P, lds, l);
#endif
        }
        if (ph + 1 < ph_hi) {
            if (ph == 0) { cg::this_grid().sync(); bar = xcd_barrier_post((unsigned*)(P->ws + WS_BAR), MISC + 8); }
            else xcd_barrier(bar);
        }
    }
#endif
}

extern "C" void kernel_launch(void* const* d_in, const int* in_sizes, int n_in, void* d_out, int out_size, void* d_ws, size_t ws_size, hipStream_t stream) {
    static int grid = 0;
    if (grid == 0) {
        if (ws_size < WS_END || n_in < 22) { fprintf(stderr, "kernel_launch: ws too small (%zu) or n_in %d\n", ws_size, n_in); grid = -1; return; }
        if (hipFuncSetAttribute((const void*)mega, hipFuncAttributeMaxDynamicSharedMemorySize, LDS_BYTES) != hipSuccess) { fprintf(stderr, "kernel_launch: hipFuncSetAttribute failed\n"); grid = -1; return; }
        int dev = 0, cus = 0, per_cu = 0; hipGetDevice(&dev); hipDeviceGetAttribute(&cus, hipDeviceAttributeMultiprocessorCount, dev);
        if (hipOccupancyMaxActiveBlocksPerMultiprocessor(&per_cu, (const void*)mega, 512, LDS_BYTES) != hipSuccess || per_cu < 1) { fprintf(stderr, "kernel_launch: occupancy query says %d\n", per_cu); grid = -1; return; }
        grid = cus;
    }
    if (grid < 0) return;
    Params P{};
    const float** pp = (const float**)&P;
    for (int i = 0; i < 22; ++i) pp[i] = (const float*)d_in[i];
    P.out = (float*)d_out; P.ws = (unsigned char*)d_ws;
    int lo = 0, hi = PH_END;
    void* args[] = {&P, &lo, &hi};
    hipError_t e = hipLaunchCooperativeKernel((const void*)mega, dim3(grid), dim3(512), args, LDS_BYTES, stream);
    if (e != hipSuccess) fprintf(stderr, "kernel_launch: cooperative launch failed: %s (grid %d)\n", hipGetErrorString(e), grid);
}
```

```cpp
#include <hip/hip_runtime.h>
#include <hip/hip_cooperative_groups.h>
#include <stdint.h>
#include <cstdio>
namespace cg = cooperative_groups;

typedef unsigned short bf16_t;
__device__ __forceinline__ float bf2f(bf16_t v) { return __uint_as_float(((unsigned)v) << 16); }
__device__ __forceinline__ bf16_t f2bf(float f) { unsigned u = __float_as_uint(f); return (bf16_t)((u + 0x7fffu + ((u >> 16) & 1u)) >> 16); }
__device__ __forceinline__ unsigned pk2(float lo, float hi) { return (unsigned)f2bf(lo) | ((unsigned)f2bf(hi) << 16); }

constexpr int MIDP = 2880;
constexpr int DM = 1024, NB = 2, SEQ = 8192, CTXL = 256, RPB = SEQ + CTXL, M = NB * RPB, DFF = 2816, DIN = 1536, NMOD = 9216, NIN = 1792;
constexpr float QSCALE = 0.125f * 1.4426950408889634f;
constexpr float LOG2E = 1.4426950408889634f;
constexpr size_t MiB = 1u << 20;
constexpr size_t WS_H = 0, WS_XN = 66 * MiB, WS_MID = 99 * MiB;
constexpr size_t WS_QA = 99 * MiB, WS_QB = 112 * MiB, WS_KA = 125 * MiB, WS_KB = 130 * MiB, WS_VTA = 135 * MiB, WS_VTB = 140 * MiB, WS_VS = 145 * MiB, WS_ZS = 161 * MiB, WS_VC = 177 * MiB;
constexpr size_t WS_MOD = 201129984, WS_TAB = WS_MOD + 294912, WS_WT = WS_MOD + 524288, WS_PART = 270 * MiB, WS_END = 290 * MiB;
constexpr int TAB_COS = 0, TAB_ROPE = 8192;
constexpr size_t TAB_D1_BYTES = 65536, TAB_D3_BYTES = 65536 + 32768;
constexpr size_t WT_GU = 0, WT_DN = 2ull * 5632 * 1024, WT_IN = WT_DN + 2ull * 1024 * MIDP, WT_OUT = WT_IN + 1792ull * 1024, WT_L = WT_OUT + 1024ull * 1024;
static_assert(WS_WT + 2 * WT_L * 2 <= WS_PART, "ws map");

__device__ __forceinline__ float silu_f(float x) { return x * __builtin_amdgcn_rcpf(1.f + __expf(-x)); }
__device__ __forceinline__ int row_w(int row) { int b = row / RPB, t = row - b * RPB; return t >= SEQ ? 2 : b; }

struct Params {
    const float *x, *c, *ctx, *cctx, *w_ada, *b_ada, *g_ffn1, *g_mix, *g_ffn2, *w_in, *g_qn, *g_kn, *sink, *w_four, *w_out, *w1g, *w1u, *w1d, *w2g, *w2u, *w2d, *g_final;
    float* out; unsigned char* ws;
};
typedef const __attribute__((address_space(4))) Params* KP;

namespace pg8 {
#define PG8_LAS __attribute__((address_space(3)))
typedef unsigned short bf16_t;
typedef short bf16x8 __attribute__((ext_vector_type(8)));
typedef float f32x4 __attribute__((ext_vector_type(4)));
typedef unsigned u32x4 __attribute__((ext_vector_type(4)));
constexpr int BM = 256, BK = 64, HALF = 128, HTB = HALF * BK * 2  , STAGE_BYTES = 8 * HTB, NXCD = 8, WGM = 8;

__host__ __device__ __forceinline__ int lds_byte(int r, int c) { const int st = (r >> 4) * 2 + (c >> 5), rr = r & 15, cc = c & 31, ob = rr * 64 + cc * 2; return st * 1024 + (ob ^ (((ob >> 9) & 1) << 5)); }
__host__ __device__ __forceinline__ void stage_rc(int b, int& R, int& C) { const int st = b / 1024, sb = b % 1024, swz = sb ^ (((sb >> 9) & 1) << 5); R = (st >> 1) * 16 + swz / 64; C = (st & 1) * 32 + (swz % 64) / 2; }
__host__ __device__ __forceinline__ int perm32(int rho) { const int n = rho >> 4, i = rho & 15; return 8 * (i >> 2) + 4 * n + (i & 3); }

struct Unit { int pm, pn, ko; };
struct Gemm { const bf16_t* A; const bf16_t* Bt; int M, N, K, ld, blocked; };

struct StaticOrder {
    int nM, nN, nwg, G, c;
    __host__ __device__ void init(int M, int N, int G_, int c_) { nM = M / BM; nN = N / BM; nwg = nM * nN; G = G_; c = c_; }
    __host__ __device__ bool next(int i, Unit& u) const {
        const long L = (long)i * G + c; if (L >= nwg) return false;
        int wgid = (int)L; { const int q = nwg / NXCD, r = nwg % NXCD, xcd = wgid % NXCD, off = wgid / NXCD; wgid = (xcd < r ? xcd * (q + 1) : r * (q + 1) + (xcd - r) * q) + off; }
        const int nig = WGM * nN, gid = wgid / nig, fm = gid * WGM, gsz = (nM - fm) < WGM ? (nM - fm) : WGM;
        u.pm = fm + ((wgid % nig) % gsz); u.pn = (wgid % nig) / gsz; return true;
    }
    __device__ __forceinline__ void a_ready(const Unit&) const {}
    __device__ __forceinline__ void done(const Unit&) const {}
};

struct SplitOrder {
    int mode, nchunk, kchunk; StaticOrder S;
    __device__ void init(int mode_, int Mrows, int N, int G, int c, int nchunk_, int kchunk_) { mode = mode_; nchunk = nchunk_; kchunk = kchunk_; S.init(mode_ == 1 ? 64 * BM : Mrows, N, G, c); }
    __device__ bool next(int i, Unit& u) const {
        if (mode == 2) { const long L = (long)i * S.G + S.c; if (L >= 8 * nchunk) return false; const int un = (int)L / nchunk, ch = (int)L - un * nchunk;
            u.pm = (un >> 2) ? 65 : 32; u.pn = un & 3; u.ko = ch * kchunk; return true; }
        if (!S.next(i, u)) return false;
        u.ko = 0; if (mode == 1) u.pm += u.pm >> 5;
        return true;
    }
    __device__ __forceinline__ void a_ready(const Unit&) const {}
    __device__ __forceinline__ void done(const Unit&) const {}
};

__device__ __forceinline__ unsigned cvt_pk_bf16(float lo, float hi) { unsigned r; asm("v_cvt_pk_bf16_f32 %0, %1, %2" : "=v"(r) : "v"(lo), "v"(hi)); return r; }
__device__ __forceinline__ int tile_w(int pm) { const int b = pm / 33, wi = pm - b * 33; return wi == 32 ? 2 : b; }
struct EpiSwiglu {
    static constexpr bool PERM = false, AFTER_DRAIN = false;
    bf16_t* O;
    __device__ __forceinline__ void operator()(const f32x4 (&acc)[2][2][4][2], const Unit& u, int wr, int wc, int fr, int fq) const {
        const int row0 = u.pm * BM + wr * 64 + fr, col = u.pn * 128 + wc * 32 + fq * 8;
#pragma unroll
        for (int ai = 0; ai < 2; ++ai)
#pragma unroll
            for (int m = 0; m < 4; ++m) {
                const f32x4 g0 = acc[ai][0][m][0], u0 = acc[ai][1][m][0], g1 = acc[ai][0][m][1], u1 = acc[ai][1][m][1];
                u32x4 w;
                w.x = cvt_pk_bf16(silu_f(g0[0]) * u0[0], silu_f(g0[1]) * u0[1]); w.y = cvt_pk_bf16(silu_f(g0[2]) * u0[2], silu_f(g0[3]) * u0[3]);
                w.z = cvt_pk_bf16(silu_f(g1[0]) * u1[0], silu_f(g1[1]) * u1[1]); w.w = cvt_pk_bf16(silu_f(g1[2]) * u1[2], silu_f(g1[3]) * u1[3]);
                *(u32x4*)(O + (size_t)u.pm * BM * DFF + (size_t)(col >> 6) * (BM * 64) + (size_t)(wr * 64 + fr + ai * HALF + m * 16) * 64 + (col & 63)) = w;
            }
    }
};
struct EpiRes {
    static constexpr bool PERM = false, AFTER_DRAIN = false;
    float* H; const float* MODl; int gate_chunk; float coef; float* PART;
    __device__ __forceinline__ void operator()(const f32x4 (&acc)[2][2][4][2], const Unit& u, int wr, int wc, int fr, int fq) const {
        const float* gate = MODl + tile_w(u.pm) * NMOD + gate_chunk * 1024;
        const bool part = u.ko != 0;
        float* base = part ? PART + ((size_t)((u.ko >> 8) - 1) * 512 + (u.pm == 32 ? 0 : 256) + wr * 64 + fr) * DM : H + (size_t)(u.pm * BM + wr * 64 + fr) * DM;
#pragma unroll
        for (int bj = 0; bj < 2; ++bj)
#pragma unroll
            for (int n = 0; n < 2; ++n) {
                const int col = u.pn * BM + bj * HALF + wc * 32 + n * 16 + fq * 4;
                const f32x4 gv = *(const f32x4*)(gate + col) * coef;
                f32x4 old[2][4];
#pragma unroll
                for (int ai = 0; ai < 2; ++ai)
#pragma unroll
                    for (int m = 0; m < 4; ++m) old[ai][m] = part ? (f32x4){0.f, 0.f, 0.f, 0.f} : *(const f32x4*)(base + (size_t)(ai * HALF + m * 16) * DM + col);
#pragma unroll
                for (int ai = 0; ai < 2; ++ai)
#pragma unroll
                    for (int m = 0; m < 4; ++m) *(f32x4*)(base + (size_t)(ai * HALF + m * 16) * DM + col) = old[ai][m] + gv * acc[ai][bj][m][n];
            }
    }
};
struct EpiWin {
    static constexpr bool PERM = false, AFTER_DRAIN = false;
    const float* gqn; const float* gkn; const float* ROPE;
    bf16_t *QA, *QB, *KA, *KB, *VTA, *VTB; unsigned *VS, *VC;
    __device__ __forceinline__ void operator()(const f32x4 (&acc)[2][2][4][2], const Unit& u, int wr, int wc, int fr, int fq) const {
        const int unit = u.pn * 4 + wc;
        const int b = u.pm / 33, wi = u.pm - b * 33; const bool lat = wi < 32; const int t0 = wi * 256;
        if (unit < 20) {
            const bool isB = unit >= 10; const int ul = isB ? unit - 10 : unit;
            const bool isq = ul < 6, isk = ul >= 6 && ul < 8;
            f32x4 gg[2][2];
            if (isB && (isq || isk)) { const float* g = isq ? gqn : gkn;
#pragma unroll
                for (int bj = 0; bj < 2; ++bj)
#pragma unroll
                    for (int n = 0; n < 2; ++n) gg[bj][n] = *(const f32x4*)(g + 32 * bj + 16 * n + 4 * fq); }
#pragma unroll
            for (int ai = 0; ai < 2; ++ai)
#pragma unroll
                for (int m = 0; m < 4; ++m) {
                    const int t = t0 + ai * HALF + wr * 64 + m * 16 + fr; const size_t row = (size_t)b * RPB + t;
                    f32x4 v[2][2];
#pragma unroll
                    for (int bj = 0; bj < 2; ++bj)
#pragma unroll
                        for (int n = 0; n < 2; ++n) v[bj][n] = acc[ai][bj][m][n];
                    if (isB && (isq || isk)) {
                        float ss = 0.f;
#pragma unroll
                        for (int bj = 0; bj < 2; ++bj)
#pragma unroll
                            for (int n = 0; n < 2; ++n) ss += (v[bj][n][0] * v[bj][n][0] + v[bj][n][1] * v[bj][n][1]) + (v[bj][n][2] * v[bj][n][2] + v[bj][n][3] * v[bj][n][3]);
                        ss += __shfl_xor(ss, 16); ss += __shfl_xor(ss, 32);
                        const float r = rsqrtf(ss * (1.f / 64.f) + 1e-6f);
#pragma unroll
                        for (int bj = 0; bj < 2; ++bj)
#pragma unroll
                            for (int n = 0; n < 2; ++n) v[bj][n] = v[bj][n] * r * gg[bj][n];
                    }
                    if (lat && (isq || isk)) {
#pragma unroll
                        for (int bj = 0; bj < 2; ++bj) {
                            const int p = bj == 0 ? (t >> 6) : 128 + (t & 63);
                            const f32x4 cs0 = *(const f32x4*)(ROPE + (p * 16 + 4 * fq) * 2), cs1 = *(const f32x4*)(ROPE + (p * 16 + 4 * fq) * 2 + 4);
                            const f32x4 cv = {cs0[0], cs0[2], cs1[0], cs1[2]}, sv = {cs0[1], cs0[3], cs1[1], cs1[3]};
                            const f32x4 a = v[bj][0], bb = v[bj][1];
                            v[bj][0] = a * cv - bb * sv; v[bj][1] = bb * cv + a * sv;
                        }
                    }
                    if (isq || isk) {
                        const float sc = isq ? QSCALE : 1.f;
                        bf16_t* dst = isq ? ((isB ? QB : QA) + row * 384 + ul * 64) : ((isB ? KB : KA) + row * 128 + (ul - 6) * 64);
#pragma unroll
                        for (int bj = 0; bj < 2; ++bj)
#pragma unroll
                            for (int n = 0; n < 2; ++n) { const f32x4 x = v[bj][n] * sc; uint2 w; w.x = cvt_pk_bf16(x[0], x[1]); w.y = cvt_pk_bf16(x[2], x[3]);
                                *(uint2*)(dst + 32 * bj + 16 * n + 4 * fq) = w; }
                    } else {
                        bf16_t* dst = (isB ? VTB : VTA) + ((size_t)(b * 2 + (ul - 8)) * 64) * RPB + t;
#pragma unroll
                        for (int bj = 0; bj < 2; ++bj)
#pragma unroll
                            for (int n = 0; n < 2; ++n)
#pragma unroll
                                for (int i = 0; i < 4; ++i) dst[(size_t)(32 * bj + 16 * n + 4 * fq + i) * RPB] = f2bf(v[bj][n][i]);
                    }
                }
        } else {
            const int chb = ((unit - 20) >> 1) * 64 + 32 * ((unit - 20) & 1);
#pragma unroll
            for (int ai = 0; ai < 2; ++ai)
#pragma unroll
                for (int m = 0; m < 4; ++m) {
                    const int t = t0 + ai * HALF + wr * 64 + m * 16 + fr;
#pragma unroll
                    for (int bj = 0; bj < 2; ++bj)
#pragma unroll
                        for (int n = 0; n < 2; ++n) {
                            const f32x4 x = acc[ai][bj][m][n]; const int ch = chb + 16 * bj + 8 * n + 2 * fq;
                            const unsigned w0 = cvt_pk_bf16(x[0], x[1]), w1 = cvt_pk_bf16(x[2], x[3]);
                            if (lat) { unsigned* d = VS + ((size_t)(b * SEQ + t) * 256 + ch); d[0] = w0; d[1] = w1; }
                            else { unsigned* d = VC + ((size_t)(b * 256 + (t - SEQ)) * 256 + ch); d[0] = w0; d[1] = w1; }
                        }
                }
        }
    }
};

struct EpiAll {
    static constexpr bool PERM = false, AFTER_DRAIN = false;
    unsigned char* ws; const float* gqn; const float* gkn; int mode, l, chunk; float coef;
    __device__ __forceinline__ void operator()(const f32x4 (&acc)[2][2][4][2], const Unit& u, int wr, int wc, int fr, int fq) const {
        if (mode == 0) { EpiSwiglu E{(bf16_t*)(ws + WS_MID)}; E(acc, u, wr, wc, fr, fq); }
        else if (mode == 1) { EpiRes E{(float*)(ws + WS_H), (const float*)(ws + WS_MOD) + (size_t)l * 3 * NMOD, chunk, coef, (float*)(ws + WS_PART)}; E(acc, u, wr, wc, fr, fq); }
        else { EpiWin E{gqn, gkn, (const float*)(ws + WS_TAB) + TAB_ROPE, (bf16_t*)(ws + WS_QA), (bf16_t*)(ws + WS_QB), (bf16_t*)(ws + WS_KA), (bf16_t*)(ws + WS_KB),
                        (bf16_t*)(ws + WS_VTA), (bf16_t*)(ws + WS_VTB), (unsigned*)(ws + WS_VS), (unsigned*)(ws + WS_VC)}; E(acc, u, wr, wc, fr, fq); }
    }
};

template <class Epi, class Sched, bool ALIGN_EPI = false, bool SP2 = false>
__device__ __forceinline__ void gemm_phase(PG8_LAS unsigned char* lds, const Gemm g, const Sched& S, const Epi& E) {
    int tid_ = threadIdx.x; asm volatile("" : "+v"(tid_)); const int tid = tid_, wid = __builtin_amdgcn_readfirstlane(tid >> 6), lane = tid & 63, wr = wid >> 2, wc = wid & 3, fr = lane & 15, fq = lane >> 4;
    const int K = g.K, nt = K / BK, LD = g.blocked ? BK : g.ld;
    unsigned voffA[2], voffB[2];
#pragma unroll
    for (int i = 0; i < 2; ++i) { int R, C; stage_rc(tid * 16 + i * 8192, R, C); const int Rb = Epi::PERM ? ((R & ~31) + perm32(R & 31)) : R;
        voffA[i] = (unsigned)(R * LD + C) * 2u; voffB[i] = (unsigned)(Rb * LD + C) * 2u; }
    const size_t kstep = g.blocked ? (size_t)(BM * BK * 2) : (size_t)(BK * 2);
    const size_t hstep = (size_t)HALF * LD * 2;
    const size_t tstep = g.blocked ? (size_t)BM * g.ld * 2 : 2 * hstep;
    const unsigned ldsw = (unsigned)wid * 1024u;
    const int aoff = lds_byte(wr * 64 + fr, fq * 8), boff = lds_byte(wc * 32 + fr, fq * 8);
#define PG8_SA(b, h) (((b) * 2 + (h)) * HTB)
#define PG8_SB(b, h) ((4 + (b) * 2 + (h)) * HTB)
#define PG8_STAGE(bufoff, gbase, voff) do { _Pragma("unroll") for (int _i = 0; _i < 2; ++_i) \
        __builtin_amdgcn_global_load_lds((const unsigned*)((const char*)(gbase) + (voff)[_i]), (PG8_LAS unsigned*)(lds + (bufoff) + ldsw + _i * 8192), 16, 0, 0); } while (0)
#define PG8_LDA(dst, b, h) do { _Pragma("unroll") for (int m = 0; m < 4; ++m) _Pragma("unroll") for (int k = 0; k < 2; ++k) dst[m][k] = *(const PG8_LAS bf16x8*)(lds + PG8_SA(b, h) + aoff + m * 2048 + k * 1024); } while (0)
#define PG8_LDB(dst, b, h) do { _Pragma("unroll") for (int n = 0; n < 2; ++n) _Pragma("unroll") for (int k = 0; k < 2; ++k) dst[n][k] = *(const PG8_LAS bf16x8*)(lds + PG8_SB(b, h) + boff + n * 2048 + k * 1024); } while (0)
#define PG8_MMA(ai, bj, At, Bt) do { __builtin_amdgcn_s_setprio(1); _Pragma("unroll") for (int m = 0; m < 4; ++m) _Pragma("unroll") for (int n = 0; n < 2; ++n) _Pragma("unroll") for (int k = 0; k < 2; ++k) \
        acc[ai][bj][m][n] = __builtin_amdgcn_mfma_f32_16x16x32_bf16(Bt[n][k], At[m][k], acc[ai][bj][m][n], 0, 0, 0); __builtin_amdgcn_s_setprio(0); } while (0)
#define PG8_WAIT_V(n) asm volatile("s_waitcnt vmcnt(" #n ")" ::: "memory")
#define PG8_WAIT_L(n) asm volatile("s_waitcnt lgkmcnt(" #n ")" ::: "memory")
#define PG8_BAR __builtin_amdgcn_s_barrier()
#define PG8_SCHED __builtin_amdgcn_sched_barrier(0)
    Unit cur, nxt; int ui = 0;
    if (!S.next(0, cur)) return;
    f32x4 acc[2][2][4][2];
#pragma unroll
    for (int a = 0; a < 2; ++a)
#pragma unroll
        for (int b = 0; b < 2; ++b)
#pragma unroll
            for (int m = 0; m < 4; ++m)
#pragma unroll
                for (int n = 0; n < 2; ++n) acc[a][b][m][n] = (f32x4){0.f, 0.f, 0.f, 0.f};
    bf16x8 At[4][2], B0[2][2], B1[2][2];
    const char* cA = (const char*)g.A + (size_t)cur.pm * tstep + (size_t)(cur.ko / BK) * kstep; const char* cB = (const char*)g.Bt + (size_t)cur.pn * tstep + (size_t)(cur.ko / BK) * kstep;
    S.a_ready(cur);
    if constexpr (SP2) {
        PG8_STAGE(PG8_SB(0, 0), cB, voffB); PG8_STAGE(PG8_SB(0, 1), cB + hstep, voffB); PG8_STAGE(PG8_SA(0, 0), cA, voffA); PG8_STAGE(PG8_SA(0, 1), cA + hstep, voffA);
        if (wr == 1) PG8_BAR;
        PG8_WAIT_V(2); PG8_BAR;
        PG8_STAGE(PG8_SB(1, 0), cB + kstep, voffB); PG8_STAGE(PG8_SA(1, 0), cA + kstep, voffA); PG8_STAGE(PG8_SB(1, 1), cB + hstep + kstep, voffB);
        PG8_WAIT_V(6); PG8_BAR;
    } else {
        PG8_STAGE(PG8_SB(0, 0), cB, voffB); PG8_STAGE(PG8_SA(0, 0), cA, voffA); PG8_STAGE(PG8_SB(0, 1), cB + hstep, voffB); PG8_STAGE(PG8_SA(0, 1), cA + hstep, voffA);
        if (wr == 1) PG8_BAR;
        PG8_WAIT_V(4); PG8_BAR;
        PG8_STAGE(PG8_SB(1, 0), cB + kstep, voffB); PG8_STAGE(PG8_SA(1, 0), cA + kstep, voffA); PG8_STAGE(PG8_SB(1, 1), cB + hstep + kstep, voffB);
        PG8_WAIT_V(6); PG8_BAR;
    }
    for (;;) {
        const bool has_next = S.next(ui + 1, nxt);
        const char* nA = has_next ? (const char*)g.A + (size_t)nxt.pm * tstep + (size_t)(nxt.ko / BK) * kstep : cA; const char* nB = has_next ? (const char*)g.Bt + (size_t)nxt.pn * tstep + (size_t)(nxt.ko / BK) * kstep : cB;
        for (int t = 0; t < nt; t += 2) {
            const bool last = (t == nt - 2);
            const char* a1 = cA + (size_t)(t + 1) * kstep;
            const char* a2 = last ? nA : cA + (size_t)(t + 2) * kstep; const char* b2 = last ? nB : cB + (size_t)(t + 2) * kstep;
            const char* a3 = a2 + kstep; const char* b3 = b2 + kstep;
            if (last && has_next) S.a_ready(nxt);
            if constexpr (SP2) {
            PG8_LDB(B0, 0, 0); PG8_LDB(B1, 0, 1); PG8_SCHED; PG8_LDA(At, 0, 0); PG8_STAGE(PG8_SA(1, 1), a1 + hstep, voffA);
            PG8_WAIT_V(8); PG8_WAIT_L(0); PG8_BAR; PG8_MMA(0, 0, At, B0); PG8_MMA(0, 1, At, B1); PG8_BAR; PG8_SCHED;
            PG8_LDA(At, 0, 1); PG8_STAGE(PG8_SB(0, 0), b2, voffB); PG8_STAGE(PG8_SB(0, 1), b2 + hstep, voffB); PG8_STAGE(PG8_SA(0, 0), a2, voffA);
            PG8_WAIT_V(8); PG8_WAIT_L(0); PG8_BAR; PG8_MMA(1, 0, At, B0); PG8_MMA(1, 1, At, B1); PG8_BAR; PG8_SCHED;
            PG8_LDB(B0, 1, 0); PG8_LDB(B1, 1, 1); PG8_SCHED; PG8_LDA(At, 1, 0); PG8_STAGE(PG8_SA(0, 1), a2 + hstep, voffA);
            PG8_WAIT_V(8); PG8_WAIT_L(0); PG8_BAR; PG8_MMA(0, 0, At, B0); PG8_MMA(0, 1, At, B1); PG8_BAR; PG8_SCHED;
            PG8_LDA(At, 1, 1); PG8_STAGE(PG8_SB(1, 0), b3, voffB); PG8_STAGE(PG8_SB(1, 1), b3 + hstep, voffB); PG8_STAGE(PG8_SA(1, 0), a3, voffA);
            PG8_WAIT_V(8); PG8_WAIT_L(0); PG8_BAR; PG8_MMA(1, 0, At, B0); PG8_MMA(1, 1, At, B1); PG8_BAR; PG8_SCHED;
            } else {
            PG8_LDB(B0, 0, 0); PG8_SCHED; PG8_LDA(At, 0, 0); PG8_STAGE(PG8_SA(1, 1), a1 + hstep, voffA);
            PG8_WAIT_L(8); PG8_BAR; PG8_WAIT_L(0); PG8_MMA(0, 0, At, B0); PG8_BAR; PG8_SCHED;
            PG8_LDB(B1, 0, 1); PG8_STAGE(PG8_SB(0, 0), b2, voffB);
            PG8_BAR; PG8_WAIT_L(0); PG8_MMA(0, 1, At, B1); PG8_BAR;
            PG8_LDA(At, 0, 1); PG8_STAGE(PG8_SA(0, 0), a2, voffA);
            PG8_BAR; PG8_WAIT_L(0); PG8_MMA(1, 0, At, B0); PG8_BAR; PG8_SCHED;
            PG8_STAGE(PG8_SB(0, 1), b2 + hstep, voffB);
            PG8_WAIT_V(6); PG8_BAR; PG8_MMA(1, 1, At, B1); PG8_BAR;
            PG8_LDB(B0, 1, 0); PG8_SCHED; PG8_LDA(At, 1, 0); PG8_STAGE(PG8_SA(0, 1), a2 + hstep, voffA);
            PG8_WAIT_L(8); PG8_BAR; PG8_WAIT_L(0); PG8_MMA(0, 0, At, B0); PG8_BAR; PG8_SCHED;
            PG8_LDB(B1, 1, 1); PG8_STAGE(PG8_SB(1, 0), b3, voffB);
            PG8_BAR; PG8_WAIT_L(0); PG8_MMA(0, 1, At, B1); PG8_BAR;
            PG8_LDA(At, 1, 1); PG8_STAGE(PG8_SA(1, 0), a3, voffA);
            PG8_BAR; PG8_WAIT_L(0); PG8_MMA(1, 0, At, B0); PG8_BAR; PG8_SCHED;
            PG8_STAGE(PG8_SB(1, 1), b3 + hstep, voffB);
            PG8_WAIT_V(6); PG8_BAR; PG8_MMA(1, 1, At, B1); PG8_BAR;
            }
        }
        if constexpr (ALIGN_EPI) { if (wr == 0) PG8_BAR; }
        if constexpr (!Epi::AFTER_DRAIN) { E(acc, cur, wr, wc, fr, fq); S.done(cur); }
        if (!has_next) break;
#pragma unroll
        for (int a = 0; a < 2; ++a)
#pragma unroll
            for (int b = 0; b < 2; ++b)
#pragma unroll
                for (int m = 0; m < 4; ++m)
#pragma unroll
                    for (int n = 0; n < 2; ++n) acc[a][b][m][n] = (f32x4){0.f, 0.f, 0.f, 0.f};
        cur = nxt; cA = nA; cB = nB; ++ui;
        if constexpr (ALIGN_EPI) { if (wr == 1) PG8_BAR; }
    }
    PG8_WAIT_V(0);
    if constexpr (!ALIGN_EPI) { if (wr == 0) PG8_BAR; }
    PG8_BAR;
    if constexpr (Epi::AFTER_DRAIN) { E.fused(acc, cur, wr, wc, fr, fq, lds, wid, lane); S.done(cur); }
#undef PG8_SA
#undef PG8_SB
#undef PG8_STAGE
#undef PG8_LDA
#undef PG8_LDB
#undef PG8_MMA
#undef PG8_WAIT_V
#undef PG8_WAIT_L
#undef PG8_BAR
#undef PG8_SCHED
}
}
#define FAST_ATTN 1
#define FAST_FFT 1
#define LAS __attribute__((address_space(3)))
__device__ __forceinline__ float wave_sum(float v) {
#pragma unroll
    for (int o = 1; o < 64; o <<= 1) v += __shfl_xor(v, o);
    return v;
}
__device__ __forceinline__ void tr_write(const LAS float* scr, bf16_t* Bt, int ldk, int k0, int P0, int P1, int P2, int P3, int lane) {
    const int c = lane & 7, nl = lane >> 3;
#pragma unroll
    for (int j = 0; j < 4; ++j) { const int n = nl + 8 * j; const LAS float* s = scr + (8 * c) * 33 + n; const int P = j == 0 ? P0 : j == 1 ? P1 : j == 2 ? P2 : P3;
        uint4 o; o.x = pk2(s[0], s[33]); o.y = pk2(s[2 * 33], s[3 * 33]); o.z = pk2(s[4 * 33], s[5 * 33]); o.w = pk2(s[6 * 33], s[7 * 33]);
        *(uint4*)(Bt + (size_t)P * ldk + k0 + 8 * c) = o; }
    asm volatile("s_waitcnt lgkmcnt(0)" ::: "memory");
}
__device__ __forceinline__ void tr_load(LAS float* scr, const float* W, int ldw, int k0, int col0, int lane) {
    float v[32];
#pragma unroll
    for (int i = 0; i < 32; ++i) v[i] = W[(size_t)(k0 + 2 * i + (lane >> 5)) * ldw + col0 + (lane & 31)];
#pragma unroll
    for (int i = 0; i < 32; ++i) scr[(2 * i + (lane >> 5)) * 33 + (lane & 31)] = v[i];
    asm volatile("s_waitcnt lgkmcnt(0)" ::: "memory");
}
__device__ __forceinline__ int perm_gu(int j, int t) { const int jj = j & 127; return 256 * (j >> 7) + 128 * t + 32 * (jj >> 5) + 16 * ((jj & 7) >> 2) + 4 * ((jj & 31) >> 3) + (jj & 3); }
__device__ __forceinline__ int perm_in(int u, int d) { return 256 * (u >> 2) + 32 * (u & 3) + 128 * (d >> 5) + (d & 31); }

__device__ __forceinline__ void prologue_phase(KP P, LAS unsigned char* lds) {
    int tid_ = threadIdx.x, bid_ = blockIdx.x; asm volatile("" : "+v"(tid_)); asm volatile("" : "+s"(bid_));
    const int tid = tid_, lane = tid & 63, wave = tid >> 6, bid = bid_, G = gridDim.x;
    float* MOD = (float*)(P->ws + WS_MOD); float* TAB = (float*)(P->ws + WS_TAB);
    LAS float* cs64 = (LAS float*)(lds + 8 * 8448);
    LAS unsigned* ctr = (LAS unsigned*)(lds + 8 * 8448 + 256);
    if (tid < 64) cs64[tid] = cospif((float)tid / 32.f);
    if (tid == 64) ctr[0] = 0u;
    {
        const int i = bid * 512 + tid;
        if (i < 8192) TAB[TAB_COS + i] = cospif((float)i / 4096.f);
        else if (i < 8192 + 3072) { const int e = i - 8192, p = e / 16, k = e % 16; const float inv = powf(10000.f, -(float)(2 * k) / 32.f);
            const float ang = (float)(p < 128 ? p : p - 128) * inv; TAB[TAB_ROPE + e * 2] = cosf(ang); TAB[TAB_ROPE + e * 2 + 1] = sinf(ang); }
        else if (i < 8192 + 3072 + 16384) { const int e = i - 8192 - 3072, mrow = e >> 7, kcol = e & 127; const int k1 = mrow >> 1, ro = mrow & 1, l1 = kcol >> 1, ri = kcol & 1;
            const int j = (k1 * l1) & 63; const float cv = cospif((float)j / 32.f), sv = sinpif((float)j / 32.f);
            const float v = (ro == ri) ? cv : (ro == 0 ? sv : -sv);
            ((bf16_t*)(P->ws + WS_TAB + TAB_D1_BYTES))[e] = f2bf(v); }
        else if (i < 8192 + 3072 + 16384 + 32768) { const int e = i - 8192 - 3072 - 16384, k2 = e >> 8, kcol = e & 255, l2 = kcol >> 1, ri = kcol & 1;
            const int j = (k2 * l2) & 127; const float v = ri == 0 ? cospif((float)j / 64.f) : sinpif((float)j / 64.f);
            ((bf16_t*)(P->ws + WS_TAB + TAB_D3_BYTES))[e] = f2bf(v); }
    }
    {
        LAS float* sv = (LAS float*)lds;
        LAS float* red = (LAS float*)(lds + 12288);
        for (int i = tid; i < 1024; i += 512) { sv[i] = silu_f(P->c[i]); sv[1024 + i] = silu_f(P->c[1024 + i]); sv[2048 + i] = silu_f(P->cctx[i]); }
        __syncthreads();
        for (int it = bid; it < 256; it += G) {
            const int l = it >> 7, n0 = (it & 127) * 72;
            const float* W = P->w_ada + (size_t)l * 1024 * NMOD + n0;
            float a0 = 0.f, a1 = 0.f, a2 = 0.f, e0 = 0.f, e1 = 0.f, e2 = 0.f;
            const int ks = wave * 128 + 16 * (lane >> 3);
#pragma unroll
            for (int j = 0; j < 16; ++j) { const float w = W[(size_t)(ks + j) * NMOD + 64 + (lane & 7)]; e0 += sv[ks + j] * w; e1 += sv[1024 + ks + j] * w; e2 += sv[2048 + ks + j] * w; }
#pragma unroll 32
            for (int k = wave * 128; k < wave * 128 + 128; ++k) { const float w = W[(size_t)k * NMOD + lane]; a0 += sv[k] * w; a1 += sv[1024 + k] * w; a2 += sv[2048 + k] * w; }
#pragma unroll
            for (int o = 8; o < 64; o <<= 1) { e0 += __shfl_xor(e0, o); e1 += __shfl_xor(e1, o); e2 += __shfl_xor(e2, o); }
            red[(wave * 3 + 0) * 72 + lane] = a0; red[(wave * 3 + 1) * 72 + lane] = a1; red[(wave * 3 + 2) * 72 + lane] = a2;
            if (lane < 8) { red[(wave * 3 + 0) * 72 + 64 + lane] = e0; red[(wave * 3 + 1) * 72 + 64 + lane] = e1; red[(wave * 3 + 2) * 72 + 64 + lane] = e2; }
            __syncthreads();
            if (tid < 216) { const int w = tid / 72, cc = tid - w * 72; float s = P->b_ada[l * NMOD + n0 + cc];
#pragma unroll
                for (int q = 0; q < 8; ++q) s += red[(q * 3 + w) * 72 + cc];
                MOD[(size_t)(l * 3 + w) * NMOD + n0 + cc] = s; }
            __syncthreads();
        }
    }
    {
        LAS float* scr = (LAS float*)(lds + wave * 8448);
        const int nl = lane >> 3;
        for (int hid = bid + G * wave; hid < 768 && wave < 8; hid += 8 * G) {
            const int l = hid / 384; int r = hid - l * 384;
            bf16_t* WT = (bf16_t*)(P->ws + WS_WT) + (size_t)l * WT_L;
            if (r < 256) {
                const int kb = r / 16, ob = r % 16;
                const int u = 20 + (ob >> 1), g = (u - 20) >> 1, half = (u - 20) & 1, q = (ob & 1) * 32 + (lane & 31);
                const int dch = 32 * half + (q >> 1), ri = q & 1;
                const float* W = P->w_in + (size_t)l * 1024 * DIN + 1280 + g * 64;
                float tw[64];
#pragma unroll
                for (int cc = 0; cc < 64; ++cc) { const int j = (cc * dch) & 63; tw[cc] = ri == 0 ? cs64[j] : -cs64[(j - 16) & 63]; }
                for (int i = 0; i < 32; ++i) { const int kk = 2 * i + (lane >> 5); const float4* w4 = (const float4*)(W + (size_t)(kb * 64 + kk) * DIN); float a = 0.f;
#pragma unroll
                    for (int c4 = 0; c4 < 16; ++c4) { const float4 wv = w4[c4]; a += wv.x * tw[4 * c4] + wv.y * tw[4 * c4 + 1] + wv.z * tw[4 * c4 + 2] + wv.w * tw[4 * c4 + 3]; }
                    scr[kk * 33 + (lane & 31)] = a; }
                asm volatile("s_waitcnt lgkmcnt(0)" ::: "memory");
                const int d = (ob & 1) * 32 + nl;
                tr_write(scr, WT + WT_IN, 1024, kb * 64, perm_in(u, d), perm_in(u, d + 8), perm_in(u, d + 16), perm_in(u, d + 24), lane);
            } else {
                r -= 256; const int g = r / 32, nb = r % 32;
                const float* wo = P->w_out + (size_t)l * 1024 * 1024 + (size_t)(768 + g * 64) * 1024 + nb * 32 + (lane & 31);
                const float* wf = P->w_four + (size_t)(l * 4 + g) * 4096;
                float wov[64];
#pragma unroll
                for (int d = 0; d < 64; ++d) wov[d] = wo[(size_t)d * 1024];
                for (int i = 0; i < 32; ++i) { const int kk = 2 * i + (lane >> 5); const float4* f4 = (const float4*)(wf + kk * 64); float a = 0.f;
#pragma unroll
                    for (int d4 = 0; d4 < 16; ++d4) { const float4 fv = f4[d4]; a += fv.x * wov[4 * d4] + fv.y * wov[4 * d4 + 1] + fv.z * wov[4 * d4 + 2] + fv.w * wov[4 * d4 + 3]; }
                    scr[kk * 33 + (lane & 31)] = a; }
                asm volatile("s_waitcnt lgkmcnt(0)" ::: "memory");
                const int j = nb * 32 + nl;
                tr_write(scr, WT + WT_OUT, 1024, 768 + g * 64, j, j + 8, j + 16, j + 24, lane);
            }
        }
        constexpr int NA = 4 * 1408, NBd = 2 * 1408, NC = 640, NE = 384, NL = NA + NBd + NC + NE;
        const int lo = (int)(((long)bid * (2 * NL)) / G), hi = (int)(((long)(bid + 1) * (2 * NL)) / G);
        for (;;) {
            unsigned iu = 0u; if (lane == 0) iu = __hip_atomic_fetch_add(ctr, 1u, __ATOMIC_RELAXED, __HIP_MEMORY_SCOPE_WORKGROUP);
            const int it = lo + (int)__builtin_amdgcn_readfirstlane(iu);
            if (it >= hi) break;
            const int l = it / NL; int r = it - l * NL;
            bf16_t* WT = (bf16_t*)(P->ws + WS_WT) + (size_t)l * WT_L;
            if (r < NA) { const int f = r / 2816, t = (r / 1408) & 1, q = r % 1408, kb = q / 88, nb = q % 88;
                const float* W = (f == 0 ? (t == 0 ? P->w1g : P->w1u) : (t == 0 ? P->w2g : P->w2u)) + (size_t)l * 1024 * DFF;
                tr_load(scr, W, DFF, kb * 64, nb * 32, lane);
                const int j = nb * 32 + nl;
                tr_write(scr, WT + WT_GU + (size_t)f * 5632 * 1024, 1024, kb * 64, perm_gu(j, t), perm_gu(j + 8, t), perm_gu(j + 16, t), perm_gu(j + 24, t), lane);
                continue; }
            r -= NA;
            if (r < NBd) { const int f = r / 1408, q = r % 1408, kb = q / 32, nb = q % 32;
                const float* W = (f == 0 ? P->w1d : P->w2d) + (size_t)l * DFF * 1024;
                tr_load(scr, W, 1024, kb * 64, nb * 32, lane);
                const int j = nb * 32 + nl;
                { bf16_t* Bd = WT + WT_DN + (size_t)f * 1024 * MIDP + (size_t)(j >> 8) * 256 * DFF + (size_t)kb * (256 * 64);
                  tr_write(scr, Bd, 64, 0, j & 255, (j + 8) & 255, (j + 16) & 255, (j + 24) & 255, lane); }
                continue; }
            r -= NBd;
            if (r < NC) { const int kb = r / 40, nb = r % 40;
                tr_load(scr, P->w_in + (size_t)l * 1024 * DIN, DIN, kb * 64, nb * 32, lane);
                const int u = nb >> 1, d = (nb & 1) * 32 + nl;
                tr_write(scr, WT + WT_IN, 1024, kb * 64, perm_in(u, d), perm_in(u, d + 8), perm_in(u, d + 16), perm_in(u, d + 24), lane);
                continue; }
            r -= NC;
            { const int kb = r / 32, nb = r % 32;
                tr_load(scr, P->w_out + (size_t)l * 1024 * 1024, 1024, kb * 64, nb * 32, lane);
                const int j = nb * 32 + nl;
                tr_write(scr, WT + WT_OUT, 1024, kb * 64, j, j + 8, j + 16, j + 24, lane); }
        }
    }
}
__device__ __forceinline__ void norm_phase(KP P, const float* g, const float* MODl, int shc, int scc, bool from_input, int npart) {
    int tid_ = threadIdx.x, bid_ = blockIdx.x; asm volatile("" : "+v"(tid_)); asm volatile("" : "+s"(bid_));
    const int lane = tid_ & 63, gw = bid_ * 8 + (tid_ >> 6), NGW = gridDim.x * 8;
    float* H = (float*)(P->ws + WS_H); bf16_t* XN = (bf16_t*)(P->ws + WS_XN);
    constexpr int RU = 3;
    for (int row0 = gw; row0 < M; row0 += RU * NGW) {
        float4 v[RU][4]; float ss[RU];
#pragma unroll
        for (int u = 0; u < RU; ++u) { const int row = row0 + u * NGW; ss[u] = 0.f;
            if (row < M) { const int b = row / RPB, t = row - b * RPB;
                const float4* h = from_input ? (t < SEQ ? (const float4*)(P->x + ((size_t)b * SEQ + t) * DM) : (const float4*)(P->ctx + ((size_t)b * CTXL + (t - SEQ)) * DM)) : (const float4*)(H + (size_t)row * DM);
#pragma unroll
                for (int j = 0; j < 4; ++j) v[u][j] = h[lane + 64 * j]; } }
#pragma unroll
        for (int u = 0; u < RU; ++u) { const int row = row0 + u * NGW;
            if (row < M) { const int b = row / RPB, t = row - b * RPB, w = t >= SEQ ? 2 : b;
                if (t >= SEQ && npart > 0) {
                    const float4* pp = (const float4*)(P->ws + WS_PART) + (size_t)(b * CTXL + (t - SEQ)) * 256 + lane;
                    for (int q = 0; q < npart; ++q) {
#pragma unroll
                        for (int j = 0; j < 4; ++j) { const float4 a = pp[(size_t)q * 512 * 256 + 64 * j]; v[u][j].x += a.x; v[u][j].y += a.y; v[u][j].z += a.z; v[u][j].w += a.w; } } }
#pragma unroll
                for (int j = 0; j < 4; ++j) ss[u] += v[u][j].x * v[u][j].x + v[u][j].y * v[u][j].y + v[u][j].z * v[u][j].z + v[u][j].w * v[u][j].w;
                if (from_input || (t >= SEQ && npart > 0)) {
#pragma unroll
                    for (int j = 0; j < 4; ++j) ((float4*)(H + (size_t)row * DM))[lane + 64 * j] = v[u][j]; }
                const float r = rsqrtf(wave_sum(ss[u]) * (1.f / DM) + 1e-6f);
                const float* sh = MODl + w * NMOD + shc * 1024; const float* sc = MODl + w * NMOD + scc * 1024;
#pragma unroll
                for (int j = 0; j < 4; ++j) { const int c = (lane + 64 * j) * 4; const float4 gg = *(const float4*)(g + c), s4 = *(const float4*)(sh + c), c4 = *(const float4*)(sc + c);
                    uint2 o; o.x = pk2(v[u][j].x * r * gg.x * (1.f + c4.x) + s4.x, v[u][j].y * r * gg.y * (1.f + c4.y) + s4.y);
                    o.y = pk2(v[u][j].z * r * gg.z * (1.f + c4.z) + s4.z, v[u][j].w * r * gg.w * (1.f + c4.w) + s4.w);
                    *(uint2*)(XN + (size_t)row * DM + c) = o; } } }
    }
}
__device__ __forceinline__ void final_phase(KP P) {
    int tid_ = threadIdx.x, bid_ = blockIdx.x; asm volatile("" : "+v"(tid_)); asm volatile("" : "+s"(bid_));
    const int lane = tid_ & 63, gw = bid_ * 8 + (tid_ >> 6), NGW = gridDim.x * 8;
    const float* H = (const float*)(P->ws + WS_H);
    for (int orow = gw; orow < NB * SEQ; orow += NGW) {
        const int b = orow / SEQ, t = orow - b * SEQ;
        const float4* h = (const float4*)(H + (size_t)(b * RPB + t) * DM);
        float4 v[4]; float ss = 0.f;
#pragma unroll
        for (int j = 0; j < 4; ++j) { v[j] = h[lane + 64 * j]; ss += v[j].x * v[j].x + v[j].y * v[j].y + v[j].z * v[j].z + v[j].w * v[j].w; }
        const float r = rsqrtf(wave_sum(ss) * (1.f / DM) + 1e-6f);
#pragma unroll
        for (int j = 0; j < 4; ++j) { const int c = (lane + 64 * j) * 4; const float4 gg = *(const float4*)(P->g_final + c);
            float4 o; o.x = v[j].x * r * gg.x; o.y = v[j].y * r * gg.y; o.z = v[j].z * r * gg.z; o.w = v[j].w * r * gg.w;
            *(float4*)(P->out + (size_t)orow * DM + c) = o; }
    }
}
template <class Epi> __device__ __forceinline__ void run_gemm(LAS unsigned char* lds, const bf16_t* A, const bf16_t* Bt, int N, int K, int lda, int blocked, int no_ctx, Epi E) {
    const int npass = (N == 1024 && !no_ctx) ? 2 : 1;
    for (int pass = 0; pass < npass; ++pass) {
        pg8::Gemm g{A, Bt, M, N, pass ? 256 : K, lda, blocked}; pg8::SplitOrder S; S.init((N == 1024 || no_ctx) ? 1 + pass : 0, M, N, (int)gridDim.x, (int)blockIdx.x, K / 256, 256);
        pg8::gemm_phase<Epi, pg8::SplitOrder, true, true>(lds, g, S, E);
    }
}

typedef float f32x16 __attribute__((ext_vector_type(16)));
typedef short bf16x8_t __attribute__((ext_vector_type(8)));
typedef short s16x4_t __attribute__((ext_vector_type(4)));
typedef unsigned u32x4_t __attribute__((ext_vector_type(4)));
typedef unsigned u32x2_t __attribute__((ext_vector_type(2)));
constexpr int AT_KBUF = 0, AT_VBUF = 32768, AT_VSTRIDE = 264, AT_VBYTES = 64 * AT_VSTRIDE, AT_COMB = AT_VBUF + 3 * AT_VBYTES, AT_COMB_PAIR = 34 * 64 * 4;
static_assert(AT_COMB + 4 * AT_COMB_PAIR <= 131072, "attention LDS map");
typedef float at_f32x2 __attribute__((ext_vector_type(2))); typedef __bf16 at_bf16x2 __attribute__((ext_vector_type(2)));
__device__ __forceinline__ unsigned cvtpk(float lo, float hi) { const at_f32x2 v = {lo, hi}; const at_bf16x2 b = __builtin_convertvector(v, at_bf16x2); return __builtin_bit_cast(unsigned, b); }

__device__ __forceinline__ void attn_unit(KP P, LAS unsigned char* lds, int l, int tid, int b, int hh, int q0, bool lat) {
    unsigned char* ws = P->ws;
    const int lane = tid & 63, r32 = lane & 31, hi = lane >> 5, wid = __builtin_amdgcn_readfirstlane(tid >> 6), g = wid >> 2, wq = wid & 3;
    const bool isB = hh >= 6; const int h = isB ? hh - 6 : hh, kvh = h / 3;
    const bf16_t* Q = (const bf16_t*)(ws + (isB ? WS_QB : WS_QA)) + ((size_t)b * RPB + q0 + 32 * wq + r32) * 384 + h * 64;
    const bf16_t* Kg = (const bf16_t*)(ws + (isB ? WS_KB : WS_KA)) + (size_t)b * RPB * 128 + kvh * 64;
    const bf16_t* Vg = (const bf16_t*)(ws + (isB ? WS_VTB : WS_VTA)) + ((size_t)(b * 2 + kvh) * 64) * RPB;
    int npre, kb_lo, nsteps;
    if (!lat) { npre = 2; kb_lo = 0; nsteps = 2; }
    else if (isB) { npre = 0; kb_lo = 0; nsteps = 66; }
    else { const int qb = q0 >> 7; kb_lo = qb > 0 ? qb - 1 : 0; const int kb_hi = qb < 63 ? qb + 1 : 63; npre = 2; nsteps = 2 + (kb_hi - kb_lo + 1); }
    const int kkey0 = tid >> 3, kc = tid & 7;
    const unsigned kdst0 = (unsigned)(kkey0 * 128 + ((kc ^ ((kkey0 >> 1) & 7)) * 16));
    const int vd0 = tid >> 4, vc = tid & 15;
    const unsigned vdst0 = (unsigned)(vd0 * AT_VSTRIDE + vc * 16);
    const bf16_t* kg0 = Kg + (size_t)kkey0 * 128 + kc * 8;
    const bf16_t* vg0 = Vg + (size_t)vd0 * RPB + vc * 8;
    u32x4_t pk0, pk1, pv0, pv1;
#define AT_KP0(s) ((s) < npre ? SEQ + 128 * (s) : 128 * (kb_lo + (s) - npre))
#define AT_LOADK(s) do { const int kp0_ = AT_KP0(s); pk0 = *(const u32x4_t*)(kg0 + (size_t)kp0_ * 128); pk1 = *(const u32x4_t*)(kg0 + (size_t)(kp0_ + 64) * 128); } while (0)
#define AT_LOADV(s) do { const int kp0_ = AT_KP0(s); pv0 = *(const u32x4_t*)(vg0 + kp0_); pv1 = *(const u32x4_t*)(vg0 + (size_t)32 * RPB + kp0_); } while (0)
#define AT_STOREK(buf) do { LAS unsigned char* kb_ = lds + AT_KBUF + (buf) * 16384; *(LAS u32x4_t*)(kb_ + kdst0) = pk0; *(LAS u32x4_t*)(kb_ + kdst0 + 8192) = pk1; } while (0)
#define AT_STOREV(buf) do { LAS unsigned char* vb_ = lds + AT_VBUF + (buf) * AT_VBYTES; \
        *(LAS u32x2_t*)(vb_ + vdst0) = (u32x2_t){pv0.x, pv0.y}; *(LAS u32x2_t*)(vb_ + vdst0 + 8) = (u32x2_t){pv0.z, pv0.w}; \
        *(LAS u32x2_t*)(vb_ + vdst0 + 32 * AT_VSTRIDE) = (u32x2_t){pv1.x, pv1.y}; *(LAS u32x2_t*)(vb_ + vdst0 + 32 * AT_VSTRIDE + 8) = (u32x2_t){pv1.z, pv1.w}; } while (0)
#define AT_QK_LD(buf) do { const LAS unsigned char* kb_ = lds + AT_KBUF + (buf) * 16384; \
        _Pragma("unroll") for (int d0 = 0; d0 < 4; ++d0) { kf[2 * d0] = *(const LAS bf16x8_t*)(kb_ + koff[d0]); kf[2 * d0 + 1] = *(const LAS bf16x8_t*)(kb_ + koff[d0] + 4096); } } while (0)
#define AT_QK_MMA(S0_, S1_) do { S0_ = __builtin_amdgcn_mfma_f32_32x32x16_bf16(kf[0], qf[0], negm, 0, 0, 0); S1_ = __builtin_amdgcn_mfma_f32_32x32x16_bf16(kf[1], qf[0], negm, 0, 0, 0); \
        _Pragma("unroll") for (int d0 = 1; d0 < 4; ++d0) { \
            S0_ = __builtin_amdgcn_mfma_f32_32x32x16_bf16(kf[2 * d0], qf[d0], S0_, 0, 0, 0); S1_ = __builtin_amdgcn_mfma_f32_32x32x16_bf16(kf[2 * d0 + 1], qf[d0], S1_, 0, 0, 0); } } while (0)
#define AT_QK(S0_, S1_, buf) do { AT_QK_LD(buf); __builtin_amdgcn_sched_barrier(0); AT_QK_MMA(S0_, S1_); } while (0)
    AT_LOADK(0); AT_LOADV(0);
    u32x4_t pk2, pk3;
    { const int kp1_ = AT_KP0(1); pk2 = *(const u32x4_t*)(kg0 + (size_t)kp1_ * 128); pk3 = *(const u32x4_t*)(kg0 + (size_t)(kp1_ + 64) * 128); }
    bf16x8_t qf[4], kf[8], vfr[8];
#pragma unroll
    for (int d0 = 0; d0 < 4; ++d0) qf[d0] = *(const bf16x8_t*)(Q + 16 * d0 + 8 * hi);
    const int key0 = 64 * g + r32; const int swz = (key0 >> 1) & 7;
    unsigned koff[4];
#pragma unroll
    for (int d0 = 0; d0 < 4; ++d0) koff[d0] = (unsigned)(key0 * 128 + (((2 * d0 + hi) ^ swz) * 16));
    const unsigned voff = (unsigned)(r32 * AT_VSTRIDE + 128 * g + 8 * hi);
    f32x16 O0 = {}, O1 = {};
    float m = 0.f, lsum = 0.f, pend = 0.f;
    f32x16 negm = {};
    constexpr float AT_THR = 8.f;
    const int qp = q0 + 32 * wq + r32;
    AT_STOREK(0); AT_STOREV(0);
    { LAS unsigned char* kb_ = lds + AT_KBUF + 16384; *(LAS u32x4_t*)(kb_ + kdst0) = pk2; *(LAS u32x4_t*)(kb_ + kdst0 + 8192) = pk3; }
    __syncthreads();
    f32x16 S0, S1;
    AT_QK(S0, S1, 0);
    __syncthreads();
#define AT_PV_LD(vs) do { const LAS unsigned char* vb_ = lds + AT_VBUF + (vs) * AT_VBYTES; \
        _Pragma("unroll") for (int sl = 0; sl < 4; ++sl) _Pragma("unroll") for (int dd = 0; dd < 2; ++dd) { \
            const u32x2_t lo = *(const LAS u32x2_t*)(vb_ + voff + dd * 32 * AT_VSTRIDE + 32 * sl), hi8 = *(const LAS u32x2_t*)(vb_ + voff + dd * 32 * AT_VSTRIDE + 32 * sl + 16); \
            const u32x4_t vw = {lo.x, lo.y, hi8.x, hi8.y}; vfr[2 * sl + dd] = __builtin_bit_cast(bf16x8_t, vw); } } while (0)
#define AT_PV_MMA() do { _Pragma("unroll") for (int sl = 0; sl < 4; ++sl) { const bf16x8_t pf = __builtin_bit_cast(bf16x8_t, pp[sl]); \
            O0 = __builtin_amdgcn_mfma_f32_32x32x16_bf16(vfr[2 * sl], pf, O0, 0, 0, 0); O1 = __builtin_amdgcn_mfma_f32_32x32x16_bf16(vfr[2 * sl + 1], pf, O1, 0, 0, 0); } } while (0)
#define AT_PV(vs) do { AT_PV_LD(vs); __builtin_amdgcn_sched_barrier(0); AT_PV_MMA(); } while (0)
    u32x4_t pp[4] = {};
    int vs_prev = 0, vs_cur = 0, vs_next = 1;
    for (int s = 0; s < nsteps; ++s) {
        if (s + 2 < nsteps) AT_LOADK(s + 2);
        if (s + 1 < nsteps) AT_LOADV(s + 1);
        f32x16 N0, N1;
        if (lat && !isB && s >= npre) {
            const int kpb = AT_KP0(s) + 64 * g + 4 * hi - qp;
#pragma unroll
            for (int r = 0; r < 16; ++r) { const int dlt = kpb + (r & 3) + 8 * (r >> 2);
                if (dlt > 128 || dlt < -128) S0[r] = -1e30f;
                if (dlt + 32 > 128 || dlt + 32 < -128) S1[r] = -1e30f; }
        }
        if (__any(pend != 0.f)) { S0 = S0 - pend; S1 = S1 - pend; }
        AT_QK_LD((s + 1) & 1);
        __builtin_amdgcn_sched_barrier(0);
        __builtin_amdgcn_s_setprio(1); AT_QK_MMA(N0, N1); __builtin_amdgcn_s_setprio(0);
        AT_PV_LD(vs_prev);
        __builtin_amdgcn_sched_barrier(0);
        __builtin_amdgcn_s_setprio(1); AT_PV_MMA(); __builtin_amdgcn_s_setprio(0);
        __builtin_amdgcn_sched_barrier(0);
        float rm = __builtin_fmaxf(__builtin_fmaxf(S0[0], S1[0]), S0[1]);
#pragma unroll
        for (int r = 1; r < 16; ++r) rm = __builtin_fmaxf(__builtin_fmaxf(rm, S1[r]), r < 15 ? S0[r + 1] : S1[r]);
        { const auto rr = __builtin_amdgcn_permlane32_swap(__float_as_uint(rm), __float_as_uint(rm), false, false); rm = fmaxf(__uint_as_float(rr[0]), __uint_as_float(rr[1])); }
        float alpha = 1.f; pend = 0.f;
        if (s == 0 || __any(rm > AT_THR)) {
            const float dl = s == 0 ? rm : fmaxf(rm, 0.f);
            S0 = S0 - dl; S1 = S1 - dl; negm = negm - dl; m += dl; pend = dl;
            alpha = __builtin_amdgcn_exp2f(-dl); lsum *= alpha;
        }
        float ps = 0.f;
#pragma unroll
        for (int r = 0; r < 16; ++r) { S0[r] = __builtin_amdgcn_exp2f(S0[r]); S1[r] = __builtin_amdgcn_exp2f(S1[r]); ps += S0[r] + S1[r]; }
        lsum += ps;
#pragma unroll
        for (int sl = 0; sl < 4; ++sl) { const int rb = 8 * (sl & 1);
            if (sl < 2) pp[sl] = (u32x4_t){cvtpk(S0[rb], S0[rb + 1]), cvtpk(S0[rb + 2], S0[rb + 3]), cvtpk(S0[rb + 4], S0[rb + 5]), cvtpk(S0[rb + 6], S0[rb + 7])};
            else pp[sl] = (u32x4_t){cvtpk(S1[rb], S1[rb + 1]), cvtpk(S1[rb + 2], S1[rb + 3]), cvtpk(S1[rb + 4], S1[rb + 5]), cvtpk(S1[rb + 6], S1[rb + 7])}; }
        __builtin_amdgcn_sched_barrier(0);
        if (__any(alpha != 1.f)) {
#pragma unroll
            for (int r = 0; r < 16; ++r) { O0[r] *= alpha; O1[r] *= alpha; } }
        if (s + 2 < nsteps) AT_STOREK(s & 1);
        if (s + 1 < nsteps) AT_STOREV(vs_next);
        __syncthreads();
        S0 = N0; S1 = N1;
        vs_prev = vs_cur; vs_cur = vs_next; vs_next = vs_next == 2 ? 0 : vs_next + 1;
    }
    AT_PV(vs_prev);
#undef AT_PV
#undef AT_PV_LD
#undef AT_PV_MMA
#undef AT_QK_LD
#undef AT_QK_MMA
#undef AT_LOADK
#undef AT_LOADV
#undef AT_STOREK
#undef AT_STOREV
#undef AT_QK
    float ltot = lsum + __shfl_xor(lsum, 32);
    LAS float* comb = (LAS float*)(lds + AT_COMB + wq * AT_COMB_PAIR);
    if (g == 1) {
        comb[lane] = m; comb[64 + lane] = ltot;
#pragma unroll
        for (int r = 0; r < 16; ++r) { comb[(2 + r) * 64 + lane] = O0[r]; comb[(18 + r) * 64 + lane] = O1[r]; }
    }
    __syncthreads();
    if (g == 0) {
        const float m1 = comb[lane], l1 = comb[64 + lane];
        float mf = fmaxf(m, m1); float sk = 0.f;
        if (!isB) { const float s2 = P->sink[l * 6 + h] * LOG2E; mf = fmaxf(mf, s2); sk = __builtin_amdgcn_exp2f(s2 - mf); }
        const float a0 = __builtin_amdgcn_exp2f(m - mf), a1 = __builtin_amdgcn_exp2f(m1 - mf);
        const float inv = 1.f / (ltot * a0 + l1 * a1 + sk);
        const float c0 = a0 * inv, c1 = a1 * inv;
        bf16_t* dst = (bf16_t*)(ws + WS_XN) + ((size_t)b * RPB + q0 + 32 * wq + r32) * DM + (isB ? 384 : 0) + h * 64 + 4 * hi;
#pragma unroll
        for (int rq = 0; rq < 4; ++rq) {
            float o[8];
#pragma unroll
            for (int i = 0; i < 4; ++i) { o[i] = O0[4 * rq + i] * c0 + comb[(2 + 4 * rq + i) * 64 + lane] * c1; o[4 + i] = O1[4 * rq + i] * c0 + comb[(18 + 4 * rq + i) * 64 + lane] * c1; }
            *(u32x2_t*)(dst + 8 * rq) = (u32x2_t){cvtpk(o[0], o[1]), cvtpk(o[2], o[3])};
            *(u32x2_t*)(dst + 32 + 8 * rq) = (u32x2_t){cvtpk(o[4], o[5]), cvtpk(o[6], o[7])};
        }
    }
    __syncthreads();
#undef AT_KP0
}
__device__ __forceinline__ void attn_phase(KP P, LAS unsigned char* lds, int l) {
    int tid_ = threadIdx.x, bid_ = blockIdx.x; asm volatile("" : "+v"(tid_)); asm volatile("" : "+s"(bid_));
    const int G = gridDim.x;
    const bool xcd = (G == 256);
    const int NU = 1536 + (l == 0 ? 48 : 0);
    for (int it = 0;; ++it) {
        int idx;
        if (xcd) { if (it >= 7) break; idx = it < 6 ? (it / 3) * 768 + (bid_ & 7) * 96 + (it % 3) * 32 + (bid_ >> 3) : 1536 + bid_; if (idx >= NU) break; }
        else { idx = bid_ + it * G; if (idx >= NU) break; }
        int b, hh, q0; bool lat = true;
        if (idx < 768) { b = idx / 384; hh = 6 + (idx % 384) / 64; q0 = (idx & 63) * 128; }
        else if (idx < 1536) { const int u = idx - 768; b = u / 384; hh = (u % 384) / 64; q0 = (u & 63) * 128; }
        else { const int u = idx - 1536; b = u / 24; hh = (u % 24) >> 1; q0 = SEQ + 128 * (u & 1); lat = false; }
        attn_unit(P, lds, l, tid_, b, hh, q0, lat);
    }
}

__device__ __forceinline__ void fft1_phase(KP P, int l) {
    int tid_ = threadIdx.x, bid_ = blockIdx.x; asm volatile("" : "+v"(tid_)); asm volatile("" : "+s"(bid_));
    unsigned char* ws = P->ws;
    const int lane = tid_ & 63, r32 = lane & 31, hi = lane >> 5, w = tid_ >> 6;
    const bf16_t* D1 = (const bf16_t*)(ws + WS_TAB + TAB_D1_BYTES); const float* TAB = (const float*)(ws + WS_TAB);
    for (int it = bid_; it < 256; it += gridDim.x) {
        const int b = it >> 7, l2 = it & 127, ch = 32 * w + r32;
        const unsigned* vsrc = (const unsigned*)(ws + WS_VS) + ((size_t)(b * SEQ + l2 + 512 * hi)) * 256 + ch;
        u32x4_t bfr[8];
#pragma unroll
        for (int s = 0; s < 8; ++s)
#pragma unroll
            for (int j = 0; j < 4; ++j) bfr[s][j] = vsrc[(size_t)(128 * (8 * s + j)) * 256];
        f32x16 acc[4] = {};
#pragma unroll
        for (int s = 0; s < 8; ++s) {
            const bf16x8_t bf = __builtin_bit_cast(bf16x8_t, bfr[s]);
#pragma unroll
            for (int mt = 0; mt < 4; ++mt) { const bf16x8_t af = *(const bf16x8_t*)(D1 + (32 * mt + r32) * 128 + 16 * s + 8 * hi);
                acc[mt] = __builtin_amdgcn_mfma_f32_32x32x16_bf16(af, bf, acc[mt], 0, 0, 0); }
        }
        unsigned* zs = (unsigned*)(ws + WS_ZS);
#pragma unroll
        for (int mt = 0; mt < 4; ++mt)
#pragma unroll
            for (int rq = 0; rq < 4; ++rq)
#pragma unroll
                for (int e = 0; e < 2; ++e) {
                    const int k1 = 16 * mt + 4 * rq + 2 * hi + e; const int idx = k1 * l2;
                    const float ct = TAB[TAB_COS + idx], st = TAB[TAB_COS + ((idx - 2048) & 8191)];
                    const float yr = acc[mt][4 * rq + 2 * e], yi = acc[mt][4 * rq + 2 * e + 1];
                    zs[((size_t)(b * 64 + k1) * 128 + l2) * 256 + ch] = cvtpk(yr * ct + yi * st, yi * ct - yr * st);
                }
    }
    if (l == 0) {
        const unsigned* VC = (const unsigned*)(ws + WS_VC); bf16_t* OM = (bf16_t*)(ws + WS_XN);
        for (int gt = bid_ * 512 + tid_; gt < NB * CTXL * 256; gt += gridDim.x * 512) {
            const int ch = gt & 255, k = (gt >> 8) & 255, b = gt >> 16;
            const unsigned* vp = VC + (size_t)(b * 256) * 256 + ch; float a = 0.f;
#pragma unroll 8
            for (int j = 0; j < 256; ++j) { const unsigned pk = vp[(size_t)j * 256]; const float vr = __uint_as_float(pk << 16), vi = __uint_as_float(pk & 0xffff0000u);
                const int ix = ((k * j) & 255) * 32; a += vr * TAB[TAB_COS + ix] + vi * TAB[TAB_COS + ((ix - 2048) & 8191)]; }
            OM[(size_t)(b * RPB + SEQ + k) * DM + 768 + ch] = f2bf(a * (1.f / 128.f));
        }
    }
}
__device__ __forceinline__ void fft3_phase(KP P, LAS unsigned char* lds, int l) {
    int tid_ = threadIdx.x, bid_ = blockIdx.x; asm volatile("" : "+v"(tid_)); asm volatile("" : "+s"(bid_));
    unsigned char* ws = P->ws;
    const int lane = tid_ & 63, r32 = lane & 31, hi = lane >> 5, w = tid_ >> 6;
    const bf16_t* D3 = (const bf16_t*)(ws + WS_TAB + TAB_D3_BYTES); bf16_t* OM = (bf16_t*)(ws + WS_XN);
    for (int it = bid_; it < 256; it += gridDim.x) {
        const int b = it >> 7, k1 = (it & 127) >> 1, chh = it & 1, ch = 32 * (4 * chh + (w & 3)) + r32, mh = w >> 2;
        const unsigned* zsrc = (const unsigned*)(ws + WS_ZS) + ((size_t)(b * 64 + k1) * 128 + 4 * hi) * 256 + ch;
        f32x16 acc[2] = {};
#pragma unroll
        for (int sh = 0; sh < 2; ++sh) {
            u32x4_t bfr[8];
#pragma unroll
            for (int s = 0; s < 8; ++s)
#pragma unroll
                for (int j = 0; j < 4; ++j) bfr[s][j] = zsrc[(size_t)(8 * (8 * sh + s) + j) * 256];
#pragma unroll
            for (int s = 0; s < 8; ++s) {
                const bf16x8_t bf = __builtin_bit_cast(bf16x8_t, bfr[s]);
#pragma unroll
                for (int mi = 0; mi < 2; ++mi) { const bf16x8_t af = *(const bf16x8_t*)(D3 + (32 * (2 * mh + mi) + r32) * 256 + 16 * (8 * sh + s) + 8 * hi);
                    acc[mi] = __builtin_amdgcn_mfma_f32_32x32x16_bf16(af, bf, acc[mi], 0, 0, 0); }
            }
        }
#pragma unroll
        for (int mi = 0; mi < 2; ++mi)
#pragma unroll
            for (int r = 0; r < 16; ++r) { const int k2 = 32 * (2 * mh + mi) + (r & 3) + 8 * (r >> 2) + 4 * hi;
                OM[((size_t)b * RPB + k1 + 64 * k2) * DM + 768 + ch] = f2bf(acc[mi][r] * 0.0013810679320049757f); }
    }
}

#define GAS __attribute__((address_space(1)))
#define XB_TMO      128
#define XB_XCNT(j)  (256  + 64 * (j))
#define XB_XSUB(j)  (1280 + 64 * (j))
#define XB_XGEN(j)  (2304 + 64 * (j))
#define XB_TOP      3328
#define XB_TOPGEN   3392
#define XCD_BAR_WORDS 3456
#define XB_SPIN_CAP (1u << 18)

__device__ __forceinline__ unsigned xb_ld(unsigned* p)              { return __hip_atomic_load(p, __ATOMIC_RELAXED, __HIP_MEMORY_SCOPE_AGENT); }
__device__ __forceinline__ unsigned xb_add(unsigned* p, unsigned v) { return __hip_atomic_fetch_add(p, v, __ATOMIC_RELAXED, __HIP_MEMORY_SCOPE_AGENT); }
__device__ __forceinline__ unsigned xb_xcc_id() { return (unsigned)__builtin_amdgcn_s_getreg((3 << 11) | 20) & 0xFu; }
#define XB_SPIN(cond, bar) do { unsigned _sp = 0; while (cond) { __builtin_amdgcn_s_sleep(1); \
    if ((++_sp & 255u) == 0u) { if (xb_ld(&(bar)[XB_TMO])) break; if (_sp > XB_SPIN_CAP) { atomicAdd(&(bar)[XB_TMO], 1u); break; } } } } while (0)

struct XcdBarrier {
    unsigned* bar; unsigned x;
    volatile LAS unsigned* st;
};

__device__ __forceinline__ XcdBarrier xcd_barrier_post(unsigned* bar, volatile LAS unsigned* st) {
    XcdBarrier b; b.bar = bar; b.x = xb_xcc_id(); b.st = st;
    if (threadIdx.x == 0) (void)xb_add(&bar[XB_XCNT(b.x)], 1u);
    return b;
}
__device__ __forceinline__ void xcd_barrier_complete(unsigned* bar, unsigned x, unsigned& nloc, unsigned& nx) {
    const unsigned G = gridDim.x * gridDim.y * gridDim.z;
    unsigned sum, cnt, mine, sp = 0u;
    for (;;) {
        sum = 0u; cnt = 0u; mine = 0u;
#pragma unroll
        for (unsigned j = 0; j < 16; ++j) { const unsigned c = xb_ld(&bar[XB_XCNT(j)]); sum += c; cnt += (c > 0u) ? 1u : 0u; mine = (j == x) ? c : mine; }
        if (sum == G) break;
        __builtin_amdgcn_s_sleep(1);
        if ((++sp & 255u) == 0u) { if (xb_ld(&bar[XB_TMO])) break; if (sp > XB_SPIN_CAP) { atomicAdd(&bar[XB_TMO], 1u); break; } }
    }
    nloc = mine > 0u ? mine : 1u; nx = cnt > 0u ? cnt : 1u;
}

__device__ __forceinline__ void xcd_barrier(const XcdBarrier& b) {
    asm volatile("s_waitcnt vmcnt(0)" ::: "memory");
    __syncthreads();
    if (threadIdx.x == 0) {
        unsigned* bar = b.bar;
        __builtin_amdgcn_s_waitcnt(0);
        unsigned nloc = b.st[0], nx = b.st[1];
        if (nloc == 0u) { xcd_barrier_complete(bar, b.x, nloc, nx); b.st[0] = nloc; b.st[1] = nx; }
        const unsigned old = xb_add(&bar[XB_XSUB(b.x)], 1u);
        const unsigned gen = old / nloc;
        if (old + 1u == (gen + 1u) * nloc) {
            __builtin_amdgcn_fence(__ATOMIC_RELEASE, "agent");
            asm volatile("s_waitcnt vmcnt(0)" ::: "memory");
            const unsigned og = xb_add(&bar[XB_TOP], 1u);
            const unsigned tg = og / nx;
            if (og + 1u == (tg + 1u) * nx) xb_add(&bar[XB_TOPGEN], 1u);
            else XB_SPIN(xb_ld(&bar[XB_TOPGEN]) == tg, bar);
            __builtin_amdgcn_fence(__ATOMIC_ACQUIRE, "agent");
            xb_add(&bar[XB_XGEN(b.x)], 1u);
            asm volatile("s_waitcnt vmcnt(0)" ::: "memory");
        } else {
            XB_SPIN(xb_ld(&bar[XB_XGEN(b.x)]) == gen, bar);
            __builtin_amdgcn_fence(__ATOMIC_ACQUIRE, "agent");
            asm volatile("s_waitcnt vmcnt(0)" ::: "memory");
        }
    }
    __syncthreads();
}

constexpr int LDS_BYTES = 132096;
constexpr int PH_FINAL = 25, PH_END = 26;
constexpr size_t WS_BAR = WS_MOD + 262144;
constexpr int MISC_OFF = 131072;
__global__ void __launch_bounds__(512, 2) mega(Params Pk, int ph_lo, int ph_hi) {
#if defined(__HIP_DEVICE_COMPILE__)
    extern __shared__ __attribute__((aligned(16))) unsigned char lds_raw[];
    LAS unsigned char* lds = (LAS unsigned char*)lds_raw;
    volatile LAS unsigned* MISC = (volatile LAS unsigned*)(lds + MISC_OFF);
    if (threadIdx.x < 32) MISC[threadIdx.x] = 0u;
    __syncthreads();
    XcdBarrier bar; bar.bar = nullptr; bar.x = 0; bar.st = nullptr;
    for (int ph = ph_lo; ph < ph_hi; ++ph) {
        KP P = (KP)__builtin_amdgcn_kernarg_segment_ptr(); asm volatile("" : "+s"(P));
        if (ph == 0 && blockIdx.x == 0) { unsigned* bw = (unsigned*)(P->ws + WS_BAR); for (int i = threadIdx.x; i < XCD_BAR_WORDS; i += 512) bw[i] = 0u; }
        unsigned char* ws = P->ws;
        float* H = (float*)(ws + WS_H); bf16_t* XN = (bf16_t*)(ws + WS_XN); bf16_t* MID = (bf16_t*)(ws + WS_MID);
        if (ph == 0) prologue_phase(P, lds);
        else if (ph == PH_FINAL) final_phase(P);
        else {
            const int l = (ph - 1) / 12, s = (ph - 1) % 12;
            const float* MODl = (const float*)(ws + WS_MOD) + (size_t)l * 3 * NMOD;
            const bf16_t* WT = (const bf16_t*)(ws + WS_WT) + (size_t)l * WT_L;
            if (s == 0 || s == 3 || s == 8) {
                const float* g = (s == 0 ? P->g_ffn1 : s == 3 ? P->g_mix : P->g_ffn2) + l * 1024; const int shc = s == 0 ? 0 : s == 3 ? 3 : 6;
                norm_phase(P, g, MODl, shc, shc + 1, ph == 1, ph == 1 ? 0 : (s == 8 ? (l == 1 ? 0 : 3) : 10));
            } else if (s == 1 || s == 2 || s == 4 || s == 7 || s == 9 || s == 10) {
                const int mode = (s == 1 || s == 9) ? 0 : (s == 4 ? 2 : 1);
                pg8::EpiAll E{ws, P->g_qn + l * 64, P->g_kn + l * 64, mode, l, s == 2 ? 2 : s == 7 ? 5 : 8, s == 7 ? 1.0f : 0.5f};
                const bf16_t* A = (s == 2 || s == 10) ? MID : XN;
                const bf16_t* Bt = WT + (mode == 0 ? WT_GU + (size_t)(s == 9 ? 1 : 0) * 5632 * 1024 : mode == 2 ? WT_IN : s == 7 ? WT_OUT : WT_DN + (size_t)(s == 10 ? 1 : 0) * 1024 * MIDP);
                const int N = mode == 0 ? 5632 : mode == 2 ? NIN : 1024, K = (s == 2 || s == 10) ? DFF : 1024;
                run_gemm(lds, A, Bt, N, K, (s == 2 || s == 10) ? DFF : 1024, (s == 2 || s == 10) ? 1 : 0, (l == 1 && s >= 7) ? 1 : 0, E);
            }
            else if (s == 5) {
#if FAST_FFT
                fft1_phase(P, l);
#endif
#if FAST_ATTN
                attn_phase(P, lds, l);
#endif
            }
#if FAST_FFT
            else if (s == 6) fft3_phase(P, lds, l);
#endif
        }
        if (ph + 1 < ph_hi) {
            if (ph == 0) { cg::this_grid().sync(); bar = xcd_barrier_post((unsigned*)(P->ws + WS_BAR), MISC + 8); }
            else xcd_barrier(bar);
        }
    }
#endif
}

extern "C" void kernel_launch(void* const* d_in, const int* in_sizes, int n_in, void* d_out, int out_size, void* d_ws, size_t ws_size, hipStream_t stream) {
    static int grid = 0;
    if (grid == 0) {
        if (ws_size < WS_END || n_in < 22) { fprintf(stderr, "kernel_launch: ws too small (%zu) or n_in %d\n", ws_size, n_in); grid = -1; return; }
        if (hipFuncSetAttribute((const void*)mega, hipFuncAttributeMaxDynamicSharedMemorySize, LDS_BYTES) != hipSuccess) { fprintf(stderr, "kernel_launch: hipFuncSetAttribute failed\n"); grid = -1; return; }
        int dev = 0, cus = 0, per_cu = 0; hipGetDevice(&dev); hipDeviceGetAttribute(&cus, hipDeviceAttributeMultiprocessorCount, dev);
        if (hipOccupancyMaxActiveBlocksPerMultiprocessor(&per_cu, (const void*)mega, 512, LDS_BYTES) != hipSuccess || per_cu < 1) { fprintf(stderr, "kernel_launch: occupancy query says %d\n", per_cu); grid = -1; return; }
        grid = cus;
    }
    if (grid < 0) return;
    Params P{};
    const float** pp = (const float**)&P;
    for (int i = 0; i < 22; ++i) pp[i] = (const float*)d_in[i];
    P.out = (float*)d_out; P.ws = (unsigned char*)d_ws;
    int lo = 0, hi = PH_END;
    void* args[] = {&P, &lo, &hi};
    hipError_t e = hipLaunchCooperativeKernel((const void*)mega, dim3(grid), dim3(512), args, LDS_BYTES, stream);
    if (e != hipSuccess) fprintf(stderr, "kernel_launch: cooperative launch failed: %s (grid %d)\n", hipGetErrorString(e), grid);
}
```

```cpp
#include <hip/hip_runtime.h>
#include <hip/hip_cooperative_groups.h>
#include <stdint.h>
#include <cstdio>
namespace cg = cooperative_groups;

typedef unsigned short bf16_t;
__device__ __forceinline__ float bf2f(bf16_t v) { return __uint_as_float(((unsigned)v) << 16); }
__device__ __forceinline__ bf16_t f2bf(float f) { unsigned u = __float_as_uint(f); return (bf16_t)((u + 0x7fffu + ((u >> 16) & 1u)) >> 16); }
__device__ __forceinline__ unsigned pk2(float lo, float hi) { return (unsigned)f2bf(lo) | ((unsigned)f2bf(hi) << 16); }

constexpr int MIDP = 2880;
constexpr int DM = 1024, NB = 2, SEQ = 8192, CTXL = 256, RPB = SEQ + CTXL, M = NB * RPB, DFF = 2816, DIN = 1536, NMOD = 9216, NIN = 1792;
constexpr float QSCALE = 0.125f * 1.4426950408889634f;
constexpr float LOG2E = 1.4426950408889634f;
constexpr size_t MiB = 1u << 20;
constexpr size_t WS_H = 0, WS_XN = 66 * MiB, WS_MID = 99 * MiB;
constexpr size_t WS_QA = 99 * MiB, WS_QB = 112 * MiB, WS_KA = 125 * MiB, WS_KB = 130 * MiB, WS_VTA = 135 * MiB, WS_VTB = 140 * MiB, WS_VS = 145 * MiB, WS_ZS = 161 * MiB, WS_VC = 177 * MiB;
constexpr size_t WS_MOD = 201129984, WS_TAB = WS_MOD + 294912, WS_WT = WS_MOD + 524288, WS_PART = 270 * MiB, WS_END = 290 * MiB;
constexpr int TAB_COS = 0, TAB_ROPE = 8192;
constexpr size_t TAB_D1_BYTES = 65536, TAB_D3_BYTES = 65536 + 32768;
constexpr size_t WT_GU = 0, WT_DN = 2ull * 5632 * 1024, WT_IN = WT_DN + 2ull * 1024 * MIDP, WT_OUT = WT_IN + 1792ull * 1024, WT_L = WT_OUT + 1024ull * 1024;
static_assert(WS_WT + 2 * WT_L * 2 <= WS_PART, "ws map");

__device__ __forceinline__ float silu_f(float x) { return x * __builtin_amdgcn_rcpf(1.f + __expf(-x)); }
__device__ __forceinline__ int row_w(int row) { int b = row / RPB, t = row - b * RPB; return t >= SEQ ? 2 : b; }

struct Params {
    const float *x, *c, *ctx, *cctx, *w_ada, *b_ada, *g_ffn1, *g_mix, *g_ffn2, *w_in, *g_qn, *g_kn, *sink, *w_four, *w_out, *w1g, *w1u, *w1d, *w2g, *w2u, *w2d, *g_final;
    float* out; unsigned char* ws;
};
typedef const __attribute__((address_space(4))) Params* KP;

namespace pg8 {
#define PG8_LAS __attribute__((address_space(3)))
typedef unsigned short bf16_t;
typedef short bf16x8 __attribute__((ext_vector_type(8)));
typedef float f32x4 __attribute__((ext_vector_type(4)));
typedef unsigned u32x4 __attribute__((ext_vector_type(4)));
constexpr int BM = 256, BK = 64, HALF = 128, HTB = HALF * BK * 2  , STAGE_BYTES = 8 * HTB, NXCD = 8, WGM = 8;

__host__ __device__ __forceinline__ int lds_byte(int r, int c) { const int st = (r >> 4) * 2 + (c >> 5), rr = r & 15, cc = c & 31, ob = rr * 64 + cc * 2; return st * 1024 + (ob ^ (((ob >> 9) & 1) << 5)); }
__host__ __device__ __forceinline__ void stage_rc(int b, int& R, int& C) { const int st = b / 1024, sb = b % 1024, swz = sb ^ (((sb >> 9) & 1) << 5); R = (st >> 1) * 16 + swz / 64; C = (st & 1) * 32 + (swz % 64) / 2; }
__host__ __device__ __forceinline__ int perm32(int rho) { const int n = rho >> 4, i = rho & 15; return 8 * (i >> 2) + 4 * n + (i & 3); }

struct Unit { int pm, pn, ko; };
struct Gemm { const bf16_t* A; const bf16_t* Bt; int M, N, K, ld, blocked; };

struct StaticOrder {
    int nM, nN, nwg, G, c;
    __host__ __device__ void init(int M, int N, int G_, int c_) { nM = M / BM; nN = N / BM; nwg = nM * nN; G = G_; c = c_; }
    __host__ __device__ bool next(int i, Unit& u) const {
        const long L = (long)i * G + c; if (L >= nwg) return false;
        int wgid = (int)L; { const int q = nwg / NXCD, r = nwg % NXCD, xcd = wgid % NXCD, off = wgid / NXCD; wgid = (xcd < r ? xcd * (q + 1) : r * (q + 1) + (xcd - r) * q) + off; }
        const int nig = WGM * nN, gid = wgid / nig, fm = gid * WGM, gsz = (nM - fm) < WGM ? (nM - fm) : WGM;
        u.pm = fm + ((wgid % nig) % gsz); u.pn = (wgid % nig) / gsz; return true;
    }
    __device__ __forceinline__ void a_ready(const Unit&) const {}
    __device__ __forceinline__ void done(const Unit&) const {}
};

struct SplitOrder {
    int mode, nchunk, kchunk; StaticOrder S;
    __device__ void init(int mode_, int Mrows, int N, int G, int c, int nchunk_, int kchunk_) { mode = mode_; nchunk = nchunk_; kchunk = kchunk_; S.init(mode_ == 1 ? 64 * BM : Mrows, N, G, c); }
    __device__ bool next(int i, Unit& u) const {
        if (mode == 2) { const long L = (long)i * S.G + S.c; if (L >= 8 * nchunk) return false; const int un = (int)L / nchunk, ch = (int)L - un * nchunk;
            u.pm = (un >> 2) ? 65 : 32; u.pn = un & 3; u.ko = ch * kchunk; return true; }
        if (!S.next(i, u)) return false;
        u.ko = 0; if (mode == 1) u.pm += u.pm >> 5;
        return true;
    }
    __device__ __forceinline__ void a_ready(const Unit&) const {}
    __device__ __forceinline__ void done(const Unit&) const {}
};

__device__ __forceinline__ unsigned cvt_pk_bf16(float lo, float hi) { unsigned r; asm("v_cvt_pk_bf16_f32 %0, %1, %2" : "=v"(r) : "v"(lo), "v"(hi)); return r; }
__device__ __forceinline__ int tile_w(int pm) { const int b = pm / 33, wi = pm - b * 33; return wi == 32 ? 2 : b; }
struct EpiSwiglu {
    static constexpr bool PERM = false, AFTER_DRAIN = false;
    bf16_t* O;
    __device__ __forceinline__ void operator()(const f32x4 (&acc)[2][2][4][2], const Unit& u, int wr, int wc, int fr, int fq) const {
        const int row0 = u.pm * BM + wr * 64 + fr, col = u.pn * 128 + wc * 32 + fq * 8;
#pragma unroll
        for (int ai = 0; ai < 2; ++ai)
#pragma unroll
            for (int m = 0; m < 4; ++m) {
                const f32x4 g0 = acc[ai][0][m][0], u0 = acc[ai][1][m][0], g1 = acc[ai][0][m][1], u1 = acc[ai][1][m][1];
                u32x4 w;
                w.x = cvt_pk_bf16(silu_f(g0[0]) * u0[0], silu_f(g0[1]) * u0[1]); w.y = cvt_pk_bf16(silu_f(g0[2]) * u0[2], silu_f(g0[3]) * u0[3]);
                w.z = cvt_pk_bf16(silu_f(g1[0]) * u1[0], silu_f(g1[1]) * u1[1]); w.w = cvt_pk_bf16(silu_f(g1[2]) * u1[2], silu_f(g1[3]) * u1[3]);
                *(u32x4*)(O + (size_t)u.pm * BM * DFF + (size_t)(col >> 6) * (BM * 64) + (size_t)(wr * 64 + fr + ai * HALF + m * 16) * 64 + (col & 63)) = w;
            }
    }
};
struct EpiRes {
    static constexpr bool PERM = false, AFTER_DRAIN = false;
    float* H; const float* MODl; int gate_chunk; float coef; float* PART;
    __device__ __forceinline__ void operator()(const f32x4 (&acc)[2][2][4][2], const Unit& u, int wr, int wc, int fr, int fq) const {
        const float* gate = MODl + tile_w(u.pm) * NMOD + gate_chunk * 1024;
        const bool part = u.ko != 0;
        float* base = part ? PART + ((size_t)((u.ko >> 8) - 1) * 512 + (u.pm == 32 ? 0 : 256) + wr * 64 + fr) * DM : H + (size_t)(u.pm * BM + wr * 64 + fr) * DM;
#pragma unroll
        for (int bj = 0; bj < 2; ++bj)
#pragma unroll
            for (int n = 0; n < 2; ++n) {
                const int col = u.pn * BM + bj * HALF + wc * 32 + n * 16 + fq * 4;
                const f32x4 gv = *(const f32x4*)(gate + col) * coef;
                f32x4 old[2][4];
#pragma unroll
                for (int ai = 0; ai < 2; ++ai)
#pragma unroll
                    for (int m = 0; m < 4; ++m) old[ai][m] = part ? (f32x4){0.f, 0.f, 0.f, 0.f} : *(const f32x4*)(base + (size_t)(ai * HALF + m * 16) * DM + col);
#pragma unroll
                for (int ai = 0; ai < 2; ++ai)
#pragma unroll
                    for (int m = 0; m < 4; ++m) *(f32x4*)(base + (size_t)(ai * HALF + m * 16) * DM + col) = old[ai][m] + gv * acc[ai][bj][m][n];
            }
    }
};
struct EpiWin {
    static constexpr bool PERM = false, AFTER_DRAIN = false;
    const float* gqn; const float* gkn; const float* ROPE;
    bf16_t *QA, *QB, *KA, *KB, *VTA, *VTB; unsigned *VS, *VC;
    __device__ __forceinline__ void operator()(const f32x4 (&acc)[2][2][4][2], const Unit& u, int wr, int wc, int fr, int fq) const {
        const int unit = u.pn * 4 + wc;
        const int b = u.pm / 33, wi = u.pm - b * 33; const bool lat = wi < 32; const int t0 = wi * 256;
        if (unit < 20) {
            const bool isB = unit >= 10; const int ul = isB ? unit - 10 : unit;
            const bool isq = ul < 6, isk = ul >= 6 && ul < 8;
            f32x4 gg[2][2];
            if (isB && (isq || isk)) { const float* g = isq ? gqn : gkn;
#pragma unroll
                for (int bj = 0; bj < 2; ++bj)
#pragma unroll
                    for (int n = 0; n < 2; ++n) gg[bj][n] = *(const f32x4*)(g + 32 * bj + 16 * n + 4 * fq); }
#pragma unroll
            for (int ai = 0; ai < 2; ++ai)
#pragma unroll
                for (int m = 0; m < 4; ++m) {
                    const int t = t0 + ai * HALF + wr * 64 + m * 16 + fr; const size_t row = (size_t)b * RPB + t;
                    f32x4 v[2][2];
#pragma unroll
                    for (int bj = 0; bj < 2; ++bj)
#pragma unroll
                        for (int n = 0; n < 2; ++n) v[bj][n] = acc[ai][bj][m][n];
                    if (isB && (isq || isk)) {
                        float ss = 0.f;
#pragma unroll
                        for (int bj = 0; bj < 2; ++bj)
#pragma unroll
                            for (int n = 0; n < 2; ++n) ss += (v[bj][n][0] * v[bj][n][0] + v[bj][n][1] * v[bj][n][1]) + (v[bj][n][2] * v[bj][n][2] + v[bj][n][3] * v[bj][n][3]);
                        ss += __shfl_xor(ss, 16); ss += __shfl_xor(ss, 32);
                        const float r = rsqrtf(ss * (1.f / 64.f) + 1e-6f);
#pragma unroll
                        for (int bj = 0; bj < 2; ++bj)
#pragma unroll
                            for (int n = 0; n < 2; ++n) v[bj][n] = v[bj][n] * r * gg[bj][n];
                    }
                    if (lat && (isq || isk)) {
#pragma unroll
                        for (int bj = 0; bj < 2; ++bj) {
                            const int p = bj == 0 ? (t >> 6) : 128 + (t & 63);
                            const f32x4 cs0 = *(const f32x4*)(ROPE + (p * 16 + 4 * fq) * 2), cs1 = *(const f32x4*)(ROPE + (p * 16 + 4 * fq) * 2 + 4);
                            const f32x4 cv = {cs0[0], cs0[2], cs1[0], cs1[2]}, sv = {cs0[1], cs0[3], cs1[1], cs1[3]};
                            const f32x4 a = v[bj][0], bb = v[bj][1];
                            v[bj][0] = a * cv - bb * sv; v[bj][1] = bb * cv + a * sv;
                        }
                    }
                    if (isq || isk) {
                        const float sc = isq ? QSCALE : 1.f;
                        bf16_t* dst = isq ? ((isB ? QB : QA) + row * 384 + ul * 64) : ((isB ? KB : KA) + row * 128 + (ul - 6) * 64);
#pragma unroll
                        for (int bj = 0; bj < 2; ++bj)
#pragma unroll
                            for (int n = 0; n < 2; ++n) { const f32x4 x = v[bj][n] * sc; uint2 w; w.x = cvt_pk_bf16(x[0], x[1]); w.y = cvt_pk_bf16(x[2], x[3]);
                                *(uint2*)(dst + 32 * bj + 16 * n + 4 * fq) = w; }
                    } else {
                        bf16_t* dst = (isB ? VTB : VTA) + ((size_t)(b * 2 + (ul - 8)) * 64) * RPB + t;
#pragma unroll
                        for (int bj = 0; bj < 2; ++bj)
#pragma unroll
                            for (int n = 0; n < 2; ++n)
#pragma unroll
                                for (int i = 0; i < 4; ++i) dst[(size_t)(32 * bj + 16 * n + 4 * fq + i) * RPB] = f2bf(v[bj][n][i]);
                    }
                }
        } else {
            const int chb = ((unit - 20) >> 1) * 64 + 32 * ((unit - 20) & 1);
#pragma unroll
            for (int ai = 0; ai < 2; ++ai)
#pragma unroll
                for (int m = 0; m < 4; ++m) {
                    const int t = t0 + ai * HALF + wr * 64 + m * 16 + fr;
#pragma unroll
                    for (int bj = 0; bj < 2; ++bj)
#pragma unroll
                        for (int n = 0; n < 2; ++n) {
                            const f32x4 x = acc[ai][bj][m][n]; const int ch = chb + 16 * bj + 8 * n + 2 * fq;
                            const unsigned w0 = cvt_pk_bf16(x[0], x[1]), w1 = cvt_pk_bf16(x[2], x[3]);
                            if (lat) { unsigned* d = VS + ((size_t)(b * SEQ + t) * 256 + ch); d[0] = w0; d[1] = w1; }
                            else { unsigned* d = VC + ((size_t)(b * 256 + (t - SEQ)) * 256 + ch); d[0] = w0; d[1] = w1; }
                        }
                }
        }
    }
};

struct EpiAll {
    static constexpr bool PERM = false, AFTER_DRAIN = false;
    unsigned char* ws; const float* gqn; const float* gkn; int mode, l, chunk; float coef;
    __device__ __forceinline__ void operator()(const f32x4 (&acc)[2][2][4][2], const Unit& u, int wr, int wc, int fr, int fq) const {
        if (mode == 0) { EpiSwiglu E{(bf16_t*)(ws + WS_MID)}; E(acc, u, wr, wc, fr, fq); }
        else if (mode == 1) { EpiRes E{(float*)(ws + WS_H), (const float*)(ws + WS_MOD) + (size_t)l * 3 * NMOD, chunk, coef, (float*)(ws + WS_PART)}; E(acc, u, wr, wc, fr, fq); }
        else { EpiWin E{gqn, gkn, (const float*)(ws + WS_TAB) + TAB_ROPE, (bf16_t*)(ws + WS_QA), (bf16_t*)(ws + WS_QB), (bf16_t*)(ws + WS_KA), (bf16_t*)(ws + WS_KB),
                        (bf16_t*)(ws + WS_VTA), (bf16_t*)(ws + WS_VTB), (unsigned*)(ws + WS_VS), (unsigned*)(ws + WS_VC)}; E(acc, u, wr, wc, fr, fq); }
    }
};

template <class Epi, class Sched, bool ALIGN_EPI = false, bool SP2 = false>
__device__ __forceinline__ void gemm_phase(PG8_LAS unsigned char* lds, const Gemm g, const Sched& S, const Epi& E) {
    int tid_ = threadIdx.x; asm volatile("" : "+v"(tid_)); const int tid = tid_, wid = __builtin_amdgcn_readfirstlane(tid >> 6), lane = tid & 63, wr = wid >> 2, wc = wid & 3, fr = lane & 15, fq = lane >> 4;
    const int K = g.K, nt = K / BK, LD = g.blocked ? BK : g.ld;
    unsigned voffA[2], voffB[2];
#pragma unroll
    for (int i = 0; i < 2; ++i) { int R, C; stage_rc(tid * 16 + i * 8192, R, C); const int Rb = Epi::PERM ? ((R & ~31) + perm32(R & 31)) : R;
        voffA[i] = (unsigned)(R * LD + C) * 2u; voffB[i] = (unsigned)(Rb * LD + C) * 2u; }
    const size_t kstep = g.blocked ? (size_t)(BM * BK * 2) : (size_t)(BK * 2);
    const size_t hstep = (size_t)HALF * LD * 2;
    const size_t tstep = g.blocked ? (size_t)BM * g.ld * 2 : 2 * hstep;
    const unsigned ldsw = (unsigned)wid * 1024u;
    const int aoff = lds_byte(wr * 64 + fr, fq * 8), boff = lds_byte(wc * 32 + fr, fq * 8);
#define PG8_SA(b, h) (((b) * 2 + (h)) * HTB)
#define PG8_SB(b, h) ((4 + (b) * 2 + (h)) * HTB)
#define PG8_STAGE(bufoff, gbase, voff) do { _Pragma("unroll") for (int _i = 0; _i < 2; ++_i) \
        __builtin_amdgcn_global_load_lds((const unsigned*)((const char*)(gbase) + (voff)[_i]), (PG8_LAS unsigned*)(lds + (bufoff) + ldsw + _i * 8192), 16, 0, 0); } while (0)
#define PG8_LDA(dst, b, h) do { _Pragma("unroll") for (int m = 0; m < 4; ++m) _Pragma("unroll") for (int k = 0; k < 2; ++k) dst[m][k] = *(const PG8_LAS bf16x8*)(lds + PG8_SA(b, h) + aoff + m * 2048 + k * 1024); } while (0)
#define PG8_LDB(dst, b, h) do { _Pragma("unroll") for (int n = 0; n < 2; ++n) _Pragma("unroll") for (int k = 0; k < 2; ++k) dst[n][k] = *(const PG8_LAS bf16x8*)(lds + PG8_SB(b, h) + boff + n * 2048 + k * 1024); } while (0)
#define PG8_MMA(ai, bj, At, Bt) do { __builtin_amdgcn_s_setprio(1); _Pragma("unroll") for (int m = 0; m < 4; ++m) _Pragma("unroll") for (int n = 0; n < 2; ++n) _Pragma("unroll") for (int k = 0; k < 2; ++k) \
        acc[ai][bj][m][n] = __builtin_amdgcn_mfma_f32_16x16x32_bf16(Bt[n][k], At[m][k], acc[ai][bj][m][n], 0, 0, 0); __builtin_amdgcn_s_setprio(0); } while (0)
#define PG8_WAIT_V(n) asm volatile("s_waitcnt vmcnt(" #n ")" ::: "memory")
#define PG8_WAIT_L(n) asm volatile("s_waitcnt lgkmcnt(" #n ")" ::: "memory")
#define PG8_BAR __builtin_amdgcn_s_barrier()
#define PG8_SCHED __builtin_amdgcn_sched_barrier(0)
    Unit cur, nxt; int ui = 0;
    if (!S.next(0, cur)) return;
    f32x4 acc[2][2][4][2];
#pragma unroll
    for (int a = 0; a < 2; ++a)
#pragma unroll
        for (int b = 0; b < 2; ++b)
#pragma unroll
            for (int m = 0; m < 4; ++m)
#pragma unroll
                for (int n = 0; n < 2; ++n) acc[a][b][m][n] = (f32x4){0.f, 0.f, 0.f, 0.f};
    bf16x8 At[4][2], B0[2][2], B1[2][2];
    const char* cA = (const char*)g.A + (size_t)cur.pm * tstep + (size_t)(cur.ko / BK) * kstep; const char* cB = (const char*)g.Bt + (size_t)cur.pn * tstep + (size_t)(cur.ko / BK) * kstep;
    S.a_ready(cur);
    if constexpr (SP2) {
        PG8_STAGE(PG8_SB(0, 0), cB, voffB); PG8_STAGE(PG8_SB(0, 1), cB + hstep, voffB); PG8_STAGE(PG8_SA(0, 0), cA, voffA); PG8_STAGE(PG8_SA(0, 1), cA + hstep, voffA);
        if (wr == 1) PG8_BAR;
        PG8_WAIT_V(2); PG8_BAR;
        PG8_STAGE(PG8_SB(1, 0), cB + kstep, voffB); PG8_STAGE(PG8_SA(1, 0), cA + kstep, voffA); PG8_STAGE(PG8_SB(1, 1), cB + hstep + kstep, voffB);
        PG8_WAIT_V(6); PG8_BAR;
    } else {
        PG8_STAGE(PG8_SB(0, 0), cB, voffB); PG8_STAGE(PG8_SA(0, 0), cA, voffA); PG8_STAGE(PG8_SB(0, 1), cB + hstep, voffB); PG8_STAGE(PG8_SA(0, 1), cA + hstep, voffA);
        if (wr == 1) PG8_BAR;
        PG8_WAIT_V(4); PG8_BAR;
        PG8_STAGE(PG8_SB(1, 0), cB + kstep, voffB); PG8_STAGE(PG8_SA(1, 0), cA + kstep, voffA); PG8_STAGE(PG8_SB(1, 1), cB + hstep + kstep, voffB);
        PG8_WAIT_V(6); PG8_BAR;
    }
    for (;;) {
        const bool has_next = S.next(ui + 1, nxt);
        const char* nA = has_next ? (const char*)g.A + (size_t)nxt.pm * tstep + (size_t)(nxt.ko / BK) * kstep : cA; const char* nB = has_next ? (const char*)g.Bt + (size_t)nxt.pn * tstep + (size_t)(nxt.ko / BK) * kstep : cB;
        for (int t = 0; t < nt; t += 2) {
            const bool last = (t == nt - 2);
            const char* a1 = cA + (size_t)(t + 1) * kstep;
            const char* a2 = last ? nA : cA + (size_t)(t + 2) * kstep; const char* b2 = last ? nB : cB + (size_t)(t + 2) * kstep;
            const char* a3 = a2 + kstep; const char* b3 = b2 + kstep;
            if (last && has_next) S.a_ready(nxt);
            if constexpr (SP2) {
            PG8_LDB(B0, 0, 0); PG8_LDB(B1, 0, 1); PG8_SCHED; PG8_LDA(At, 0, 0); PG8_STAGE(PG8_SA(1, 1), a1 + hstep, voffA);
            PG8_WAIT_V(8); PG8_WAIT_L(0); PG8_BAR; PG8_MMA(0, 0, At, B0); PG8_MMA(0, 1, At, B1); PG8_BAR; PG8_SCHED;
            PG8_LDA(At, 0, 1); PG8_STAGE(PG8_SB(0, 0), b2, voffB); PG8_STAGE(PG8_SB(0, 1), b2 + hstep, voffB); PG8_STAGE(PG8_SA(0, 0), a2, voffA);
            PG8_WAIT_V(8); PG8_WAIT_L(0); PG8_BAR; PG8_MMA(1, 0, At, B0); PG8_MMA(1, 1, At, B1); PG8_BAR; PG8_SCHED;
            PG8_LDB(B0, 1, 0); PG8_LDB(B1, 1, 1); PG8_SCHED; PG8_LDA(At, 1, 0); PG8_STAGE(PG8_SA(0, 1), a2 + hstep, voffA);
            PG8_WAIT_V(8); PG8_WAIT_L(0); PG8_BAR; PG8_MMA(0, 0, At, B0); PG8_MMA(0, 1, At, B1); PG8_BAR; PG8_SCHED;
            PG8_LDA(At, 1, 1); PG8_STAGE(PG8_SB(1, 0), b3, voffB); PG8_STAGE(PG8_SB(1, 1), b3 + hstep, voffB); PG8_STAGE(PG8_SA(1, 0), a3, voffA);
            PG8_WAIT_V(8); PG8_WAIT_L(0); PG8_BAR; PG8_MMA(1, 0, At, B0); PG8_MMA(1, 1, At, B1); PG8_BAR; PG8_SCHED;
            } else {
            PG8_LDB(B0, 0, 0); PG8_SCHED; PG8_LDA(At, 0, 0); PG8_STAGE(PG8_SA(1, 1), a1 + hstep, voffA);
            PG8_WAIT_L(8); PG8_BAR; PG8_WAIT_L(0); PG8_MMA(0, 0, At, B0); PG8_BAR; PG8_SCHED;
            PG8_LDB(B1, 0, 1); PG8_STAGE(PG8_SB(0, 0), b2, voffB);
            PG8_BAR; PG8_WAIT_L(0); PG8_MMA(0, 1, At, B1); PG8_BAR;
            PG8_LDA(At, 0, 1); PG8_STAGE(PG8_SA(0, 0), a2, voffA);
            PG8_BAR; PG8_WAIT_L(0); PG8_MMA(1, 0, At, B0); PG8_BAR; PG8_SCHED;
            PG8_STAGE(PG8_SB(0, 1), b2 + hstep, voffB);
            PG8_WAIT_V(6); PG8_BAR; PG8_MMA(1, 1, At, B1); PG8_BAR;
            PG8_LDB(B0, 1, 0); PG8_SCHED; PG8_LDA(At, 1, 0); PG8_STAGE(PG8_SA(0, 1), a2 + hstep, voffA);
            PG8_WAIT_L(8); PG8_BAR; PG8_WAIT_L(0); PG8_MMA(0, 0, At, B0); PG8_BAR; PG8_SCHED;
            PG8_LDB(B1, 1, 1); PG8_STAGE(PG8_SB(1, 0), b3, voffB);
            PG8_BAR; PG8_WAIT_L(0); PG8_MMA(0, 1, At, B1); PG8_BAR;
            PG8_LDA(At, 1, 1); PG8_STAGE(PG8_SA(1, 0), a3, voffA);
            PG8_BAR; PG8_WAIT_L(0); PG8_MMA(1, 0, At, B0); PG8_BAR; PG8_SCHED;
            PG8_STAGE(PG8_SB(1, 1), b3 + hstep, voffB);
            PG8_WAIT_V(6); PG8_BAR; PG8_MMA(1, 1, At, B1); PG8_BAR;
            }
        }
        if constexpr (ALIGN_EPI) { if (wr == 0) PG8_BAR; }
        if constexpr (!Epi::AFTER_DRAIN) { E(acc, cur, wr, wc, fr, fq); S.done(cur); }
        if (!has_next) break;
#pragma unroll
        for (int a = 0; a < 2; ++a)
#pragma unroll
            for (int b = 0; b < 2; ++b)
#pragma unroll
                for (int m = 0; m < 4; ++m)
#pragma unroll
                    for (int n = 0; n < 2; ++n) acc[a][b][m][n] = (f32x4){0.f, 0.f, 0.f, 0.f};
        cur = nxt; cA = nA; cB = nB; ++ui;
        if constexpr (ALIGN_EPI) { if (wr == 1) PG8_BAR; }
    }
    PG8_WAIT_V(0);
    if constexpr (!ALIGN_EPI) { if (wr == 0) PG8_BAR; }
    PG8_BAR;
    if constexpr (Epi::AFTER_DRAIN) { E.fused(acc, cur, wr, wc, fr, fq, lds, wid, lane); S.done(cur); }
#undef PG8_SA
#undef PG8_SB
#undef PG8_STAGE
#undef PG8_LDA
#undef PG8_LDB
#undef PG8_MMA
#undef PG8_WAIT_V
#undef PG8_WAIT_L
#undef PG8_BAR
#undef PG8_SCHED
}
}
#define FAST_ATTN 1
#define FAST_FFT 1
#define LAS __attribute__((address_space(3)))
__device__ __forceinline__ float wave_sum(float v) {
#pragma unroll
    for (int o = 1; o < 64; o <<= 1) v += __shfl_xor(v, o);
    return v;
}
__device__ __forceinline__ void tr_write(const LAS float* scr, bf16_t* Bt, int ldk, int k0, int P0, int P1, int P2, int P3, int lane) {
    const int c = lane & 7, nl = lane >> 3;
#pragma unroll
    for (int j = 0; j < 4; ++j) { const int n = nl + 8 * j; const LAS float* s = scr + (8 * c) * 33 + n; const int P = j == 0 ? P0 : j == 1 ? P1 : j == 2 ? P2 : P3;
        uint4 o; o.x = pk2(s[0], s[33]); o.y = pk2(s[2 * 33], s[3 * 33]); o.z = pk2(s[4 * 33], s[5 * 33]); o.w = pk2(s[6 * 33], s[7 * 33]);
        *(uint4*)(Bt + (size_t)P * ldk + k0 + 8 * c) = o; }
    asm volatile("s_waitcnt lgkmcnt(0)" ::: "memory");
}
__device__ __forceinline__ void tr_load(LAS float* scr, const float* W, int ldw, int k0, int col0, int lane) {
    float v[32];
#pragma unroll
    for (int i = 0; i < 32; ++i) v[i] = __builtin_nontemporal_load(W + (size_t)(k0 + 2 * i + (lane >> 5)) * ldw + col0 + (lane & 31));
#pragma unroll
    for (int i = 0; i < 32; ++i) scr[(2 * i + (lane >> 5)) * 33 + (lane & 31)] = v[i];
    asm volatile("s_waitcnt lgkmcnt(0)" ::: "memory");
}
__device__ __forceinline__ int perm_gu(int j, int t) { const int jj = j & 127; return 256 * (j >> 7) + 128 * t + 32 * (jj >> 5) + 16 * ((jj & 7) >> 2) + 4 * ((jj & 31) >> 3) + (jj & 3); }
__device__ __forceinline__ int perm_in(int u, int d) { return 256 * (u >> 2) + 32 * (u & 3) + 128 * (d >> 5) + (d & 31); }

__device__ __forceinline__ void prologue_phase(KP P, LAS unsigned char* lds) {
    int tid_ = threadIdx.x, bid_ = blockIdx.x; asm volatile("" : "+v"(tid_)); asm volatile("" : "+s"(bid_));
    const int tid = tid_, lane = tid & 63, wave = tid >> 6, bid = bid_, G = gridDim.x;
    float* MOD = (float*)(P->ws + WS_MOD); float* TAB = (float*)(P->ws + WS_TAB);
    LAS float* cs64 = (LAS float*)(lds + 8 * 8448);
    LAS unsigned* ctr = (LAS unsigned*)(lds + 8 * 8448 + 256);
    if (tid < 64) cs64[tid] = cospif((float)tid / 32.f);
    if (tid == 64) ctr[0] = 0u;
    {
        const int i = bid * 512 + tid;
        if (i < 8192) TAB[TAB_COS + i] = cospif((float)i / 4096.f);
        else if (i < 8192 + 3072) { const int e = i - 8192, p = e / 16, k = e % 16; const float inv = powf(10000.f, -(float)(2 * k) / 32.f);
            const float ang = (float)(p < 128 ? p : p - 128) * inv; TAB[TAB_ROPE + e * 2] = cosf(ang); TAB[TAB_ROPE + e * 2 + 1] = sinf(ang); }
        else if (i < 8192 + 3072 + 16384) { const int e = i - 8192 - 3072, mrow = e >> 7, kcol = e & 127; const int k1 = mrow >> 1, ro = mrow & 1, l1 = kcol >> 1, ri = kcol & 1;
            const int j = (k1 * l1) & 63; const float cv = cospif((float)j / 32.f), sv = sinpif((float)j / 32.f);
            const float v = (ro == ri) ? cv : (ro == 0 ? sv : -sv);
            ((bf16_t*)(P->ws + WS_TAB + TAB_D1_BYTES))[e] = f2bf(v); }
        else if (i < 8192 + 3072 + 16384 + 32768) { const int e = i - 8192 - 3072 - 16384, k2 = e >> 8, kcol = e & 255, l2 = kcol >> 1, ri = kcol & 1;
            const int j = (k2 * l2) & 127; const float v = ri == 0 ? cospif((float)j / 64.f) : sinpif((float)j / 64.f);
            ((bf16_t*)(P->ws + WS_TAB + TAB_D3_BYTES))[e] = f2bf(v); }
    }
    {
        LAS float* sv = (LAS float*)lds;
        LAS float* red = (LAS float*)(lds + 12288);
        for (int i = tid; i < 1024; i += 512) { sv[i] = silu_f(P->c[i]); sv[1024 + i] = silu_f(P->c[1024 + i]); sv[2048 + i] = silu_f(P->cctx[i]); }
        __syncthreads();
        for (int it = bid; it < 256; it += G) {
            const int l = it >> 7, n0 = (it & 127) * 72;
            const float* W = P->w_ada + (size_t)l * 1024 * NMOD + n0;
            float a0 = 0.f, a1 = 0.f, a2 = 0.f, e0 = 0.f, e1 = 0.f, e2 = 0.f;
            const int ks = wave * 128 + 16 * (lane >> 3);
#pragma unroll
            for (int j = 0; j < 16; ++j) { const float w = __builtin_nontemporal_load(W + (size_t)(ks + j) * NMOD + 64 + (lane & 7)); e0 += sv[ks + j] * w; e1 += sv[1024 + ks + j] * w; e2 += sv[2048 + ks + j] * w; }
#pragma unroll 32
            for (int k = wave * 128; k < wave * 128 + 128; ++k) { const float w = __builtin_nontemporal_load(W + (size_t)k * NMOD + lane); a0 += sv[k] * w; a1 += sv[1024 + k] * w; a2 += sv[2048 + k] * w; }
#pragma unroll
            for (int o = 8; o < 64; o <<= 1) { e0 += __shfl_xor(e0, o); e1 += __shfl_xor(e1, o); e2 += __shfl_xor(e2, o); }
            red[(wave * 3 + 0) * 72 + lane] = a0; red[(wave * 3 + 1) * 72 + lane] = a1; red[(wave * 3 + 2) * 72 + lane] = a2;
            if (lane < 8) { red[(wave * 3 + 0) * 72 + 64 + lane] = e0; red[(wave * 3 + 1) * 72 + 64 + lane] = e1; red[(wave * 3 + 2) * 72 + 64 + lane] = e2; }
            __syncthreads();
            if (tid < 216) { const int w = tid / 72, cc = tid - w * 72; float s = P->b_ada[l * NMOD + n0 + cc];
#pragma unroll
                for (int q = 0; q < 8; ++q) s += red[(q * 3 + w) * 72 + cc];
                MOD[(size_t)(l * 3 + w) * NMOD + n0 + cc] = s; }
            __syncthreads();
        }
    }
    {
        LAS float* scr = (LAS float*)(lds + wave * 8448);
        const int nl = lane >> 3;
        for (int hid = bid + G * wave; hid < 768 && wave < 8; hid += 8 * G) {
            const int l = hid / 384; int r = hid - l * 384;
            bf16_t* WT = (bf16_t*)(P->ws + WS_WT) + (size_t)l * WT_L;
            if (r < 256) {
                const int kb = r / 16, ob = r % 16;
                const int u = 20 + (ob >> 1), g = (u - 20) >> 1, half = (u - 20) & 1, q = (ob & 1) * 32 + (lane & 31);
                const int dch = 32 * half + (q >> 1), ri = q & 1;
                const float* W = P->w_in + (size_t)l * 1024 * DIN + 1280 + g * 64;
                float tw[64];
#pragma unroll
                for (int cc = 0; cc < 64; ++cc) { const int j = (cc * dch) & 63; tw[cc] = ri == 0 ? cs64[j] : -cs64[(j - 16) & 63]; }
                for (int i = 0; i < 32; ++i) { const int kk = 2 * i + (lane >> 5); const float4* w4 = (const float4*)(W + (size_t)(kb * 64 + kk) * DIN); float a = 0.f;
#pragma unroll
                    for (int c4 = 0; c4 < 16; ++c4) { const float4 wv = w4[c4]; a += wv.x * tw[4 * c4] + wv.y * tw[4 * c4 + 1] + wv.z * tw[4 * c4 + 2] + wv.w * tw[4 * c4 + 3]; }
                    scr[kk * 33 + (lane & 31)] = a; }
                asm volatile("s_waitcnt lgkmcnt(0)" ::: "memory");
                const int d = (ob & 1) * 32 + nl;
                tr_write(scr, WT + WT_IN, 1024, kb * 64, perm_in(u, d), perm_in(u, d + 8), perm_in(u, d + 16), perm_in(u, d + 24), lane);
            } else {
                r -= 256; const int g = r / 32, nb = r % 32;
                const float* wo = P->w_out + (size_t)l * 1024 * 1024 + (size_t)(768 + g * 64) * 1024 + nb * 32 + (lane & 31);
                const float* wf = P->w_four + (size_t)(l * 4 + g) * 4096;
                float wov[64];
#pragma unroll
                for (int d = 0; d < 64; ++d) wov[d] = wo[(size_t)d * 1024];
                for (int i = 0; i < 32; ++i) { const int kk = 2 * i + (lane >> 5); const float4* f4 = (const float4*)(wf + kk * 64); float a = 0.f;
#pragma unroll
                    for (int d4 = 0; d4 < 16; ++d4) { const float4 fv = f4[d4]; a += fv.x * wov[4 * d4] + fv.y * wov[4 * d4 + 1] + fv.z * wov[4 * d4 + 2] + fv.w * wov[4 * d4 + 3]; }
                    scr[kk * 33 + (lane & 31)] = a; }
                asm volatile("s_waitcnt lgkmcnt(0)" ::: "memory");
                const int j = nb * 32 + nl;
                tr_write(scr, WT + WT_OUT, 1024, 768 + g * 64, j, j + 8, j + 16, j + 24, lane);
            }
        }
        constexpr int NA = 4 * 1408, NBd = 2 * 1408, NC = 640, NE = 384, NL = NA + NBd + NC + NE;
        const int lo = (int)(((long)bid * (2 * NL)) / G), hi = (int)(((long)(bid + 1) * (2 * NL)) / G);
        for (;;) {
            unsigned iu = 0u; if (lane == 0) iu = __hip_atomic_fetch_add(ctr, 1u, __ATOMIC_RELAXED, __HIP_MEMORY_SCOPE_WORKGROUP);
            const int it = lo + (int)__builtin_amdgcn_readfirstlane(iu);
            if (it >= hi) break;
            const int l = it / NL; int r = it - l * NL;
            bf16_t* WT = (bf16_t*)(P->ws + WS_WT) + (size_t)l * WT_L;
            if (r < NA) { const int f = r / 2816, t = (r / 1408) & 1, q = r % 1408, kb = q / 88, nb = q % 88;
                const float* W = (f == 0 ? (t == 0 ? P->w1g : P->w1u) : (t == 0 ? P->w2g : P->w2u)) + (size_t)l * 1024 * DFF;
                tr_load(scr, W, DFF, kb * 64, nb * 32, lane);
                const int j = nb * 32 + nl;
                tr_write(scr, WT + WT_GU + (size_t)f * 5632 * 1024, 1024, kb * 64, perm_gu(j, t), perm_gu(j + 8, t), perm_gu(j + 16, t), perm_gu(j + 24, t), lane);
                continue; }
            r -= NA;
            if (r < NBd) { const int f = r / 1408, q = r % 1408, kb = q / 32, nb = q % 32;
                const float* W = (f == 0 ? P->w1d : P->w2d) + (size_t)l * DFF * 1024;
                tr_load(scr, W, 1024, kb * 64, nb * 32, lane);
                const int j = nb * 32 + nl;
                { bf16_t* Bd = WT + WT_DN + (size_t)f * 1024 * MIDP + (size_t)(j >> 8) * 256 * DFF + (size_t)kb * (256 * 64);
                  tr_write(scr, Bd, 64, 0, j & 255, (j + 8) & 255, (j + 16) & 255, (j + 24) & 255, lane); }
                continue; }
            r -= NBd;
            if (r < NC) { const int kb = r / 40, nb = r % 40;
                tr_load(scr, P->w_in + (size_t)l * 1024 * DIN, DIN, kb * 64, nb * 32, lane);
                const int u = nb >> 1, d = (nb & 1) * 32 + nl;
                tr_write(scr, WT + WT_IN, 1024, kb * 64, perm_in(u, d), perm_in(u, d + 8), perm_in(u, d + 16), perm_in(u, d + 24), lane);
                continue; }
            r -= NC;
            { const int kb = r / 32, nb = r % 32;
                tr_load(scr, P->w_out + (size_t)l * 1024 * 1024, 1024, kb * 64, nb * 32, lane);
                const int j = nb * 32 + nl;
                tr_write(scr, WT + WT_OUT, 1024, kb * 64, j, j + 8, j + 16, j + 24, lane); }
        }
    }
}
__device__ __forceinline__ void norm_phase(KP P, const float* g, const float* MODl, int shc, int scc, bool from_input, int npart) {
    int tid_ = threadIdx.x, bid_ = blockIdx.x; asm volatile("" : "+v"(tid_)); asm volatile("" : "+s"(bid_));
    const int lane = tid_ & 63, gw = bid_ * 8 + (tid_ >> 6), NGW = gridDim.x * 8;
    float* H = (float*)(P->ws + WS_H); bf16_t* XN = (bf16_t*)(P->ws + WS_XN);
    constexpr int RU = 3;
    for (int row0 = gw; row0 < M; row0 += RU * NGW) {
        float4 v[RU][4]; float ss[RU];
#pragma unroll
        for (int u = 0; u < RU; ++u) { const int row = row0 + u * NGW; ss[u] = 0.f;
            if (row < M) { const int b = row / RPB, t = row - b * RPB;
                const float4* h = from_input ? (t < SEQ ? (const float4*)(P->x + ((size_t)b * SEQ + t) * DM) : (const float4*)(P->ctx + ((size_t)b * CTXL + (t - SEQ)) * DM)) : (const float4*)(H + (size_t)row * DM);
#pragma unroll
                for (int j = 0; j < 4; ++j) v[u][j] = h[lane + 64 * j]; } }
#pragma unroll
        for (int u = 0; u < RU; ++u) { const int row = row0 + u * NGW;
            if (row < M) { const int b = row / RPB, t = row - b * RPB, w = t >= SEQ ? 2 : b;
                if (t >= SEQ && npart > 0) {
                    const float4* pp = (const float4*)(P->ws + WS_PART) + (size_t)(b * CTXL + (t - SEQ)) * 256 + lane;
                    for (int q = 0; q < npart; ++q) {
#pragma unroll
                        for (int j = 0; j < 4; ++j) { const float4 a = pp[(size_t)q * 512 * 256 + 64 * j]; v[u][j].x += a.x; v[u][j].y += a.y; v[u][j].z += a.z; v[u][j].w += a.w; } } }
#pragma unroll
                for (int j = 0; j < 4; ++j) ss[u] += v[u][j].x * v[u][j].x + v[u][j].y * v[u][j].y + v[u][j].z * v[u][j].z + v[u][j].w * v[u][j].w;
                if (from_input || (t >= SEQ && npart > 0)) {
#pragma unroll
                    for (int j = 0; j < 4; ++j) ((float4*)(H + (size_t)row * DM))[lane + 64 * j] = v[u][j]; }
                const float r = rsqrtf(wave_sum(ss[u]) * (1.f / DM) + 1e-6f);
                const float* sh = MODl + w * NMOD + shc * 1024; const float* sc = MODl + w * NMOD + scc * 1024;
#pragma unroll
                for (int j = 0; j < 4; ++j) { const int c = (lane + 64 * j) * 4; const float4 gg = *(const float4*)(g + c), s4 = *(const float4*)(sh + c), c4 = *(const float4*)(sc + c);
                    uint2 o; o.x = pk2(v[u][j].x * r * gg.x * (1.f + c4.x) + s4.x, v[u][j].y * r * gg.y * (1.f + c4.y) + s4.y);
                    o.y = pk2(v[u][j].z * r * gg.z * (1.f + c4.z) + s4.z, v[u][j].w * r * gg.w * (1.f + c4.w) + s4.w);
                    *(uint2*)(XN + (size_t)row * DM + c) = o; } } }
    }
}
__device__ __forceinline__ void final_phase(KP P) {
    int tid_ = threadIdx.x, bid_ = blockIdx.x; asm volatile("" : "+v"(tid_)); asm volatile("" : "+s"(bid_));
    const int lane = tid_ & 63, gw = bid_ * 8 + (tid_ >> 6), NGW = gridDim.x * 8;
    const float* H = (const float*)(P->ws + WS_H);
    for (int orow = gw; orow < NB * SEQ; orow += NGW) {
        const int b = orow / SEQ, t = orow - b * SEQ;
        const float4* h = (const float4*)(H + (size_t)(b * RPB + t) * DM);
        float4 v[4]; float ss = 0.f;
#pragma unroll
        for (int j = 0; j < 4; ++j) { v[j] = h[lane + 64 * j]; ss += v[j].x * v[j].x + v[j].y * v[j].y + v[j].z * v[j].z + v[j].w * v[j].w; }
        const float r = rsqrtf(wave_sum(ss) * (1.f / DM) + 1e-6f);
#pragma unroll
        for (int j = 0; j < 4; ++j) { const int c = (lane + 64 * j) * 4; const float4 gg = *(const float4*)(P->g_final + c);
            float4 o; o.x = v[j].x * r * gg.x; o.y = v[j].y * r * gg.y; o.z = v[j].z * r * gg.z; o.w = v[j].w * r * gg.w;
            *(float4*)(P->out + (size_t)orow * DM + c) = o; }
    }
}
template <class Epi> __device__ __forceinline__ void run_gemm(LAS unsigned char* lds, const bf16_t* A, const bf16_t* Bt, int N, int K, int lda, int blocked, int no_ctx, Epi E) {
    const int npass = (N == 1024 && !no_ctx) ? 2 : 1;
    for (int pass = 0; pass < npass; ++pass) {
        pg8::Gemm g{A, Bt, M, N, pass ? 256 : K, lda, blocked}; pg8::SplitOrder S; S.init((N == 1024 || no_ctx) ? 1 + pass : 0, M, N, (int)gridDim.x, (int)blockIdx.x, K / 256, 256);
        pg8::gemm_phase<Epi, pg8::SplitOrder, true, true>(lds, g, S, E);
    }
}

typedef float f32x16 __attribute__((ext_vector_type(16)));
typedef short bf16x8_t __attribute__((ext_vector_type(8)));
typedef short s16x4_t __attribute__((ext_vector_type(4)));
typedef unsigned u32x4_t __attribute__((ext_vector_type(4)));
typedef unsigned u32x2_t __attribute__((ext_vector_type(2)));
constexpr int AT_KBUF = 0, AT_VBUF = 32768, AT_VSTRIDE = 264, AT_VBYTES = 64 * AT_VSTRIDE, AT_COMB = AT_VBUF + 3 * AT_VBYTES, AT_COMB_PAIR = 34 * 64 * 4;
static_assert(AT_COMB + 4 * AT_COMB_PAIR <= 131072, "attention LDS map");
typedef float at_f32x2 __attribute__((ext_vector_type(2))); typedef __bf16 at_bf16x2 __attribute__((ext_vector_type(2)));
__device__ __forceinline__ unsigned cvtpk(float lo, float hi) { const at_f32x2 v = {lo, hi}; const at_bf16x2 b = __builtin_convertvector(v, at_bf16x2); return __builtin_bit_cast(unsigned, b); }

__device__ __forceinline__ void attn_unit(KP P, LAS unsigned char* lds, int l, int tid, int b, int hh, int q0, bool lat) {
    unsigned char* ws = P->ws;
    const int lane = tid & 63, r32 = lane & 31, hi = lane >> 5, wid = __builtin_amdgcn_readfirstlane(tid >> 6), g = wid >> 2, wq = wid & 3;
    const bool isB = hh >= 6; const int h = isB ? hh - 6 : hh, kvh = h / 3;
    const bf16_t* Q = (const bf16_t*)(ws + (isB ? WS_QB : WS_QA)) + ((size_t)b * RPB + q0 + 32 * wq + r32) * 384 + h * 64;
    const bf16_t* Kg = (const bf16_t*)(ws + (isB ? WS_KB : WS_KA)) + (size_t)b * RPB * 128 + kvh * 64;
    const bf16_t* Vg = (const bf16_t*)(ws + (isB ? WS_VTB : WS_VTA)) + ((size_t)(b * 2 + kvh) * 64) * RPB;
    int npre, kb_lo, nsteps;
    if (!lat) { npre = 2; kb_lo = 0; nsteps = 2; }
    else if (isB) { npre = 0; kb_lo = 0; nsteps = 66; }
    else { const int qb = q0 >> 7; kb_lo = qb > 0 ? qb - 1 : 0; const int kb_hi = qb < 63 ? qb + 1 : 63; npre = 2; nsteps = 2 + (kb_hi - kb_lo + 1); }
    const int kkey0 = tid >> 3, kc = tid & 7;
    const unsigned kdst0 = (unsigned)(kkey0 * 128 + ((kc ^ ((kkey0 >> 1) & 7)) * 16));
    const int vd0 = tid >> 4, vc = tid & 15;
    const unsigned vdst0 = (unsigned)(vd0 * AT_VSTRIDE + vc * 16);
    const bf16_t* kg0 = Kg + (size_t)kkey0 * 128 + kc * 8;
    const bf16_t* vg0 = Vg + (size_t)vd0 * RPB + vc * 8;
    u32x4_t pk0, pk1, pv0, pv1;
#define AT_KP0(s) ((s) < npre ? SEQ + 128 * (s) : 128 * (kb_lo + (s) - npre))
#define AT_LOADK(s) do { const int kp0_ = AT_KP0(s); pk0 = *(const u32x4_t*)(kg0 + (size_t)kp0_ * 128); pk1 = *(const u32x4_t*)(kg0 + (size_t)(kp0_ + 64) * 128); } while (0)
#define AT_LOADV(s) do { const int kp0_ = AT_KP0(s); pv0 = *(const u32x4_t*)(vg0 + kp0_); pv1 = *(const u32x4_t*)(vg0 + (size_t)32 * RPB + kp0_); } while (0)
#define AT_STOREK(buf) do { LAS unsigned char* kb_ = lds + AT_KBUF + (buf) * 16384; *(LAS u32x4_t*)(kb_ + kdst0) = pk0; *(LAS u32x4_t*)(kb_ + kdst0 + 8192) = pk1; } while (0)
#define AT_STOREV(buf) do { LAS unsigned char* vb_ = lds + AT_VBUF + (buf) * AT_VBYTES; \
        *(LAS u32x2_t*)(vb_ + vdst0) = (u32x2_t){pv0.x, pv0.y}; *(LAS u32x2_t*)(vb_ + vdst0 + 8) = (u32x2_t){pv0.z, pv0.w}; \
        *(LAS u32x2_t*)(vb_ + vdst0 + 32 * AT_VSTRIDE) = (u32x2_t){pv1.x, pv1.y}; *(LAS u32x2_t*)(vb_ + vdst0 + 32 * AT_VSTRIDE + 8) = (u32x2_t){pv1.z, pv1.w}; } while (0)
#define AT_QK_LD(buf) do { const LAS unsigned char* kb_ = lds + AT_KBUF + (buf) * 16384; \
        _Pragma("unroll") for (int d0 = 0; d0 < 4; ++d0) { kf[2 * d0] = *(const LAS bf16x8_t*)(kb_ + koff[d0]); kf[2 * d0 + 1] = *(const LAS bf16x8_t*)(kb_ + koff[d0] + 4096); } } while (0)
#define AT_QK_MMA(S0_, S1_) do { S0_ = __builtin_amdgcn_mfma_f32_32x32x16_bf16(kf[0], qf[0], negm, 0, 0, 0); S1_ = __builtin_amdgcn_mfma_f32_32x32x16_bf16(kf[1], qf[0], negm, 0, 0, 0); \
        _Pragma("unroll") for (int d0 = 1; d0 < 4; ++d0) { \
            S0_ = __builtin_amdgcn_mfma_f32_32x32x16_bf16(kf[2 * d0], qf[d0], S0_, 0, 0, 0); S1_ = __builtin_amdgcn_mfma_f32_32x32x16_bf16(kf[2 * d0 + 1], qf[d0], S1_, 0, 0, 0); } } while (0)
#define AT_QK(S0_, S1_, buf) do { AT_QK_LD(buf); __builtin_amdgcn_sched_barrier(0); AT_QK_MMA(S0_, S1_); } while (0)
    AT_LOADK(0); AT_LOADV(0);
    u32x4_t pk2, pk3;
    { const int kp1_ = AT_KP0(1); pk2 = *(const u32x4_t*)(kg0 + (size_t)kp1_ * 128); pk3 = *(const u32x4_t*)(kg0 + (size_t)(kp1_ + 64) * 128); }
    bf16x8_t qf[4], kf[8], vfr[8];
#pragma unroll
    for (int d0 = 0; d0 < 4; ++d0) qf[d0] = *(const bf16x8_t*)(Q + 16 * d0 + 8 * hi);
    const int key0 = 64 * g + r32; const int swz = (key0 >> 1) & 7;
    unsigned koff[4];
#pragma unroll
    for (int d0 = 0; d0 < 4; ++d0) koff[d0] = (unsigned)(key0 * 128 + (((2 * d0 + hi) ^ swz) * 16));
    const unsigned voff = (unsigned)(r32 * AT_VSTRIDE + 128 * g + 8 * hi);
    f32x16 O0 = {}, O1 = {};
    float m = 0.f, lsum = 0.f, pend = 0.f;
    f32x16 negm = {};
    constexpr float AT_THR = 8.f;
    const int qp = q0 + 32 * wq + r32;
    AT_STOREK(0); AT_STOREV(0);
    { LAS unsigned char* kb_ = lds + AT_KBUF + 16384; *(LAS u32x4_t*)(kb_ + kdst0) = pk2; *(LAS u32x4_t*)(kb_ + kdst0 + 8192) = pk3; }
    __syncthreads();
    f32x16 S0, S1;
    AT_QK(S0, S1, 0);
    __syncthreads();
#define AT_PV_LD(vs) do { const LAS unsigned char* vb_ = lds + AT_VBUF + (vs) * AT_VBYTES; \
        _Pragma("unroll") for (int sl = 0; sl < 4; ++sl) _Pragma("unroll") for (int dd = 0; dd < 2; ++dd) { \
            const u32x2_t lo = *(const LAS u32x2_t*)(vb_ + voff + dd * 32 * AT_VSTRIDE + 32 * sl), hi8 = *(const LAS u32x2_t*)(vb_ + voff + dd * 32 * AT_VSTRIDE + 32 * sl + 16); \
            const u32x4_t vw = {lo.x, lo.y, hi8.x, hi8.y}; vfr[2 * sl + dd] = __builtin_bit_cast(bf16x8_t, vw); } } while (0)
#define AT_PV_MMA() do { _Pragma("unroll") for (int sl = 0; sl < 4; ++sl) { const bf16x8_t pf = __builtin_bit_cast(bf16x8_t, pp[sl]); \
            O0 = __builtin_amdgcn_mfma_f32_32x32x16_bf16(vfr[2 * sl], pf, O0, 0, 0, 0); O1 = __builtin_amdgcn_mfma_f32_32x32x16_bf16(vfr[2 * sl + 1], pf, O1, 0, 0, 0); } } while (0)
#define AT_PV(vs) do { AT_PV_LD(vs); __builtin_amdgcn_sched_barrier(0); AT_PV_MMA(); } while (0)
    u32x4_t pp[4] = {};
    int vs_prev = 0, vs_cur = 0, vs_next = 1;
    for (int s = 0; s < nsteps; ++s) {
        if (s + 2 < nsteps) AT_LOADK(s + 2);
        if (s + 1 < nsteps) AT_LOADV(s + 1);
        f32x16 N0, N1;
        if (lat && !isB && s >= npre) {
            const int kpb = AT_KP0(s) + 64 * g + 4 * hi - qp;
#pragma unroll
            for (int r = 0; r < 16; ++r) { const int dlt = kpb + (r & 3) + 8 * (r >> 2);
                if (dlt > 128 || dlt < -128) S0[r] = -1e30f;
                if (dlt + 32 > 128 || dlt + 32 < -128) S1[r] = -1e30f; }
        }
        if (__any(pend != 0.f)) { S0 = S0 - pend; S1 = S1 - pend; }
        AT_QK_LD((s + 1) & 1);
        __builtin_amdgcn_sched_barrier(0);
        __builtin_amdgcn_s_setprio(1); AT_QK_MMA(N0, N1); __builtin_amdgcn_s_setprio(0);
        AT_PV_LD(vs_prev);
        __builtin_amdgcn_sched_barrier(0);
        __builtin_amdgcn_s_setprio(1); AT_PV_MMA(); __builtin_amdgcn_s_setprio(0);
        __builtin_amdgcn_sched_barrier(0);
        float rm = __builtin_fmaxf(__builtin_fmaxf(S0[0], S1[0]), S0[1]);
#pragma unroll
        for (int r = 1; r < 16; ++r) rm = __builtin_fmaxf(__builtin_fmaxf(rm, S1[r]), r < 15 ? S0[r + 1] : S1[r]);
        { const auto rr = __builtin_amdgcn_permlane32_swap(__float_as_uint(rm), __float_as_uint(rm), false, false); rm = fmaxf(__uint_as_float(rr[0]), __uint_as_float(rr[1])); }
        float alpha = 1.f; pend = 0.f;
        if (s == 0 || __any(rm > AT_THR)) {
            const float dl = s == 0 ? rm : fmaxf(rm, 0.f);
            S0 = S0 - dl; S1 = S1 - dl; negm = negm - dl; m += dl; pend = dl;
            alpha = __builtin_amdgcn_exp2f(-dl); lsum *= alpha;
        }
        float ps = 0.f;
#pragma unroll
        for (int r = 0; r < 16; ++r) { S0[r] = __builtin_amdgcn_exp2f(S0[r]); S1[r] = __builtin_amdgcn_exp2f(S1[r]); ps += S0[r] + S1[r]; }
        lsum += ps;
#pragma unroll
        for (int sl = 0; sl < 4; ++sl) { const int rb = 8 * (sl & 1);
            if (sl < 2) pp[sl] = (u32x4_t){cvtpk(S0[rb], S0[rb + 1]), cvtpk(S0[rb + 2], S0[rb + 3]), cvtpk(S0[rb + 4], S0[rb + 5]), cvtpk(S0[rb + 6], S0[rb + 7])};
            else pp[sl] = (u32x4_t){cvtpk(S1[rb], S1[rb + 1]), cvtpk(S1[rb + 2], S1[rb + 3]), cvtpk(S1[rb + 4], S1[rb + 5]), cvtpk(S1[rb + 6], S1[rb + 7])}; }
        __builtin_amdgcn_sched_barrier(0);
        if (__any(alpha != 1.f)) {
#pragma unroll
            for (int r = 0; r < 16; ++r) { O0[r] *= alpha; O1[r] *= alpha; } }
        if (s + 2 < nsteps) AT_STOREK(s & 1);
        if (s + 1 < nsteps) AT_STOREV(vs_next);
        __syncthreads();
        S0 = N0; S1 = N1;
        vs_prev = vs_cur; vs_cur = vs_next; vs_next = vs_next == 2 ? 0 : vs_next + 1;
    }
    AT_PV(vs_prev);
#undef AT_PV
#undef AT_PV_LD
#undef AT_PV_MMA
#undef AT_QK_LD
#undef AT_QK_MMA
#undef AT_LOADK
#undef AT_LOADV
#undef AT_STOREK
#undef AT_STOREV
#undef AT_QK
    float ltot = lsum + __shfl_xor(lsum, 32);
    LAS float* comb = (LAS float*)(lds + AT_COMB + wq * AT_COMB_PAIR);
    if (g == 1) {
        comb[lane] = m; comb[64 + lane] = ltot;
#pragma unroll
        for (int r = 0; r < 16; ++r) { comb[(2 + r) * 64 + lane] = O0[r]; comb[(18 + r) * 64 + lane] = O1[r]; }
    }
    __syncthreads();
    if (g == 0) {
        const float m1 = comb[lane], l1 = comb[64 + lane];
        float mf = fmaxf(m, m1); float sk = 0.f;
        if (!isB) { const float s2 = P->sink[l * 6 + h] * LOG2E; mf = fmaxf(mf, s2); sk = __builtin_amdgcn_exp2f(s2 - mf); }
        const float a0 = __builtin_amdgcn_exp2f(m - mf), a1 = __builtin_amdgcn_exp2f(m1 - mf);
        const float inv = 1.f / (ltot * a0 + l1 * a1 + sk);
        const float c0 = a0 * inv, c1 = a1 * inv;
        bf16_t* dst = (bf16_t*)(ws + WS_XN) + ((size_t)b * RPB + q0 + 32 * wq + r32) * DM + (isB ? 384 : 0) + h * 64 + 4 * hi;
#pragma unroll
        for (int rq = 0; rq < 4; ++rq) {
            float o[8];
#pragma unroll
            for (int i = 0; i < 4; ++i) { o[i] = O0[4 * rq + i] * c0 + comb[(2 + 4 * rq + i) * 64 + lane] * c1; o[4 + i] = O1[4 * rq + i] * c0 + comb[(18 + 4 * rq + i) * 64 + lane] * c1; }
            *(u32x2_t*)(dst + 8 * rq) = (u32x2_t){cvtpk(o[0], o[1]), cvtpk(o[2], o[3])};
            *(u32x2_t*)(dst + 32 + 8 * rq) = (u32x2_t){cvtpk(o[4], o[5]), cvtpk(o[6], o[7])};
        }
    }
    __syncthreads();
#undef AT_KP0
}
__device__ __forceinline__ void attn_phase(KP P, LAS unsigned char* lds, int l) {
    int tid_ = threadIdx.x, bid_ = blockIdx.x; asm volatile("" : "+v"(tid_)); asm volatile("" : "+s"(bid_));
    const int G = gridDim.x;
    const bool xcd = (G == 256);
    const int NU = 1536 + (l == 0 ? 48 : 0);
    for (int it = 0;; ++it) {
        int idx;
        if (xcd) { if (it >= 7) break; idx = it < 6 ? (it / 3) * 768 + (bid_ & 7) * 96 + (it % 3) * 32 + (bid_ >> 3) : 1536 + bid_; if (idx >= NU) break; }
        else { idx = bid_ + it * G; if (idx >= NU) break; }
        int b, hh, q0; bool lat = true;
        if (idx < 768) { b = idx / 384; hh = 6 + (idx % 384) / 64; q0 = (idx & 63) * 128; }
        else if (idx < 1536) { const int u = idx - 768; b = u / 384; hh = (u % 384) / 64; q0 = (u & 63) * 128; }
        else { const int u = idx - 1536; b = u / 24; hh = (u % 24) >> 1; q0 = SEQ + 128 * (u & 1); lat = false; }
        attn_unit(P, lds, l, tid_, b, hh, q0, lat);
    }
}

__device__ __forceinline__ void fft1_phase(KP P, int l) {
    int tid_ = threadIdx.x, bid_ = blockIdx.x; asm volatile("" : "+v"(tid_)); asm volatile("" : "+s"(bid_));
    unsigned char* ws = P->ws;
    const int lane = tid_ & 63, r32 = lane & 31, hi = lane >> 5, w = tid_ >> 6;
    const bf16_t* D1 = (const bf16_t*)(ws + WS_TAB + TAB_D1_BYTES); const float* TAB = (const float*)(ws + WS_TAB);
    for (int it = bid_; it < 256; it += gridDim.x) {
        const int b = it >> 7, l2 = it & 127, ch = 32 * w + r32;
        const unsigned* vsrc = (const unsigned*)(ws + WS_VS) + ((size_t)(b * SEQ + l2 + 512 * hi)) * 256 + ch;
        u32x4_t bfr[8];
#pragma unroll
        for (int s = 0; s < 8; ++s)
#pragma unroll
            for (int j = 0; j < 4; ++j) bfr[s][j] = vsrc[(size_t)(128 * (8 * s + j)) * 256];
        f32x16 acc[4] = {};
#pragma unroll
        for (int s = 0; s < 8; ++s) {
            const bf16x8_t bf = __builtin_bit_cast(bf16x8_t, bfr[s]);
#pragma unroll
            for (int mt = 0; mt < 4; ++mt) { const bf16x8_t af = *(const bf16x8_t*)(D1 + (32 * mt + r32) * 128 + 16 * s + 8 * hi);
                acc[mt] = __builtin_amdgcn_mfma_f32_32x32x16_bf16(af, bf, acc[mt], 0, 0, 0); }
        }
        unsigned* zs = (unsigned*)(ws + WS_ZS);
#pragma unroll
        for (int mt = 0; mt < 4; ++mt)
#pragma unroll
            for (int rq = 0; rq < 4; ++rq)
#pragma unroll
                for (int e = 0; e < 2; ++e) {
                    const int k1 = 16 * mt + 4 * rq + 2 * hi + e; const int idx = k1 * l2;
                    const float ct = TAB[TAB_COS + idx], st = TAB[TAB_COS + ((idx - 2048) & 8191)];
                    const float yr = acc[mt][4 * rq + 2 * e], yi = acc[mt][4 * rq + 2 * e + 1];
                    zs[((size_t)(b * 64 + k1) * 128 + l2) * 256 + ch] = cvtpk(yr * ct + yi * st, yi * ct - yr * st);
                }
    }
    if (l == 0) {
        const unsigned* VC = (const unsigned*)(ws + WS_VC); bf16_t* OM = (bf16_t*)(ws + WS_XN);
        for (int gt = bid_ * 512 + tid_; gt < NB * CTXL * 256; gt += gridDim.x * 512) {
            const int ch = gt & 255, k = (gt >> 8) & 255, b = gt >> 16;
            const unsigned* vp = VC + (size_t)(b * 256) * 256 + ch; float a = 0.f;
#pragma unroll 8
            for (int j = 0; j < 256; ++j) { const unsigned pk = vp[(size_t)j * 256]; const float vr = __uint_as_float(pk << 16), vi = __uint_as_float(pk & 0xffff0000u);
                const int ix = ((k * j) & 255) * 32; a += vr * TAB[TAB_COS + ix] + vi * TAB[TAB_COS + ((ix - 2048) & 8191)]; }
            OM[(size_t)(b * RPB + SEQ + k) * DM + 768 + ch] = f2bf(a * (1.f / 128.f));
        }
    }
}
__device__ __forceinline__ void fft3_phase(KP P, LAS unsigned char* lds, int l) {
    int tid_ = threadIdx.x, bid_ = blockIdx.x; asm volatile("" : "+v"(tid_)); asm volatile("" : "+s"(bid_));
    unsigned char* ws = P->ws;
    const int lane = tid_ & 63, r32 = lane & 31, hi = lane >> 5, w = tid_ >> 6;
    const bf16_t* D3 = (const bf16_t*)(ws + WS_TAB + TAB_D3_BYTES); bf16_t* OM = (bf16_t*)(ws + WS_XN);
    for (int it = bid_; it < 256; it += gridDim.x) {
        const int b = it >> 7, k1 = (it & 127) >> 1, chh = it & 1, ch = 32 * (4 * chh + (w & 3)) + r32, mh = w >> 2;
        const unsigned* zsrc = (const unsigned*)(ws + WS_ZS) + ((size_t)(b * 64 + k1) * 128 + 4 * hi) * 256 + ch;
        f32x16 acc[2] = {};
#pragma unroll
        for (int sh = 0; sh < 2; ++sh) {
            u32x4_t bfr[8];
#pragma unroll
            for (int s = 0; s < 8; ++s)
#pragma unroll
                for (int j = 0; j < 4; ++j) bfr[s][j] = zsrc[(size_t)(8 * (8 * sh + s) + j) * 256];
#pragma unroll
            for (int s = 0; s < 8; ++s) {
                const bf16x8_t bf = __builtin_bit_cast(bf16x8_t, bfr[s]);
#pragma unroll
                for (int mi = 0; mi < 2; ++mi) { const bf16x8_t af = *(const bf16x8_t*)(D3 + (32 * (2 * mh + mi) + r32) * 256 + 16 * (8 * sh + s) + 8 * hi);
                    acc[mi] = __builtin_amdgcn_mfma_f32_32x32x16_bf16(af, bf, acc[mi], 0, 0, 0); }
            }
        }
#pragma unroll
        for (int mi = 0; mi < 2; ++mi)
#pragma unroll
            for (int r = 0; r < 16; ++r) { const int k2 = 32 * (2 * mh + mi) + (r & 3) + 8 * (r >> 2) + 4 * hi;
                OM[((size_t)b * RPB + k1 + 64 * k2) * DM + 768 + ch] = f2bf(acc[mi][r] * 0.0013810679320049757f); }
    }
}

#define GAS __attribute__((address_space(1)))
#define XB_TMO      128
#define XB_XCNT(j)  (256  + 64 * (j))
#define XB_XSUB(j)  (1280 + 64 * (j))
#define XB_XGEN(j)  (2304 + 64 * (j))
#define XB_TOP      3328
#define XB_TOPGEN   3392
#define XCD_BAR_WORDS 3456
#define XB_SPIN_CAP (1u << 18)

__device__ __forceinline__ unsigned xb_ld(unsigned* p)              { return __hip_atomic_load(p, __ATOMIC_RELAXED, __HIP_MEMORY_SCOPE_AGENT); }
__device__ __forceinline__ unsigned xb_add(unsigned* p, unsigned v) { return __hip_atomic_fetch_add(p, v, __ATOMIC_RELAXED, __HIP_MEMORY_SCOPE_AGENT); }
__device__ __forceinline__ unsigned xb_xcc_id() { return (unsigned)__builtin_amdgcn_s_getreg((3 << 11) | 20) & 0xFu; }
#define XB_SPIN(cond, bar) do { unsigned _sp = 0; while (cond) { __builtin_amdgcn_s_sleep(1); \
    if ((++_sp & 255u) == 0u) { if (xb_ld(&(bar)[XB_TMO])) break; if (_sp > XB_SPIN_CAP) { atomicAdd(&(bar)[XB_TMO], 1u); break; } } } } while (0)

struct XcdBarrier {
    unsigned* bar; unsigned x;
    volatile LAS unsigned* st;
};

__device__ __forceinline__ XcdBarrier xcd_barrier_post(unsigned* bar, volatile LAS unsigned* st) {
    XcdBarrier b; b.bar = bar; b.x = xb_xcc_id(); b.st = st;
    if (threadIdx.x == 0) (void)xb_add(&bar[XB_XCNT(b.x)], 1u);
    return b;
}
__device__ __forceinline__ void xcd_barrier_complete(unsigned* bar, unsigned x, unsigned& nloc, unsigned& nx) {
    const unsigned G = gridDim.x * gridDim.y * gridDim.z;
    unsigned sum, cnt, mine, sp = 0u;
    for (;;) {
        sum = 0u; cnt = 0u; mine = 0u;
#pragma unroll
        for (unsigned j = 0; j < 16; ++j) { const unsigned c = xb_ld(&bar[XB_XCNT(j)]); sum += c; cnt += (c > 0u) ? 1u : 0u; mine = (j == x) ? c : mine; }
        if (sum == G) break;
        __builtin_amdgcn_s_sleep(1);
        if ((++sp & 255u) == 0u) { if (xb_ld(&bar[XB_TMO])) break; if (sp > XB_SPIN_CAP) { atomicAdd(&bar[XB_TMO], 1u); break; } }
    }
    nloc = mine > 0u ? mine : 1u; nx = cnt > 0u ? cnt : 1u;
}

__device__ __forceinline__ void xcd_barrier(const XcdBarrier& b) {
    asm volatile("s_waitcnt vmcnt(0)" ::: "memory");
    __syncthreads();
    if (threadIdx.x == 0) {
        unsigned* bar = b.bar;
        __builtin_amdgcn_s_waitcnt(0);
        unsigned nloc = b.st[0], nx = b.st[1];
        if (nloc == 0u) { xcd_barrier_complete(bar, b.x, nloc, nx); b.st[0] = nloc; b.st[1] = nx; }
        const unsigned old = xb_add(&bar[XB_XSUB(b.x)], 1u);
        const unsigned gen = old / nloc;
        if (old + 1u == (gen + 1u) * nloc) {
            __builtin_amdgcn_fence(__ATOMIC_RELEASE, "agent");
            asm volatile("s_waitcnt vmcnt(0)" ::: "memory");
            const unsigned og = xb_add(&bar[XB_TOP], 1u);
            const unsigned tg = og / nx;
            if (og + 1u == (tg + 1u) * nx) xb_add(&bar[XB_TOPGEN], 1u);
            else XB_SPIN(xb_ld(&bar[XB_TOPGEN]) == tg, bar);
            __builtin_amdgcn_fence(__ATOMIC_ACQUIRE, "agent");
            xb_add(&bar[XB_XGEN(b.x)], 1u);
            asm volatile("s_waitcnt vmcnt(0)" ::: "memory");
        } else {
            XB_SPIN(xb_ld(&bar[XB_XGEN(b.x)]) == gen, bar);
            __builtin_amdgcn_fence(__ATOMIC_ACQUIRE, "agent");
            asm volatile("s_waitcnt vmcnt(0)" ::: "memory");
        }
    }
    __syncthreads();
}

constexpr int LDS_BYTES = 132096;
constexpr int PH_FINAL = 25, PH_END = 26;
constexpr size_t WS_BAR = WS_MOD + 262144;
constexpr int MISC_OFF = 131072;
__global__ void __launch_bounds__(512, 2) mega(Params Pk, int ph_lo, int ph_hi) {
#if defined(__HIP_DEVICE_COMPILE__)
    extern __shared__ __attribute__((aligned(16))) unsigned char lds_raw[];
    LAS unsigned char* lds = (LAS unsigned char*)lds_raw;
    volatile LAS unsigned* MISC = (volatile LAS unsigned*)(lds + MISC_OFF);
    if (threadIdx.x < 32) MISC[threadIdx.x] = 0u;
    __syncthreads();
    XcdBarrier bar; bar.bar = nullptr; bar.x = 0; bar.st = nullptr;
    for (int ph = ph_lo; ph < ph_hi; ++ph) {
        KP P = (KP)__builtin_amdgcn_kernarg_segment_ptr(); asm volatile("" : "+s"(P));
        if (ph == 0 && blockIdx.x == 0) { unsigned* bw = (unsigned*)(P->ws + WS_BAR); for (int i = threadIdx.x; i < XCD_BAR_WORDS; i += 512) bw[i] = 0u; }
        unsigned char* ws = P->ws;
        float* H = (float*)(ws + WS_H); bf16_t* XN = (bf16_t*)(ws + WS_XN); bf16_t* MID = (bf16_t*)(ws + WS_MID);
        if (ph == 0) prologue_phase(P, lds);
        else if (ph == PH_FINAL) final_phase(P);
        else {
            const int l = (ph - 1) / 12, s = (ph - 1) % 12;
            const float* MODl = (const float*)(ws + WS_MOD) + (size_t)l * 3 * NMOD;
            const bf16_t* WT = (const bf16_t*)(ws + WS_WT) + (size_t)l * WT_L;
            if (s == 0 || s == 3 || s == 8) {
                const float* g = (s == 0 ? P->g_ffn1 : s == 3 ? P->g_mix : P->g_ffn2) + l * 1024; const int shc = s == 0 ? 0 : s == 3 ? 3 : 6;
                norm_phase(P, g, MODl, shc, shc + 1, ph == 1, ph == 1 ? 0 : (s == 8 ? (l == 1 ? 0 : 3) : 10));
            } else if (s == 1 || s == 2 || s == 4 || s == 7 || s == 9 || s == 10) {
                const int mode = (s == 1 || s == 9) ? 0 : (s == 4 ? 2 : 1);
                pg8::EpiAll E{ws, P->g_qn + l * 64, P->g_kn + l * 64, mode, l, s == 2 ? 2 : s == 7 ? 5 : 8, s == 7 ? 1.0f : 0.5f};
                const bf16_t* A = (s == 2 || s == 10) ? MID : XN;
                const bf16_t* Bt = WT + (mode == 0 ? WT_GU + (size_t)(s == 9 ? 1 : 0) * 5632 * 1024 : mode == 2 ? WT_IN : s == 7 ? WT_OUT : WT_DN + (size_t)(s == 10 ? 1 : 0) * 1024 * MIDP);
                const int N = mode == 0 ? 5632 : mode == 2 ? NIN : 1024, K = (s == 2 || s == 10) ? DFF : 1024;
                run_gemm(lds, A, Bt, N, K, (s == 2 || s == 10) ? DFF : 1024, (s == 2 || s == 10) ? 1 : 0, (l == 1 && s >= 7) ? 1 : 0, E);
            }
            else if (s == 5) {
#if FAST_FFT
                fft1_phase(P, l);
#endif
#if FAST_ATTN
                attn_phase(P, lds, l);
#endif
            }
#if FAST_FFT
            else if (s == 6) fft3_phase(P, lds, l);
#endif
        }
        if (ph + 1 < ph_hi) {
            if (ph == 0) { cg::this_grid().sync(); bar = xcd_barrier_post((unsigned*)(P->ws + WS_BAR), MISC + 8); }
            else xcd_barrier(bar);
        }
    }
#endif
}

extern "C" void kernel_launch(void* const* d_in, const int* in_sizes, int n_in, void* d_out, int out_size, void* d_ws, size_t ws_size, hipStream_t stream) {
    static int grid = 0;
    if (grid == 0) {
        if (ws_size < WS_END || n_in < 22) { fprintf(stderr, "kernel_launch: ws too small (%zu) or n_in %d\n", ws_size, n_in); grid = -1; return; }
        if (hipFuncSetAttribute((const void*)mega, hipFuncAttributeMaxDynamicSharedMemorySize, LDS_BYTES) != hipSuccess) { fprintf(stderr, "kernel_launch: hipFuncSetAttribute failed\n"); grid = -1; return; }
        int dev = 0, cus = 0, per_cu = 0; hipGetDevice(&dev); hipDeviceGetAttribute(&cus, hipDeviceAttributeMultiprocessorCount, dev);
        if (hipOccupancyMaxActiveBlocksPerMultiprocessor(&per_cu, (const void*)mega, 512, LDS_BYTES) != hipSuccess || per_cu < 1) { fprintf(stderr, "kernel_launch: occupancy query says %d\n", per_cu); grid = -1; return; }
        grid = cus;
    }
    if (grid < 0) return;
    Params P{};
    const float** pp = (const float**)&P;
    for (int i = 0; i < 22; ++i) pp[i] = (const float*)d_in[i];
    P.out = (float*)d_out; P.ws = (unsigned char*)d_ws;
    int lo = 0, hi = PH_END;
    void* args[] = {&P, &lo, &hi};
    hipError_t e = hipLaunchCooperativeKernel((const void*)mega, dim3(grid), dim3(512), args, LDS_BYTES, stream);
    if (e != hipSuccess) fprintf(stderr, "kernel_launch: cooperative launch failed: %s (grid %d)\n", hipGetErrorString(e), grid);
}
```

```cpp
#include <hip/hip_runtime.h>
#include <hip/hip_cooperative_groups.h>
#include <stdint.h>
#include <cstdio>
namespace cg = cooperative_groups;

typedef unsigned short bf16_t;
typedef float f32x4 __attribute__((ext_vector_type(4)));
__device__ __forceinline__ float bf2f(bf16_t v) { return __uint_as_float(((unsigned)v) << 16); }
__device__ __forceinline__ bf16_t f2bf(float f) { unsigned u = __float_as_uint(f); return (bf16_t)((u + 0x7fffu + ((u >> 16) & 1u)) >> 16); }
__device__ __forceinline__ unsigned pk2(float lo, float hi) { return (unsigned)f2bf(lo) | ((unsigned)f2bf(hi) << 16); }

constexpr int MIDP = 2880;
constexpr int DM = 1024, NB = 2, SEQ = 8192, CTXL = 256, RPB = SEQ + CTXL, M = NB * RPB, DFF = 2816, DIN = 1536, NMOD = 9216, NIN = 1792;
constexpr float QSCALE = 0.125f * 1.4426950408889634f;
constexpr float LOG2E = 1.4426950408889634f;
constexpr size_t MiB = 1u << 20;
constexpr size_t WS_H = 0, WS_XN = 66 * MiB, WS_MID = 99 * MiB;
constexpr size_t WS_QA = 99 * MiB, WS_QB = 112 * MiB, WS_KA = 125 * MiB, WS_KB = 130 * MiB, WS_VTA = 135 * MiB, WS_VTB = 140 * MiB, WS_VS = 145 * MiB, WS_ZS = 161 * MiB, WS_VC = 177 * MiB;
constexpr size_t WS_MOD = 201129984, WS_TAB = WS_MOD + 294912, WS_WT = WS_MOD + 524288, WS_PART = 270 * MiB, WS_END = 290 * MiB;
constexpr int TAB_COS = 0, TAB_ROPE = 8192;
constexpr size_t TAB_D1_BYTES = 65536, TAB_D3_BYTES = 65536 + 32768;
constexpr size_t WT_GU = 0, WT_DN = 2ull * 5632 * 1024, WT_IN = WT_DN + 2ull * 1024 * MIDP, WT_OUT = WT_IN + 1792ull * 1024, WT_L = WT_OUT + 1024ull * 1024;
static_assert(WS_WT + 2 * WT_L * 2 <= WS_PART, "ws map");

__device__ __forceinline__ float silu_f(float x) { return x * __builtin_amdgcn_rcpf(1.f + __expf(-x)); }
__device__ __forceinline__ int row_w(int row) { int b = row / RPB, t = row - b * RPB; return t >= SEQ ? 2 : b; }

struct Params {
    const float *x, *c, *ctx, *cctx, *w_ada, *b_ada, *g_ffn1, *g_mix, *g_ffn2, *w_in, *g_qn, *g_kn, *sink, *w_four, *w_out, *w1g, *w1u, *w1d, *w2g, *w2u, *w2d, *g_final;
    float* out; unsigned char* ws;
};
typedef const __attribute__((address_space(4))) Params* KP;

namespace pg8 {
#define PG8_LAS __attribute__((address_space(3)))
typedef unsigned short bf16_t;
typedef short bf16x8 __attribute__((ext_vector_type(8)));
typedef float f32x4 __attribute__((ext_vector_type(4)));
typedef unsigned u32x4 __attribute__((ext_vector_type(4)));
constexpr int BM = 256, BK = 64, HALF = 128, HTB = HALF * BK * 2  , STAGE_BYTES = 8 * HTB, NXCD = 8, WGM = 8;

__host__ __device__ __forceinline__ int lds_byte(int r, int c) { const int st = (r >> 4) * 2 + (c >> 5), rr = r & 15, cc = c & 31, ob = rr * 64 + cc * 2; return st * 1024 + (ob ^ (((ob >> 9) & 1) << 5)); }
__host__ __device__ __forceinline__ void stage_rc(int b, int& R, int& C) { const int st = b / 1024, sb = b % 1024, swz = sb ^ (((sb >> 9) & 1) << 5); R = (st >> 1) * 16 + swz / 64; C = (st & 1) * 32 + (swz % 64) / 2; }
__host__ __device__ __forceinline__ int perm32(int rho) { const int n = rho >> 4, i = rho & 15; return 8 * (i >> 2) + 4 * n + (i & 3); }

struct Unit { int pm, pn, ko; };
struct Gemm { const bf16_t* A; const bf16_t* Bt; int M, N, K, ld, blocked; };

struct StaticOrder {
    int nM, nN, nwg, G, c;
    __host__ __device__ void init(int M, int N, int G_, int c_) { nM = M / BM; nN = N / BM; nwg = nM * nN; G = G_; c = c_; }
    __host__ __device__ bool next(int i, Unit& u) const {
        const long L = (long)i * G + c; if (L >= nwg) return false;
        int wgid = (int)L; { const int q = nwg / NXCD, r = nwg % NXCD, xcd = wgid % NXCD, off = wgid / NXCD; wgid = (xcd < r ? xcd * (q + 1) : r * (q + 1) + (xcd - r) * q) + off; }
        const int nig = WGM * nN, gid = wgid / nig, fm = gid * WGM, gsz = (nM - fm) < WGM ? (nM - fm) : WGM;
        u.pm = fm + ((wgid % nig) % gsz); u.pn = (wgid % nig) / gsz; return true;
    }
    __device__ __forceinline__ void a_ready(const Unit&) const {}
    __device__ __forceinline__ void done(const Unit&) const {}
};

struct SplitOrder {
    int mode, nchunk, kchunk; StaticOrder S;
    __device__ void init(int mode_, int Mrows, int N, int G, int c, int nchunk_, int kchunk_) { mode = mode_; nchunk = nchunk_; kchunk = kchunk_; S.init(mode_ == 1 ? 64 * BM : Mrows, N, G, c); }
    __device__ bool next(int i, Unit& u) const {
        if (mode == 2) { const long L = (long)i * S.G + S.c; if (L >= 8 * nchunk) return false; const int un = (int)L / nchunk, ch = (int)L - un * nchunk;
            u.pm = (un >> 2) ? 65 : 32; u.pn = un & 3; u.ko = ch * kchunk; return true; }
        if (!S.next(i, u)) return false;
        u.ko = 0; if (mode == 1) u.pm += u.pm >> 5;
        return true;
    }
    __device__ __forceinline__ void a_ready(const Unit&) const {}
    __device__ __forceinline__ void done(const Unit&) const {}
};

__device__ __forceinline__ unsigned cvt_pk_bf16(float lo, float hi) { unsigned r; asm("v_cvt_pk_bf16_f32 %0, %1, %2" : "=v"(r) : "v"(lo), "v"(hi)); return r; }
__device__ __forceinline__ int tile_w(int pm) { const int b = pm / 33, wi = pm - b * 33; return wi == 32 ? 2 : b; }
struct EpiSwiglu {
    static constexpr bool PERM = false, AFTER_DRAIN = false;
    bf16_t* O;
    __device__ __forceinline__ void operator()(const f32x4 (&acc)[2][2][4][2], const Unit& u, int wr, int wc, int fr, int fq) const {
        const int row0 = u.pm * BM + wr * 64 + fr, col = u.pn * 128 + wc * 32 + fq * 8;
#pragma unroll
        for (int ai = 0; ai < 2; ++ai)
#pragma unroll
            for (int m = 0; m < 4; ++m) {
                const f32x4 g0 = acc[ai][0][m][0], u0 = acc[ai][1][m][0], g1 = acc[ai][0][m][1], u1 = acc[ai][1][m][1];
                u32x4 w;
                w.x = cvt_pk_bf16(silu_f(g0[0]) * u0[0], silu_f(g0[1]) * u0[1]); w.y = cvt_pk_bf16(silu_f(g0[2]) * u0[2], silu_f(g0[3]) * u0[3]);
                w.z = cvt_pk_bf16(silu_f(g1[0]) * u1[0], silu_f(g1[1]) * u1[1]); w.w = cvt_pk_bf16(silu_f(g1[2]) * u1[2], silu_f(g1[3]) * u1[3]);
                *(u32x4*)(O + (size_t)u.pm * BM * DFF + (size_t)(col >> 6) * (BM * 64) + (size_t)(wr * 64 + fr + ai * HALF + m * 16) * 64 + (col & 63)) = w;
            }
    }
};
struct EpiRes {
    static constexpr bool PERM = false, AFTER_DRAIN = false;
    float* H; const float* MODl; int gate_chunk; float coef; float* PART;
    __device__ __forceinline__ void operator()(const f32x4 (&acc)[2][2][4][2], const Unit& u, int wr, int wc, int fr, int fq) const {
        const float* gate = MODl + tile_w(u.pm) * NMOD + gate_chunk * 1024;
        const bool part = u.ko != 0;
        float* base = part ? PART + ((size_t)((u.ko >> 8) - 1) * 512 + (u.pm == 32 ? 0 : 256) + wr * 64 + fr) * DM : H + (size_t)(u.pm * BM + wr * 64 + fr) * DM;
#pragma unroll
        for (int bj = 0; bj < 2; ++bj)
#pragma unroll
            for (int n = 0; n < 2; ++n) {
                const int col = u.pn * BM + bj * HALF + wc * 32 + n * 16 + fq * 4;
                const f32x4 gv = *(const f32x4*)(gate + col) * coef;
                f32x4 old[2][4];
#pragma unroll
                for (int ai = 0; ai < 2; ++ai)
#pragma unroll
                    for (int m = 0; m < 4; ++m) old[ai][m] = part ? (f32x4){0.f, 0.f, 0.f, 0.f} : *(const f32x4*)(base + (size_t)(ai * HALF + m * 16) * DM + col);
#pragma unroll
                for (int ai = 0; ai < 2; ++ai)
#pragma unroll
                    for (int m = 0; m < 4; ++m) *(f32x4*)(base + (size_t)(ai * HALF + m * 16) * DM + col) = old[ai][m] + gv * acc[ai][bj][m][n];
            }
    }
};
struct EpiWin {
    static constexpr bool PERM = false, AFTER_DRAIN = false;
    const float* gqn; const float* gkn; const float* ROPE;
    bf16_t *QA, *QB, *KA, *KB, *VTA, *VTB; unsigned *VS, *VC;
    __device__ __forceinline__ void operator()(const f32x4 (&acc)[2][2][4][2], const Unit& u, int wr, int wc, int fr, int fq) const {
        const int unit = u.pn * 4 + wc;
        const int b = u.pm / 33, wi = u.pm - b * 33; const bool lat = wi < 32; const int t0 = wi * 256;
        if (unit < 20) {
            const bool isB = unit >= 10; const int ul = isB ? unit - 10 : unit;
            const bool isq = ul < 6, isk = ul >= 6 && ul < 8;
            f32x4 gg[2][2];
            if (isB && (isq || isk)) { const float* g = isq ? gqn : gkn;
#pragma unroll
                for (int bj = 0; bj < 2; ++bj)
#pragma unroll
                    for (int n = 0; n < 2; ++n) gg[bj][n] = *(const f32x4*)(g + 32 * bj + 16 * n + 4 * fq); }
#pragma unroll
            for (int ai = 0; ai < 2; ++ai)
#pragma unroll
                for (int m = 0; m < 4; ++m) {
                    const int t = t0 + ai * HALF + wr * 64 + m * 16 + fr; const size_t row = (size_t)b * RPB + t;
                    f32x4 v[2][2];
#pragma unroll
                    for (int bj = 0; bj < 2; ++bj)
#pragma unroll
                        for (int n = 0; n < 2; ++n) v[bj][n] = acc[ai][bj][m][n];
                    if (isB && (isq || isk)) {
                        float ss = 0.f;
#pragma unroll
                        for (int bj = 0; bj < 2; ++bj)
#pragma unroll
                            for (int n = 0; n < 2; ++n) ss += (v[bj][n][0] * v[bj][n][0] + v[bj][n][1] * v[bj][n][1]) + (v[bj][n][2] * v[bj][n][2] + v[bj][n][3] * v[bj][n][3]);
                        ss += __shfl_xor(ss, 16); ss += __shfl_xor(ss, 32);
                        const float r = rsqrtf(ss * (1.f / 64.f) + 1e-6f);
#pragma unroll
                        for (int bj = 0; bj < 2; ++bj)
#pragma unroll
                            for (int n = 0; n < 2; ++n) v[bj][n] = v[bj][n] * r * gg[bj][n];
                    }
                    if (lat && (isq || isk)) {
#pragma unroll
                        for (int bj = 0; bj < 2; ++bj) {
                            const int p = bj == 0 ? (t >> 6) : 128 + (t & 63);
                            const f32x4 cs0 = *(const f32x4*)(ROPE + (p * 16 + 4 * fq) * 2), cs1 = *(const f32x4*)(ROPE + (p * 16 + 4 * fq) * 2 + 4);
                            const f32x4 cv = {cs0[0], cs0[2], cs1[0], cs1[2]}, sv = {cs0[1], cs0[3], cs1[1], cs1[3]};
                            const f32x4 a = v[bj][0], bb = v[bj][1];
                            v[bj][0] = a * cv - bb * sv; v[bj][1] = bb * cv + a * sv;
                        }
                    }
                    if (isq || isk) {
                        const float sc = isq ? QSCALE : 1.f;
                        bf16_t* dst = isq ? ((isB ? QB : QA) + row * 384 + ul * 64) : ((isB ? KB : KA) + row * 128 + (ul - 6) * 64);
#pragma unroll
                        for (int bj = 0; bj < 2; ++bj)
#pragma unroll
                            for (int n = 0; n < 2; ++n) { const f32x4 x = v[bj][n] * sc; uint2 w; w.x = cvt_pk_bf16(x[0], x[1]); w.y = cvt_pk_bf16(x[2], x[3]);
                                *(uint2*)(dst + 32 * bj + 16 * n + 4 * fq) = w; }
                    } else {
                        bf16_t* dst = (isB ? VTB : VTA) + ((size_t)(b * 2 + (ul - 8)) * 64) * RPB + t;
#pragma unroll
                        for (int bj = 0; bj < 2; ++bj)
#pragma unroll
                            for (int n = 0; n < 2; ++n)
#pragma unroll
                                for (int i = 0; i < 4; ++i) dst[(size_t)(32 * bj + 16 * n + 4 * fq + i) * RPB] = f2bf(v[bj][n][i]);
                    }
                }
        } else {
            const int chb = ((unit - 20) >> 1) * 64 + 32 * ((unit - 20) & 1);
#pragma unroll
            for (int ai = 0; ai < 2; ++ai)
#pragma unroll
                for (int m = 0; m < 4; ++m) {
                    const int t = t0 + ai * HALF + wr * 64 + m * 16 + fr;
#pragma unroll
                    for (int bj = 0; bj < 2; ++bj)
#pragma unroll
                        for (int n = 0; n < 2; ++n) {
                            const f32x4 x = acc[ai][bj][m][n]; const int ch = chb + 16 * bj + 8 * n + 2 * fq;
                            const unsigned w0 = cvt_pk_bf16(x[0], x[1]), w1 = cvt_pk_bf16(x[2], x[3]);
                            if (lat) { unsigned* d = VS + ((size_t)(b * SEQ + t) * 256 + ch); d[0] = w0; d[1] = w1; }
                            else { unsigned* d = VC + ((size_t)(b * 256 + (t - SEQ)) * 256 + ch); d[0] = w0; d[1] = w1; }
                        }
                }
        }
    }
};

struct EpiAll {
    static constexpr bool PERM = false, AFTER_DRAIN = false;
    unsigned char* ws; const float* gqn; const float* gkn; int mode, l, chunk; float coef;
    __device__ __forceinline__ void operator()(const f32x4 (&acc)[2][2][4][2], const Unit& u, int wr, int wc, int fr, int fq) const {
        if (mode == 0) { EpiSwiglu E{(bf16_t*)(ws + WS_MID)}; E(acc, u, wr, wc, fr, fq); }
        else if (mode == 1) { EpiRes E{(float*)(ws + WS_H), (const float*)(ws + WS_MOD) + (size_t)l * 3 * NMOD, chunk, coef, (float*)(ws + WS_PART)}; E(acc, u, wr, wc, fr, fq); }
        else { EpiWin E{gqn, gkn, (const float*)(ws + WS_TAB) + TAB_ROPE, (bf16_t*)(ws + WS_QA), (bf16_t*)(ws + WS_QB), (bf16_t*)(ws + WS_KA), (bf16_t*)(ws + WS_KB),
                        (bf16_t*)(ws + WS_VTA), (bf16_t*)(ws + WS_VTB), (unsigned*)(ws + WS_VS), (unsigned*)(ws + WS_VC)}; E(acc, u, wr, wc, fr, fq); }
    }
};

template <class Epi, class Sched, bool ALIGN_EPI = false, bool SP2 = false>
__device__ __forceinline__ void gemm_phase(PG8_LAS unsigned char* lds, const Gemm g, const Sched& S, const Epi& E) {
    int tid_ = threadIdx.x; asm volatile("" : "+v"(tid_)); const int tid = tid_, wid = __builtin_amdgcn_readfirstlane(tid >> 6), lane = tid & 63, wr = wid >> 2, wc = wid & 3, fr = lane & 15, fq = lane >> 4;
    const int K = g.K, nt = K / BK, LD = g.blocked ? BK : g.ld;
    unsigned voffA[2], voffB[2];
#pragma unroll
    for (int i = 0; i < 2; ++i) { int R, C; stage_rc(tid * 16 + i * 8192, R, C); const int Rb = Epi::PERM ? ((R & ~31) + perm32(R & 31)) : R;
        voffA[i] = (unsigned)(R * LD + C) * 2u; voffB[i] = (unsigned)(Rb * LD + C) * 2u; }
    const size_t kstep = g.blocked ? (size_t)(BM * BK * 2) : (size_t)(BK * 2);
    const size_t hstep = (size_t)HALF * LD * 2;
    const size_t tstep = g.blocked ? (size_t)BM * g.ld * 2 : 2 * hstep;
    const unsigned ldsw = (unsigned)wid * 1024u;
    const int aoff = lds_byte(wr * 64 + fr, fq * 8), boff = lds_byte(wc * 32 + fr, fq * 8);
#define PG8_SA(b, h) (((b) * 2 + (h)) * HTB)
#define PG8_SB(b, h) ((4 + (b) * 2 + (h)) * HTB)
#define PG8_STAGE(bufoff, gbase, voff) do { _Pragma("unroll") for (int _i = 0; _i < 2; ++_i) \
        __builtin_amdgcn_global_load_lds((const unsigned*)((const char*)(gbase) + (voff)[_i]), (PG8_LAS unsigned*)(lds + (bufoff) + ldsw + _i * 8192), 16, 0, 0); } while (0)
#define PG8_LDA(dst, b, h) do { _Pragma("unroll") for (int m = 0; m < 4; ++m) _Pragma("unroll") for (int k = 0; k < 2; ++k) dst[m][k] = *(const PG8_LAS bf16x8*)(lds + PG8_SA(b, h) + aoff + m * 2048 + k * 1024); } while (0)
#define PG8_LDB(dst, b, h) do { _Pragma("unroll") for (int n = 0; n < 2; ++n) _Pragma("unroll") for (int k = 0; k < 2; ++k) dst[n][k] = *(const PG8_LAS bf16x8*)(lds + PG8_SB(b, h) + boff + n * 2048 + k * 1024); } while (0)
#define PG8_MMA(ai, bj, At, Bt) do { __builtin_amdgcn_s_setprio(1); _Pragma("unroll") for (int m = 0; m < 4; ++m) _Pragma("unroll") for (int n = 0; n < 2; ++n) _Pragma("unroll") for (int k = 0; k < 2; ++k) \
        acc[ai][bj][m][n] = __builtin_amdgcn_mfma_f32_16x16x32_bf16(Bt[n][k], At[m][k], acc[ai][bj][m][n], 0, 0, 0); __builtin_amdgcn_s_setprio(0); } while (0)
#define PG8_WAIT_V(n) asm volatile("s_waitcnt vmcnt(" #n ")" ::: "memory")
#define PG8_WAIT_L(n) asm volatile("s_waitcnt lgkmcnt(" #n ")" ::: "memory")
#define PG8_BAR __builtin_amdgcn_s_barrier()
#define PG8_SCHED __builtin_amdgcn_sched_barrier(0)
    Unit cur, nxt; int ui = 0;
    if (!S.next(0, cur)) return;
    f32x4 acc[2][2][4][2];
#pragma unroll
    for (int a = 0; a < 2; ++a)
#pragma unroll
        for (int b = 0; b < 2; ++b)
#pragma unroll
            for (int m = 0; m < 4; ++m)
#pragma unroll
                for (int n = 0; n < 2; ++n) acc[a][b][m][n] = (f32x4){0.f, 0.f, 0.f, 0.f};
    bf16x8 At[4][2], B0[2][2], B1[2][2];
    const char* cA = (const char*)g.A + (size_t)cur.pm * tstep + (size_t)(cur.ko / BK) * kstep; const char* cB = (const char*)g.Bt + (size_t)cur.pn * tstep + (size_t)(cur.ko / BK) * kstep;
    S.a_ready(cur);
    if constexpr (SP2) {
        PG8_STAGE(PG8_SB(0, 0), cB, voffB); PG8_STAGE(PG8_SB(0, 1), cB + hstep, voffB); PG8_STAGE(PG8_SA(0, 0), cA, voffA); PG8_STAGE(PG8_SA(0, 1), cA + hstep, voffA);
        if (wr == 1) PG8_BAR;
        PG8_WAIT_V(2); PG8_BAR;
        PG8_STAGE(PG8_SB(1, 0), cB + kstep, voffB); PG8_STAGE(PG8_SA(1, 0), cA + kstep, voffA); PG8_STAGE(PG8_SB(1, 1), cB + hstep + kstep, voffB);
        PG8_WAIT_V(6); PG8_BAR;
    } else {
        PG8_STAGE(PG8_SB(0, 0), cB, voffB); PG8_STAGE(PG8_SA(0, 0), cA, voffA); PG8_STAGE(PG8_SB(0, 1), cB + hstep, voffB); PG8_STAGE(PG8_SA(0, 1), cA + hstep, voffA);
        if (wr == 1) PG8_BAR;
        PG8_WAIT_V(4); PG8_BAR;
        PG8_STAGE(PG8_SB(1, 0), cB + kstep, voffB); PG8_STAGE(PG8_SA(1, 0), cA + kstep, voffA); PG8_STAGE(PG8_SB(1, 1), cB + hstep + kstep, voffB);
        PG8_WAIT_V(6); PG8_BAR;
    }
    for (;;) {
        const bool has_next = S.next(ui + 1, nxt);
        const char* nA = has_next ? (const char*)g.A + (size_t)nxt.pm * tstep + (size_t)(nxt.ko / BK) * kstep : cA; const char* nB = has_next ? (const char*)g.Bt + (size_t)nxt.pn * tstep + (size_t)(nxt.ko / BK) * kstep : cB;
        for (int t = 0; t < nt; t += 2) {
            const bool last = (t == nt - 2);
            const char* a1 = cA + (size_t)(t + 1) * kstep;
            const char* a2 = last ? nA : cA + (size_t)(t + 2) * kstep; const char* b2 = last ? nB : cB + (size_t)(t + 2) * kstep;
            const char* a3 = a2 + kstep; const char* b3 = b2 + kstep;
            if (last && has_next) S.a_ready(nxt);
            if constexpr (SP2) {
            PG8_LDB(B0, 0, 0); PG8_LDB(B1, 0, 1); PG8_SCHED; PG8_LDA(At, 0, 0); PG8_STAGE(PG8_SA(1, 1), a1 + hstep, voffA);
            PG8_WAIT_V(8); PG8_WAIT_L(0); PG8_BAR; PG8_MMA(0, 0, At, B0); PG8_MMA(0, 1, At, B1); PG8_BAR; PG8_SCHED;
            PG8_LDA(At, 0, 1); PG8_STAGE(PG8_SB(0, 0), b2, voffB); PG8_STAGE(PG8_SB(0, 1), b2 + hstep, voffB); PG8_STAGE(PG8_SA(0, 0), a2, voffA);
            PG8_WAIT_V(8); PG8_WAIT_L(0); PG8_BAR; PG8_MMA(1, 0, At, B0); PG8_MMA(1, 1, At, B1); PG8_BAR; PG8_SCHED;
            PG8_LDB(B0, 1, 0); PG8_LDB(B1, 1, 1); PG8_SCHED; PG8_LDA(At, 1, 0); PG8_STAGE(PG8_SA(0, 1), a2 + hstep, voffA);
            PG8_WAIT_V(8); PG8_WAIT_L(0); PG8_BAR; PG8_MMA(0, 0, At, B0); PG8_MMA(0, 1, At, B1); PG8_BAR; PG8_SCHED;
            PG8_LDA(At, 1, 1); PG8_STAGE(PG8_SB(1, 0), b3, voffB); PG8_STAGE(PG8_SB(1, 1), b3 + hstep, voffB); PG8_STAGE(PG8_SA(1, 0), a3, voffA);
            PG8_WAIT_V(8); PG8_WAIT_L(0); PG8_BAR; PG8_MMA(1, 0, At, B0); PG8_MMA(1, 1, At, B1); PG8_BAR; PG8_SCHED;
            } else {
            PG8_LDB(B0, 0, 0); PG8_SCHED; PG8_LDA(At, 0, 0); PG8_STAGE(PG8_SA(1, 1), a1 + hstep, voffA);
            PG8_WAIT_L(8); PG8_BAR; PG8_WAIT_L(0); PG8_MMA(0, 0, At, B0); PG8_BAR; PG8_SCHED;
            PG8_LDB(B1, 0, 1); PG8_STAGE(PG8_SB(0, 0), b2, voffB);
            PG8_BAR; PG8_WAIT_L(0); PG8_MMA(0, 1, At, B1); PG8_BAR;
            PG8_LDA(At, 0, 1); PG8_STAGE(PG8_SA(0, 0), a2, voffA);
            PG8_BAR; PG8_WAIT_L(0); PG8_MMA(1, 0, At, B0); PG8_BAR; PG8_SCHED;
            PG8_STAGE(PG8_SB(0, 1), b2 + hstep, voffB);
            PG8_WAIT_V(6); PG8_BAR; PG8_MMA(1, 1, At, B1); PG8_BAR;
            PG8_LDB(B0, 1, 0); PG8_SCHED; PG8_LDA(At, 1, 0); PG8_STAGE(PG8_SA(0, 1), a2 + hstep, voffA);
            PG8_WAIT_L(8); PG8_BAR; PG8_WAIT_L(0); PG8_MMA(0, 0, At, B0); PG8_BAR; PG8_SCHED;
            PG8_LDB(B1, 1, 1); PG8_STAGE(PG8_SB(1, 0), b3, voffB);
            PG8_BAR; PG8_WAIT_L(0); PG8_MMA(0, 1, At, B1); PG8_BAR;
            PG8_LDA(At, 1, 1); PG8_STAGE(PG8_SA(1, 0), a3, voffA);
            PG8_BAR; PG8_WAIT_L(0); PG8_MMA(1, 0, At, B0); PG8_BAR; PG8_SCHED;
            PG8_STAGE(PG8_SB(1, 1), b3 + hstep, voffB);
            PG8_WAIT_V(6); PG8_BAR; PG8_MMA(1, 1, At, B1); PG8_BAR;
            }
        }
        if constexpr (ALIGN_EPI) { if (wr == 0) PG8_BAR; }
        if constexpr (!Epi::AFTER_DRAIN) { E(acc, cur, wr, wc, fr, fq); S.done(cur); }
        if (!has_next) break;
#pragma unroll
        for (int a = 0; a < 2; ++a)
#pragma unroll
            for (int b = 0; b < 2; ++b)
#pragma unroll
                for (int m = 0; m < 4; ++m)
#pragma unroll
                    for (int n = 0; n < 2; ++n) acc[a][b][m][n] = (f32x4){0.f, 0.f, 0.f, 0.f};
        cur = nxt; cA = nA; cB = nB; ++ui;
        if constexpr (ALIGN_EPI) { if (wr == 1) PG8_BAR; }
    }
    PG8_WAIT_V(0);
    if constexpr (!ALIGN_EPI) { if (wr == 0) PG8_BAR; }
    PG8_BAR;
    if constexpr (Epi::AFTER_DRAIN) { E.fused(acc, cur, wr, wc, fr, fq, lds, wid, lane); S.done(cur); }
#undef PG8_SA
#undef PG8_SB
#undef PG8_STAGE
#undef PG8_LDA
#undef PG8_LDB
#undef PG8_MMA
#undef PG8_WAIT_V
#undef PG8_WAIT_L
#undef PG8_BAR
#undef PG8_SCHED
}
}
#define FAST_ATTN 1
#define FAST_FFT 1
#define LAS __attribute__((address_space(3)))
__device__ __forceinline__ float wave_sum(float v) {
#pragma unroll
    for (int o = 1; o < 64; o <<= 1) v += __shfl_xor(v, o);
    return v;
}
__device__ __forceinline__ void tr_write(const LAS float* scr, bf16_t* Bt, int ldk, int k0, int P0, int P1, int P2, int P3, int lane) {
    const int c = lane & 7, nl = lane >> 3;
#pragma unroll
    for (int j = 0; j < 4; ++j) { const int n = nl + 8 * j; const LAS float* s = scr + (8 * c) * 33 + n; const int P = j == 0 ? P0 : j == 1 ? P1 : j == 2 ? P2 : P3;
        uint4 o; o.x = pk2(s[0], s[33]); o.y = pk2(s[2 * 33], s[3 * 33]); o.z = pk2(s[4 * 33], s[5 * 33]); o.w = pk2(s[6 * 33], s[7 * 33]);
        *(uint4*)(Bt + (size_t)P * ldk + k0 + 8 * c) = o; }
    asm volatile("s_waitcnt lgkmcnt(0)" ::: "memory");
}
__device__ __forceinline__ void tr_load(LAS float* scr, const float* W, int ldw, int k0, int col0, int lane) {
    float v[32];
#pragma unroll
    for (int i = 0; i < 32; ++i) v[i] = __builtin_nontemporal_load(W + (size_t)(k0 + 2 * i + (lane >> 5)) * ldw + col0 + (lane & 31));
#pragma unroll
    for (int i = 0; i < 32; ++i) scr[(2 * i + (lane >> 5)) * 33 + (lane & 31)] = v[i];
    asm volatile("s_waitcnt lgkmcnt(0)" ::: "memory");
}
__device__ __forceinline__ int perm_gu(int j, int t) { const int jj = j & 127; return 256 * (j >> 7) + 128 * t + 32 * (jj >> 5) + 16 * ((jj & 7) >> 2) + 4 * ((jj & 31) >> 3) + (jj & 3); }
__device__ __forceinline__ int perm_in(int u, int d) { return 256 * (u >> 2) + 32 * (u & 3) + 128 * (d >> 5) + (d & 31); }

__device__ __forceinline__ void prologue_phase(KP P, LAS unsigned char* lds) {
    int tid_ = threadIdx.x, bid_ = blockIdx.x; asm volatile("" : "+v"(tid_)); asm volatile("" : "+s"(bid_));
    const int tid = tid_, lane = tid & 63, wave = tid >> 6, bid = bid_, G = gridDim.x;
    float* MOD = (float*)(P->ws + WS_MOD); float* TAB = (float*)(P->ws + WS_TAB);
    LAS float* cs64 = (LAS float*)(lds + 8 * 8448);
    LAS unsigned* ctr = (LAS unsigned*)(lds + 8 * 8448 + 256);
    if (tid < 64) cs64[tid] = cospif((float)tid / 32.f);
    if (tid == 64) ctr[0] = 0u;
    {
        const int i = bid * 512 + tid;
        if (i < 8192) TAB[TAB_COS + i] = cospif((float)i / 4096.f);
        else if (i < 8192 + 3072) { const int e = i - 8192, p = e / 16, k = e % 16; const float inv = powf(10000.f, -(float)(2 * k) / 32.f);
            const float ang = (float)(p < 128 ? p : p - 128) * inv; TAB[TAB_ROPE + e * 2] = cosf(ang); TAB[TAB_ROPE + e * 2 + 1] = sinf(ang); }
        else if (i < 8192 + 3072 + 16384) { const int e = i - 8192 - 3072, mrow = e >> 7, kcol = e & 127; const int k1 = mrow >> 1, ro = mrow & 1, l1 = kcol >> 1, ri = kcol & 1;
            const int j = (k1 * l1) & 63; const float cv = cospif((float)j / 32.f), sv = sinpif((float)j / 32.f);
            const float v = (ro == ri) ? cv : (ro == 0 ? sv : -sv);
            ((bf16_t*)(P->ws + WS_TAB + TAB_D1_BYTES))[e] = f2bf(v); }
        else if (i < 8192 + 3072 + 16384 + 32768) { const int e = i - 8192 - 3072 - 16384, k2 = e >> 8, kcol = e & 255, l2 = kcol >> 1, ri = kcol & 1;
            const int j = (k2 * l2) & 127; const float v = ri == 0 ? cospif((float)j / 64.f) : sinpif((float)j / 64.f);
            ((bf16_t*)(P->ws + WS_TAB + TAB_D3_BYTES))[e] = f2bf(v); }
    }
    {
        LAS float* sv = (LAS float*)lds;
        LAS float* red = (LAS float*)(lds + 12288);
        for (int i = tid; i < 1024; i += 512) { sv[i] = silu_f(P->c[i]); sv[1024 + i] = silu_f(P->c[1024 + i]); sv[2048 + i] = silu_f(P->cctx[i]); }
        __syncthreads();
        for (int it = bid; it < 256; it += G) {
            const int l = it >> 7, n0 = (it & 127) * 72;
            const float* W = P->w_ada + (size_t)l * 1024 * NMOD + n0;
            float a0 = 0.f, a1 = 0.f, a2 = 0.f, e0 = 0.f, e1 = 0.f, e2 = 0.f;
            const int ks = wave * 128 + 16 * (lane >> 3);
#pragma unroll
            for (int j = 0; j < 16; ++j) { const float w = __builtin_nontemporal_load(W + (size_t)(ks + j) * NMOD + 64 + (lane & 7)); e0 += sv[ks + j] * w; e1 += sv[1024 + ks + j] * w; e2 += sv[2048 + ks + j] * w; }
#pragma unroll 32
            for (int k = wave * 128; k < wave * 128 + 128; ++k) { const float w = __builtin_nontemporal_load(W + (size_t)k * NMOD + lane); a0 += sv[k] * w; a1 += sv[1024 + k] * w; a2 += sv[2048 + k] * w; }
#pragma unroll
            for (int o = 8; o < 64; o <<= 1) { e0 += __shfl_xor(e0, o); e1 += __shfl_xor(e1, o); e2 += __shfl_xor(e2, o); }
            red[(wave * 3 + 0) * 72 + lane] = a0; red[(wave * 3 + 1) * 72 + lane] = a1; red[(wave * 3 + 2) * 72 + lane] = a2;
            if (lane < 8) { red[(wave * 3 + 0) * 72 + 64 + lane] = e0; red[(wave * 3 + 1) * 72 + 64 + lane] = e1; red[(wave * 3 + 2) * 72 + 64 + lane] = e2; }
            __syncthreads();
            if (tid < 216) { const int w = tid / 72, cc = tid - w * 72; float s = P->b_ada[l * NMOD + n0 + cc];
#pragma unroll
                for (int q = 0; q < 8; ++q) s += red[(q * 3 + w) * 72 + cc];
                MOD[(size_t)(l * 3 + w) * NMOD + n0 + cc] = s; }
            __syncthreads();
        }
    }
    {
        LAS float* scr = (LAS float*)(lds + wave * 8448);
        const int nl = lane >> 3;
        for (int hid = bid + G * wave; hid < 768 && wave < 8; hid += 8 * G) {
            const int l = hid / 384; int r = hid - l * 384;
            bf16_t* WT = (bf16_t*)(P->ws + WS_WT) + (size_t)l * WT_L;
            if (r < 256) {
                const int kb = r / 16, ob = r % 16;
                const int u = 20 + (ob >> 1), g = (u - 20) >> 1, half = (u - 20) & 1, q = (ob & 1) * 32 + (lane & 31);
                const int dch = 32 * half + (q >> 1), ri = q & 1;
                const float* W = P->w_in + (size_t)l * 1024 * DIN + 1280 + g * 64;
                float tw[64];
#pragma unroll
                for (int cc = 0; cc < 64; ++cc) { const int j = (cc * dch) & 63; tw[cc] = ri == 0 ? cs64[j] : -cs64[(j - 16) & 63]; }
                for (int i = 0; i < 32; ++i) { const int kk = 2 * i + (lane >> 5); const float4* w4 = (const float4*)(W + (size_t)(kb * 64 + kk) * DIN); float a = 0.f;
#pragma unroll
                    for (int c4 = 0; c4 < 16; ++c4) { const float4 wv = w4[c4]; a += wv.x * tw[4 * c4] + wv.y * tw[4 * c4 + 1] + wv.z * tw[4 * c4 + 2] + wv.w * tw[4 * c4 + 3]; }
                    scr[kk * 33 + (lane & 31)] = a; }
                asm volatile("s_waitcnt lgkmcnt(0)" ::: "memory");
                const int d = (ob & 1) * 32 + nl;
                tr_write(scr, WT + WT_IN, 1024, kb * 64, perm_in(u, d), perm_in(u, d + 8), perm_in(u, d + 16), perm_in(u, d + 24), lane);
            } else {
                r -= 256; const int g = r / 32, nb = r % 32;
                const float* wo = P->w_out + (size_t)l * 1024 * 1024 + (size_t)(768 + g * 64) * 1024 + nb * 32 + (lane & 31);
                const float* wf = P->w_four + (size_t)(l * 4 + g) * 4096;
                float wov[64];
#pragma unroll
                for (int d = 0; d < 64; ++d) wov[d] = wo[(size_t)d * 1024];
                for (int i = 0; i < 32; ++i) { const int kk = 2 * i + (lane >> 5); const float4* f4 = (const float4*)(wf + kk * 64); float a = 0.f;
#pragma unroll
                    for (int d4 = 0; d4 < 16; ++d4) { const float4 fv = f4[d4]; a += fv.x * wov[4 * d4] + fv.y * wov[4 * d4 + 1] + fv.z * wov[4 * d4 + 2] + fv.w * wov[4 * d4 + 3]; }
                    scr[kk * 33 + (lane & 31)] = a; }
                asm volatile("s_waitcnt lgkmcnt(0)" ::: "memory");
                const int j = nb * 32 + nl;
                tr_write(scr, WT + WT_OUT, 1024, 768 + g * 64, j, j + 8, j + 16, j + 24, lane);
            }
        }
        constexpr int NA = 4 * 1408, NBd = 2 * 1408, NC = 640, NE = 384, NL = NA + NBd + NC + NE;
        const int lo = (int)(((long)bid * (2 * NL)) / G), hi = (int)(((long)(bid + 1) * (2 * NL)) / G);
        for (;;) {
            unsigned iu = 0u; if (lane == 0) iu = __hip_atomic_fetch_add(ctr, 1u, __ATOMIC_RELAXED, __HIP_MEMORY_SCOPE_WORKGROUP);
            const int it = lo + (int)__builtin_amdgcn_readfirstlane(iu);
            if (it >= hi) break;
            const int l = it / NL; int r = it - l * NL;
            bf16_t* WT = (bf16_t*)(P->ws + WS_WT) + (size_t)l * WT_L;
            if (r < NA) { const int f = r / 2816, t = (r / 1408) & 1, q = r % 1408, kb = q / 88, nb = q % 88;
                const float* W = (f == 0 ? (t == 0 ? P->w1g : P->w1u) : (t == 0 ? P->w2g : P->w2u)) + (size_t)l * 1024 * DFF;
                tr_load(scr, W, DFF, kb * 64, nb * 32, lane);
                const int j = nb * 32 + nl;
                tr_write(scr, WT + WT_GU + (size_t)f * 5632 * 1024, 1024, kb * 64, perm_gu(j, t), perm_gu(j + 8, t), perm_gu(j + 16, t), perm_gu(j + 24, t), lane);
                continue; }
            r -= NA;
            if (r < NBd) { const int f = r / 1408, q = r % 1408, kb = q / 32, nb = q % 32;
                const float* W = (f == 0 ? P->w1d : P->w2d) + (size_t)l * DFF * 1024;
                tr_load(scr, W, 1024, kb * 64, nb * 32, lane);
                const int j = nb * 32 + nl;
                { bf16_t* Bd = WT + WT_DN + (size_t)f * 1024 * MIDP + (size_t)(j >> 8) * 256 * DFF + (size_t)kb * (256 * 64);
                  tr_write(scr, Bd, 64, 0, j & 255, (j + 8) & 255, (j + 16) & 255, (j + 24) & 255, lane); }
                continue; }
            r -= NBd;
            if (r < NC) { const int kb = r / 40, nb = r % 40;
                tr_load(scr, P->w_in + (size_t)l * 1024 * DIN, DIN, kb * 64, nb * 32, lane);
                const int u = nb >> 1, d = (nb & 1) * 32 + nl;
                tr_write(scr, WT + WT_IN, 1024, kb * 64, perm_in(u, d), perm_in(u, d + 8), perm_in(u, d + 16), perm_in(u, d + 24), lane);
                continue; }
            r -= NC;
            { const int kb = r / 32, nb = r % 32;
                tr_load(scr, P->w_out + (size_t)l * 1024 * 1024, 1024, kb * 64, nb * 32, lane);
                const int j = nb * 32 + nl;
                tr_write(scr, WT + WT_OUT, 1024, kb * 64, j, j + 8, j + 16, j + 24, lane); }
        }
    }
}
__device__ __forceinline__ void norm_phase(KP P, const float* g, const float* MODl, int shc, int scc, bool from_input, int npart) {
    int tid_ = threadIdx.x, bid_ = blockIdx.x; asm volatile("" : "+v"(tid_)); asm volatile("" : "+s"(bid_));
    const int lane = tid_ & 63, gw = bid_ * 8 + (tid_ >> 6), NGW = gridDim.x * 8;
    float* H = (float*)(P->ws + WS_H); bf16_t* XN = (bf16_t*)(P->ws + WS_XN);
    constexpr int RU = 3;
    for (int row0 = gw; row0 < M; row0 += RU * NGW) {
        float4 v[RU][4]; float ss[RU];
#pragma unroll
        for (int u = 0; u < RU; ++u) { const int row = row0 + u * NGW; ss[u] = 0.f;
            if (row < M) { const int b = row / RPB, t = row - b * RPB;
                const float4* h = from_input ? (t < SEQ ? (const float4*)(P->x + ((size_t)b * SEQ + t) * DM) : (const float4*)(P->ctx + ((size_t)b * CTXL + (t - SEQ)) * DM)) : (const float4*)(H + (size_t)row * DM);
#pragma unroll
                for (int j = 0; j < 4; ++j) { if (from_input) { const f32x4 t4 = __builtin_nontemporal_load((const f32x4*)h + lane + 64 * j); v[u][j] = make_float4(t4[0], t4[1], t4[2], t4[3]); }
                    else v[u][j] = h[lane + 64 * j]; } } }
#pragma unroll
        for (int u = 0; u < RU; ++u) { const int row = row0 + u * NGW;
            if (row < M) { const int b = row / RPB, t = row - b * RPB, w = t >= SEQ ? 2 : b;
                if (t >= SEQ && npart > 0) {
                    const float4* pp = (const float4*)(P->ws + WS_PART) + (size_t)(b * CTXL + (t - SEQ)) * 256 + lane;
                    for (int q = 0; q < npart; ++q) {
#pragma unroll
                        for (int j = 0; j < 4; ++j) { const float4 a = pp[(size_t)q * 512 * 256 + 64 * j]; v[u][j].x += a.x; v[u][j].y += a.y; v[u][j].z += a.z; v[u][j].w += a.w; } } }
#pragma unroll
                for (int j = 0; j < 4; ++j) ss[u] += v[u][j].x * v[u][j].x + v[u][j].y * v[u][j].y + v[u][j].z * v[u][j].z + v[u][j].w * v[u][j].w;
                if (from_input || (t >= SEQ && npart > 0)) {
#pragma unroll
                    for (int j = 0; j < 4; ++j) ((float4*)(H + (size_t)row * DM))[lane + 64 * j] = v[u][j]; }
                const float r = rsqrtf(wave_sum(ss[u]) * (1.f / DM) + 1e-6f);
                const float* sh = MODl + w * NMOD + shc * 1024; const float* sc = MODl + w * NMOD + scc * 1024;
#pragma unroll
                for (int j = 0; j < 4; ++j) { const int c = (lane + 64 * j) * 4; const float4 gg = *(const float4*)(g + c), s4 = *(const float4*)(sh + c), c4 = *(const float4*)(sc + c);
                    uint2 o; o.x = pk2(v[u][j].x * r * gg.x * (1.f + c4.x) + s4.x, v[u][j].y * r * gg.y * (1.f + c4.y) + s4.y);
                    o.y = pk2(v[u][j].z * r * gg.z * (1.f + c4.z) + s4.z, v[u][j].w * r * gg.w * (1.f + c4.w) + s4.w);
                    *(uint2*)(XN + (size_t)row * DM + c) = o; } } }
    }
}
__device__ __forceinline__ void final_phase(KP P) {
    int tid_ = threadIdx.x, bid_ = blockIdx.x; asm volatile("" : "+v"(tid_)); asm volatile("" : "+s"(bid_));
    const int lane = tid_ & 63, gw = bid_ * 8 + (tid_ >> 6), NGW = gridDim.x * 8;
    const float* H = (const float*)(P->ws + WS_H);
    for (int orow = gw; orow < NB * SEQ; orow += NGW) {
        const int b = orow / SEQ, t = orow - b * SEQ;
        const float4* h = (const float4*)(H + (size_t)(b * RPB + t) * DM);
        float4 v[4]; float ss = 0.f;
#pragma unroll
        for (int j = 0; j < 4; ++j) { v[j] = h[lane + 64 * j]; ss += v[j].x * v[j].x + v[j].y * v[j].y + v[j].z * v[j].z + v[j].w * v[j].w; }
        const float r = rsqrtf(wave_sum(ss) * (1.f / DM) + 1e-6f);
#pragma unroll
        for (int j = 0; j < 4; ++j) { const int c = (lane + 64 * j) * 4; const float4 gg = *(const float4*)(P->g_final + c);
            float4 o; o.x = v[j].x * r * gg.x; o.y = v[j].y * r * gg.y; o.z = v[j].z * r * gg.z; o.w = v[j].w * r * gg.w;
            __builtin_nontemporal_store((f32x4){o.x, o.y, o.z, o.w}, (f32x4*)(P->out + (size_t)orow * DM + c)); }
    }
}
template <class Epi> __device__ __forceinline__ void run_gemm(LAS unsigned char* lds, const bf16_t* A, const bf16_t* Bt, int N, int K, int lda, int blocked, int no_ctx, Epi E) {
    const int npass = (N == 1024 && !no_ctx) ? 2 : 1;
    for (int pass = 0; pass < npass; ++pass) {
        pg8::Gemm g{A, Bt, M, N, pass ? 256 : K, lda, blocked}; pg8::SplitOrder S; S.init((N == 1024 || no_ctx) ? 1 + pass : 0, M, N, (int)gridDim.x, (int)blockIdx.x, K / 256, 256);
        pg8::gemm_phase<Epi, pg8::SplitOrder, true, true>(lds, g, S, E);
    }
}

typedef float f32x16 __attribute__((ext_vector_type(16)));
typedef short bf16x8_t __attribute__((ext_vector_type(8)));
typedef short s16x4_t __attribute__((ext_vector_type(4)));
typedef unsigned u32x4_t __attribute__((ext_vector_type(4)));
typedef unsigned u32x2_t __attribute__((ext_vector_type(2)));
constexpr int AT_KBUF = 0, AT_VBUF = 32768, AT_VSTRIDE = 264, AT_VBYTES = 64 * AT_VSTRIDE, AT_COMB = AT_VBUF + 3 * AT_VBYTES, AT_COMB_PAIR = 34 * 64 * 4;
static_assert(AT_COMB + 4 * AT_COMB_PAIR <= 131072, "attention LDS map");
typedef float at_f32x2 __attribute__((ext_vector_type(2))); typedef __bf16 at_bf16x2 __attribute__((ext_vector_type(2)));
__device__ __forceinline__ unsigned cvtpk(float lo, float hi) { const at_f32x2 v = {lo, hi}; const at_bf16x2 b = __builtin_convertvector(v, at_bf16x2); return __builtin_bit_cast(unsigned, b); }

__device__ __forceinline__ void attn_unit(KP P, LAS unsigned char* lds, int l, int tid, int b, int hh, int q0, bool lat) {
    unsigned char* ws = P->ws;
    const int lane = tid & 63, r32 = lane & 31, hi = lane >> 5, wid = __builtin_amdgcn_readfirstlane(tid >> 6), g = wid >> 2, wq = wid & 3;
    const bool isB = hh >= 6; const int h = isB ? hh - 6 : hh, kvh = h / 3;
    const bf16_t* Q = (const bf16_t*)(ws + (isB ? WS_QB : WS_QA)) + ((size_t)b * RPB + q0 + 32 * wq + r32) * 384 + h * 64;
    const bf16_t* Kg = (const bf16_t*)(ws + (isB ? WS_KB : WS_KA)) + (size_t)b * RPB * 128 + kvh * 64;
    const bf16_t* Vg = (const bf16_t*)(ws + (isB ? WS_VTB : WS_VTA)) + ((size_t)(b * 2 + kvh) * 64) * RPB;
    int npre, kb_lo, nsteps;
    if (!lat) { npre = 2; kb_lo = 0; nsteps = 2; }
    else if (isB) { npre = 0; kb_lo = 0; nsteps = 66; }
    else { const int qb = q0 >> 7; kb_lo = qb > 0 ? qb - 1 : 0; const int kb_hi = qb < 63 ? qb + 1 : 63; npre = 2; nsteps = 2 + (kb_hi - kb_lo + 1); }
    const int kkey0 = tid >> 3, kc = tid & 7;
    const unsigned kdst0 = (unsigned)(kkey0 * 128 + ((kc ^ ((kkey0 >> 1) & 7)) * 16));
    const int vd0 = tid >> 4, vc = tid & 15;
    const unsigned vdst0 = (unsigned)(vd0 * AT_VSTRIDE + vc * 16);
    const bf16_t* kg0 = Kg + (size_t)kkey0 * 128 + kc * 8;
    const bf16_t* vg0 = Vg + (size_t)vd0 * RPB + vc * 8;
    u32x4_t pk0, pk1, pv0, pv1;
#define AT_KP0(s) ((s) < npre ? SEQ + 128 * (s) : 128 * (kb_lo + (s) - npre))
#define AT_LOADK(s) do { const int kp0_ = AT_KP0(s); pk0 = *(const u32x4_t*)(kg0 + (size_t)kp0_ * 128); pk1 = *(const u32x4_t*)(kg0 + (size_t)(kp0_ + 64) * 128); } while (0)
#define AT_LOADV(s) do { const int kp0_ = AT_KP0(s); pv0 = *(const u32x4_t*)(vg0 + kp0_); pv1 = *(const u32x4_t*)(vg0 + (size_t)32 * RPB + kp0_); } while (0)
#define AT_STOREK(buf) do { LAS unsigned char* kb_ = lds + AT_KBUF + (buf) * 16384; *(LAS u32x4_t*)(kb_ + kdst0) = pk0; *(LAS u32x4_t*)(kb_ + kdst0 + 8192) = pk1; } while (0)
#define AT_STOREV(buf) do { LAS unsigned char* vb_ = lds + AT_VBUF + (buf) * AT_VBYTES; \
        *(LAS u32x2_t*)(vb_ + vdst0) = (u32x2_t){pv0.x, pv0.y}; *(LAS u32x2_t*)(vb_ + vdst0 + 8) = (u32x2_t){pv0.z, pv0.w}; \
        *(LAS u32x2_t*)(vb_ + vdst0 + 32 * AT_VSTRIDE) = (u32x2_t){pv1.x, pv1.y}; *(LAS u32x2_t*)(vb_ + vdst0 + 32 * AT_VSTRIDE + 8) = (u32x2_t){pv1.z, pv1.w}; } while (0)
#define AT_QK_LD(buf) do { const LAS unsigned char* kb_ = lds + AT_KBUF + (buf) * 16384; \
        _Pragma("unroll") for (int d0 = 0; d0 < 4; ++d0) { kf[2 * d0] = *(const LAS bf16x8_t*)(kb_ + koff[d0]); kf[2 * d0 + 1] = *(const LAS bf16x8_t*)(kb_ + koff[d0] + 4096); } } while (0)
#define AT_QK_MMA(S0_, S1_) do { S0_ = __builtin_amdgcn_mfma_f32_32x32x16_bf16(kf[0], qf[0], negm, 0, 0, 0); S1_ = __builtin_amdgcn_mfma_f32_32x32x16_bf16(kf[1], qf[0], negm, 0, 0, 0); \
        _Pragma("unroll") for (int d0 = 1; d0 < 4; ++d0) { \
            S0_ = __builtin_amdgcn_mfma_f32_32x32x16_bf16(kf[2 * d0], qf[d0], S0_, 0, 0, 0); S1_ = __builtin_amdgcn_mfma_f32_32x32x16_bf16(kf[2 * d0 + 1], qf[d0], S1_, 0, 0, 0); } } while (0)
#define AT_QK(S0_, S1_, buf) do { AT_QK_LD(buf); __builtin_amdgcn_sched_barrier(0); AT_QK_MMA(S0_, S1_); } while (0)
    AT_LOADK(0); AT_LOADV(0);
    u32x4_t pk2, pk3;
    { const int kp1_ = AT_KP0(1); pk2 = *(const u32x4_t*)(kg0 + (size_t)kp1_ * 128); pk3 = *(const u32x4_t*)(kg0 + (size_t)(kp1_ + 64) * 128); }
    bf16x8_t qf[4], kf[8], vfr[8];
#pragma unroll
    for (int d0 = 0; d0 < 4; ++d0) qf[d0] = *(const bf16x8_t*)(Q + 16 * d0 + 8 * hi);
    const int key0 = 64 * g + r32; const int swz = (key0 >> 1) & 7;
    unsigned koff[4];
#pragma unroll
    for (int d0 = 0; d0 < 4; ++d0) koff[d0] = (unsigned)(key0 * 128 + (((2 * d0 + hi) ^ swz) * 16));
    const unsigned voff = (unsigned)(r32 * AT_VSTRIDE + 128 * g + 8 * hi);
    f32x16 O0 = {}, O1 = {};
    float m = 0.f, lsum = 0.f, pend = 0.f;
    f32x16 negm = {};
    constexpr float AT_THR = 8.f;
    const int qp = q0 + 32 * wq + r32;
    AT_STOREK(0); AT_STOREV(0);
    { LAS unsigned char* kb_ = lds + AT_KBUF + 16384; *(LAS u32x4_t*)(kb_ + kdst0) = pk2; *(LAS u32x4_t*)(kb_ + kdst0 + 8192) = pk3; }
    __syncthreads();
    f32x16 S0, S1;
    AT_QK(S0, S1, 0);
    __syncthreads();
#define AT_PV_LD(vs) do { const LAS unsigned char* vb_ = lds + AT_VBUF + (vs) * AT_VBYTES; \
        _Pragma("unroll") for (int sl = 0; sl < 4; ++sl) _Pragma("unroll") for (int dd = 0; dd < 2; ++dd) { \
            const u32x2_t lo = *(const LAS u32x2_t*)(vb_ + voff + dd * 32 * AT_VSTRIDE + 32 * sl), hi8 = *(const LAS u32x2_t*)(vb_ + voff + dd * 32 * AT_VSTRIDE + 32 * sl + 16); \
            const u32x4_t vw = {lo.x, lo.y, hi8.x, hi8.y}; vfr[2 * sl + dd] = __builtin_bit_cast(bf16x8_t, vw); } } while (0)
#define AT_PV_MMA() do { _Pragma("unroll") for (int sl = 0; sl < 4; ++sl) { const bf16x8_t pf = __builtin_bit_cast(bf16x8_t, pp[sl]); \
            O0 = __builtin_amdgcn_mfma_f32_32x32x16_bf16(vfr[2 * sl], pf, O0, 0, 0, 0); O1 = __builtin_amdgcn_mfma_f32_32x32x16_bf16(vfr[2 * sl + 1], pf, O1, 0, 0, 0); } } while (0)
#define AT_PV(vs) do { AT_PV_LD(vs); __builtin_amdgcn_sched_barrier(0); AT_PV_MMA(); } while (0)
    u32x4_t pp[4] = {};
    int vs_prev = 0, vs_cur = 0, vs_next = 1;
    for (int s = 0; s < nsteps; ++s) {
        if (s + 2 < nsteps) AT_LOADK(s + 2);
        if (s + 1 < nsteps) AT_LOADV(s + 1);
        f32x16 N0, N1;
        if (lat && !isB && s >= npre) {
            const int kpb = AT_KP0(s) + 64 * g + 4 * hi - qp;
#pragma unroll
            for (int r = 0; r < 16; ++r) { const int dlt = kpb + (r & 3) + 8 * (r >> 2);
                if (dlt > 128 || dlt < -128) S0[r] = -1e30f;
                if (dlt + 32 > 128 || dlt + 32 < -128) S1[r] = -1e30f; }
        }
        if (__any(pend != 0.f)) { S0 = S0 - pend; S1 = S1 - pend; }
        AT_QK_LD((s + 1) & 1);
        __builtin_amdgcn_sched_barrier(0);
        __builtin_amdgcn_s_setprio(1); AT_QK_MMA(N0, N1); __builtin_amdgcn_s_setprio(0);
        AT_PV_LD(vs_prev);
        __builtin_amdgcn_sched_barrier(0);
        __builtin_amdgcn_s_setprio(1); AT_PV_MMA(); __builtin_amdgcn_s_setprio(0);
        __builtin_amdgcn_sched_barrier(0);
        float rm = __builtin_fmaxf(__builtin_fmaxf(S0[0], S1[0]), S0[1]);
#pragma unroll
        for (int r = 1; r < 16; ++r) rm = __builtin_fmaxf(__builtin_fmaxf(rm, S1[r]), r < 15 ? S0[r + 1] : S1[r]);
        { const auto rr = __builtin_amdgcn_permlane32_swap(__float_as_uint(rm), __float_as_uint(rm), false, false); rm = fmaxf(__uint_as_float(rr[0]), __uint_as_float(rr[1])); }
        float alpha = 1.f; pend = 0.f;
        if (s == 0 || __any(rm > AT_THR)) {
            const float dl = s == 0 ? rm : fmaxf(rm, 0.f);
            S0 = S0 - dl; S1 = S1 - dl; negm = negm - dl; m += dl; pend = dl;
            alpha = __builtin_amdgcn_exp2f(-dl); lsum *= alpha;
        }
        float ps = 0.f;
#pragma unroll
        for (int r = 0; r < 16; ++r) { S0[r] = __builtin_amdgcn_exp2f(S0[r]); S1[r] = __builtin_amdgcn_exp2f(S1[r]); ps += S0[r] + S1[r]; }
        lsum += ps;
#pragma unroll
        for (int sl = 0; sl < 4; ++sl) { const int rb = 8 * (sl & 1);
            if (sl < 2) pp[sl] = (u32x4_t){cvtpk(S0[rb], S0[rb + 1]), cvtpk(S0[rb + 2], S0[rb + 3]), cvtpk(S0[rb + 4], S0[rb + 5]), cvtpk(S0[rb + 6], S0[rb + 7])};
            else pp[sl] = (u32x4_t){cvtpk(S1[rb], S1[rb + 1]), cvtpk(S1[rb + 2], S1[rb + 3]), cvtpk(S1[rb + 4], S1[rb + 5]), cvtpk(S1[rb + 6], S1[rb + 7])}; }
        __builtin_amdgcn_sched_barrier(0);
        if (__any(alpha != 1.f)) {
#pragma unroll
            for (int r = 0; r < 16; ++r) { O0[r] *= alpha; O1[r] *= alpha; } }
        if (s + 2 < nsteps) AT_STOREK(s & 1);
        if (s + 1 < nsteps) AT_STOREV(vs_next);
        __syncthreads();
        S0 = N0; S1 = N1;
        vs_prev = vs_cur; vs_cur = vs_next; vs_next = vs_next == 2 ? 0 : vs_next + 1;
    }
    AT_PV(vs_prev);
#undef AT_PV
#undef AT_PV_LD
#undef AT_PV_MMA
#undef AT_QK_LD
#undef AT_QK_MMA
#undef AT_LOADK
#undef AT_LOADV
#undef AT_STOREK
#undef AT_STOREV
#undef AT_QK
    float ltot = lsum + __shfl_xor(lsum, 32);
    LAS float* comb = (LAS float*)(lds + AT_COMB + wq * AT_COMB_PAIR);
    if (g == 1) {
        comb[lane] = m; comb[64 + lane] = ltot;
#pragma unroll
        for (int r = 0; r < 16; ++r) { comb[(2 + r) * 64 + lane] = O0[r]; comb[(18 + r) * 64 + lane] = O1[r]; }
    }
    __syncthreads();
    if (g == 0) {
        const float m1 = comb[lane], l1 = comb[64 + lane];
        float mf = fmaxf(m, m1); float sk = 0.f;
        if (!isB) { const float s2 = P->sink[l * 6 + h] * LOG2E; mf = fmaxf(mf, s2); sk = __builtin_amdgcn_exp2f(s2 - mf); }
        const float a0 = __builtin_amdgcn_exp2f(m - mf), a1 = __builtin_amdgcn_exp2f(m1 - mf);
        const float inv = 1.f / (ltot * a0 + l1 * a1 + sk);
        const float c0 = a0 * inv, c1 = a1 * inv;
        bf16_t* dst = (bf16_t*)(ws + WS_XN) + ((size_t)b * RPB + q0 + 32 * wq + r32) * DM + (isB ? 384 : 0) + h * 64 + 4 * hi;
#pragma unroll
        for (int rq = 0; rq < 4; ++rq) {
            float o[8];
#pragma unroll
            for (int i = 0; i < 4; ++i) { o[i] = O0[4 * rq + i] * c0 + comb[(2 + 4 * rq + i) * 64 + lane] * c1; o[4 + i] = O1[4 * rq + i] * c0 + comb[(18 + 4 * rq + i) * 64 + lane] * c1; }
            *(u32x2_t*)(dst + 8 * rq) = (u32x2_t){cvtpk(o[0], o[1]), cvtpk(o[2], o[3])};
            *(u32x2_t*)(dst + 32 + 8 * rq) = (u32x2_t){cvtpk(o[4], o[5]), cvtpk(o[6], o[7])};
        }
    }
    __syncthreads();
#undef AT_KP0
}
__device__ __forceinline__ void attn_phase(KP P, LAS unsigned char* lds, int l) {
    int tid_ = threadIdx.x, bid_ = blockIdx.x; asm volatile("" : "+v"(tid_)); asm volatile("" : "+s"(bid_));
    const int G = gridDim.x;
    const bool xcd = (G == 256);
    const int NU = 1536 + (l == 0 ? 48 : 0);
    for (int it = 0;; ++it) {
        int idx;
        if (xcd) { if (it >= 7) break; idx = it < 6 ? (it / 3) * 768 + (bid_ & 7) * 96 + (it % 3) * 32 + (bid_ >> 3) : 1536 + bid_; if (idx >= NU) break; }
        else { idx = bid_ + it * G; if (idx >= NU) break; }
        int b, hh, q0; bool lat = true;
        if (idx < 768) { b = idx / 384; hh = 6 + (idx % 384) / 64; q0 = (idx & 63) * 128; }
        else if (idx < 1536) { const int u = idx - 768; b = u / 384; hh = (u % 384) / 64; q0 = (u & 63) * 128; }
        else { const int u = idx - 1536; b = u / 24; hh = (u % 24) >> 1; q0 = SEQ + 128 * (u & 1); lat = false; }
        attn_unit(P, lds, l, tid_, b, hh, q0, lat);
    }
}

__device__ __forceinline__ void fft1_phase(KP P, int l) {
    int tid_ = threadIdx.x, bid_ = blockIdx.x; asm volatile("" : "+v"(tid_)); asm volatile("" : "+s"(bid_));
    unsigned char* ws = P->ws;
    const int lane = tid_ & 63, r32 = lane & 31, hi = lane >> 5, w = tid_ >> 6;
    const bf16_t* D1 = (const bf16_t*)(ws + WS_TAB + TAB_D1_BYTES); const float* TAB = (const float*)(ws + WS_TAB);
    for (int it = bid_; it < 256; it += gridDim.x) {
        const int b = it >> 7, l2 = it & 127, ch = 32 * w + r32;
        const unsigned* vsrc = (const unsigned*)(ws + WS_VS) + ((size_t)(b * SEQ + l2 + 512 * hi)) * 256 + ch;
        u32x4_t bfr[8];
#pragma unroll
        for (int s = 0; s < 8; ++s)
#pragma unroll
            for (int j = 0; j < 4; ++j) bfr[s][j] = vsrc[(size_t)(128 * (8 * s + j)) * 256];
        f32x16 acc[4] = {};
#pragma unroll
        for (int s = 0; s < 8; ++s) {
            const bf16x8_t bf = __builtin_bit_cast(bf16x8_t, bfr[s]);
#pragma unroll
            for (int mt = 0; mt < 4; ++mt) { const bf16x8_t af = *(const bf16x8_t*)(D1 + (32 * mt + r32) * 128 + 16 * s + 8 * hi);
                acc[mt] = __builtin_amdgcn_mfma_f32_32x32x16_bf16(af, bf, acc[mt], 0, 0, 0); }
        }
        unsigned* zs = (unsigned*)(ws + WS_ZS);
#pragma unroll
        for (int mt = 0; mt < 4; ++mt)
#pragma unroll
            for (int rq = 0; rq < 4; ++rq)
#pragma unroll
                for (int e = 0; e < 2; ++e) {
                    const int k1 = 16 * mt + 4 * rq + 2 * hi + e; const int idx = k1 * l2;
                    const float ct = TAB[TAB_COS + idx], st = TAB[TAB_COS + ((idx - 2048) & 8191)];
                    const float yr = acc[mt][4 * rq + 2 * e], yi = acc[mt][4 * rq + 2 * e + 1];
                    zs[((size_t)(b * 64 + k1) * 128 + l2) * 256 + ch] = cvtpk(yr * ct + yi * st, yi * ct - yr * st);
                }
    }
    if (l == 0) {
        const unsigned* VC = (const unsigned*)(ws + WS_VC); bf16_t* OM = (bf16_t*)(ws + WS_XN);
        for (int gt = bid_ * 512 + tid_; gt < NB * CTXL * 256; gt += gridDim.x * 512) {
            const int ch = gt & 255, k = (gt >> 8) & 255, b = gt >> 16;
            const unsigned* vp = VC + (size_t)(b * 256) * 256 + ch; float a = 0.f;
#pragma unroll 8
            for (int j = 0; j < 256; ++j) { const unsigned pk = vp[(size_t)j * 256]; const float vr = __uint_as_float(pk << 16), vi = __uint_as_float(pk & 0xffff0000u);
                const int ix = ((k * j) & 255) * 32; a += vr * TAB[TAB_COS + ix] + vi * TAB[TAB_COS + ((ix - 2048) & 8191)]; }
            OM[(size_t)(b * RPB + SEQ + k) * DM + 768 + ch] = f2bf(a * (1.f / 128.f));
        }
    }
}
__device__ __forceinline__ void fft3_phase(KP P, LAS unsigned char* lds, int l) {
    int tid_ = threadIdx.x, bid_ = blockIdx.x; asm volatile("" : "+v"(tid_)); asm volatile("" : "+s"(bid_));
    unsigned char* ws = P->ws;
    const int lane = tid_ & 63, r32 = lane & 31, hi = lane >> 5, w = tid_ >> 6;
    const bf16_t* D3 = (const bf16_t*)(ws + WS_TAB + TAB_D3_BYTES); bf16_t* OM = (bf16_t*)(ws + WS_XN);
    for (int it = bid_; it < 256; it += gridDim.x) {
        const int b = it >> 7, k1 = (it & 127) >> 1, chh = it & 1, ch = 32 * (4 * chh + (w & 3)) + r32, mh = w >> 2;
        const unsigned* zsrc = (const unsigned*)(ws + WS_ZS) + ((size_t)(b * 64 + k1) * 128 + 4 * hi) * 256 + ch;
        f32x16 acc[2] = {};
#pragma unroll
        for (int sh = 0; sh < 2; ++sh) {
            u32x4_t bfr[8];
#pragma unroll
            for (int s = 0; s < 8; ++s)
#pragma unroll
                for (int j = 0; j < 4; ++j) bfr[s][j] = zsrc[(size_t)(8 * (8 * sh + s) + j) * 256];
#pragma unroll
            for (int s = 0; s < 8; ++s) {
                const bf16x8_t bf = __builtin_bit_cast(bf16x8_t, bfr[s]);
#pragma unroll
                for (int mi = 0; mi < 2; ++mi) { const bf16x8_t af = *(const bf16x8_t*)(D3 + (32 * (2 * mh + mi) + r32) * 256 + 16 * (8 * sh + s) + 8 * hi);
                    acc[mi] = __builtin_amdgcn_mfma_f32_32x32x16_bf16(af, bf, acc[mi], 0, 0, 0); }
            }
        }
#pragma unroll
        for (int mi = 0; mi < 2; ++mi)
#pragma unroll
            for (int r = 0; r < 16; ++r) { const int k2 = 32 * (2 * mh + mi) + (r & 3) + 8 * (r >> 2) + 4 * hi;
                OM[((size_t)b * RPB + k1 + 64 * k2) * DM + 768 + ch] = f2bf(acc[mi][r] * 0.0013810679320049757f); }
    }
}

#define GAS __attribute__((address_space(1)))
#define XB_TMO      128
#define XB_XCNT(j)  (256  + 64 * (j))
#define XB_XSUB(j)  (1280 + 64 * (j))
#define XB_XGEN(j)  (2304 + 64 * (j))
#define XB_TOP      3328
#define XB_TOPGEN   3392
#define XCD_BAR_WORDS 3456
#define XB_SPIN_CAP (1u << 18)

__device__ __forceinline__ unsigned xb_ld(unsigned* p)              { return __hip_atomic_load(p, __ATOMIC_RELAXED, __HIP_MEMORY_SCOPE_AGENT); }
__device__ __forceinline__ unsigned xb_add(unsigned* p, unsigned v) { return __hip_atomic_fetch_add(p, v, __ATOMIC_RELAXED, __HIP_MEMORY_SCOPE_AGENT); }
__device__ __forceinline__ unsigned xb_xcc_id() { return (unsigned)__builtin_amdgcn_s_getreg((3 << 11) | 20) & 0xFu; }
#define XB_SPIN(cond, bar) do { unsigned _sp = 0; while (cond) { __builtin_amdgcn_s_sleep(1); \
    if ((++_sp & 255u) == 0u) { if (xb_ld(&(bar)[XB_TMO])) break; if (_sp > XB_SPIN_CAP) { atomicAdd(&(bar)[XB_TMO], 1u); break; } } } } while (0)

struct XcdBarrier {
    unsigned* bar; unsigned x;
    volatile LAS unsigned* st;
};

__device__ __forceinline__ XcdBarrier xcd_barrier_post(unsigned* bar, volatile LAS unsigned* st) {
    XcdBarrier b; b.bar = bar; b.x = xb_xcc_id(); b.st = st;
    if (threadIdx.x == 0) (void)xb_add(&bar[XB_XCNT(b.x)], 1u);
    return b;
}
__device__ __forceinline__ void xcd_barrier_complete(unsigned* bar, unsigned x, unsigned& nloc, unsigned& nx) {
    const unsigned G = gridDim.x * gridDim.y * gridDim.z;
    unsigned sum, cnt, mine, sp = 0u;
    for (;;) {
        sum = 0u; cnt = 0u; mine = 0u;
#pragma unroll
        for (unsigned j = 0; j < 16; ++j) { const unsigned c = xb_ld(&bar[XB_XCNT(j)]); sum += c; cnt += (c > 0u) ? 1u : 0u; mine = (j == x) ? c : mine; }
        if (sum == G) break;
        __builtin_amdgcn_s_sleep(1);
        if ((++sp & 255u) == 0u) { if (xb_ld(&bar[XB_TMO])) break; if (sp > XB_SPIN_CAP) { atomicAdd(&bar[XB_TMO], 1u); break; } }
    }
    nloc = mine > 0u ? mine : 1u; nx = cnt > 0u ? cnt : 1u;
}

__device__ __forceinline__ void xcd_barrier(const XcdBarrier& b) {
    asm volatile("s_waitcnt vmcnt(0)" ::: "memory");
    __syncthreads();
    if (threadIdx.x == 0) {
        unsigned* bar = b.bar;
        __builtin_amdgcn_s_waitcnt(0);
        unsigned nloc = b.st[0], nx = b.st[1];
        if (nloc == 0u) { xcd_barrier_complete(bar, b.x, nloc, nx); b.st[0] = nloc; b.st[1] = nx; }
        const unsigned old = xb_add(&bar[XB_XSUB(b.x)], 1u);
        const unsigned gen = old / nloc;
        if (old + 1u == (gen + 1u) * nloc) {
            __builtin_amdgcn_fence(__ATOMIC_RELEASE, "agent");
            asm volatile("s_waitcnt vmcnt(0)" ::: "memory");
            const unsigned og = xb_add(&bar[XB_TOP], 1u);
            const unsigned tg = og / nx;
            if (og + 1u == (tg + 1u) * nx) xb_add(&bar[XB_TOPGEN], 1u);
            else XB_SPIN(xb_ld(&bar[XB_TOPGEN]) == tg, bar);
            __builtin_amdgcn_fence(__ATOMIC_ACQUIRE, "agent");
            xb_add(&bar[XB_XGEN(b.x)], 1u);
            asm volatile("s_waitcnt vmcnt(0)" ::: "memory");
        } else {
            XB_SPIN(xb_ld(&bar[XB_XGEN(b.x)]) == gen, bar);
            __builtin_amdgcn_fence(__ATOMIC_ACQUIRE, "agent");
            asm volatile("s_waitcnt vmcnt(0)" ::: "memory");
        }
    }
    __syncthreads();
}

constexpr int LDS_BYTES = 132096;
constexpr int PH_FINAL = 25, PH_END = 26;
constexpr size_t WS_BAR = WS_MOD + 262144;
constexpr int MISC_OFF = 131072;
__global__ void __launch_bounds__(512, 2) mega(Params Pk, int ph_lo, int ph_hi) {
#if defined(__HIP_DEVICE_COMPILE__)
    extern __shared__ __attribute__((aligned(16))) unsigned char lds_raw[];
    LAS unsigned char* lds = (LAS unsigned char*)lds_raw;
    volatile LAS unsigned* MISC = (volatile LAS unsigned*)(lds + MISC_OFF);
    if (threadIdx.x < 32) MISC[threadIdx.x] = 0u;
    __syncthreads();
    XcdBarrier bar; bar.bar = nullptr; bar.x = 0; bar.st = nullptr;
    for (int ph = ph_lo; ph < ph_hi; ++ph) {
        KP P = (KP)__builtin_amdgcn_kernarg_segment_ptr(); asm volatile("" : "+s"(P));
        if (ph == 0 && blockIdx.x == 0) { unsigned* bw = (unsigned*)(P->ws + WS_BAR); for (int i = threadIdx.x; i < XCD_BAR_WORDS; i += 512) bw[i] = 0u; }
        unsigned char* ws = P->ws;
        float* H = (float*)(ws + WS_H); bf16_t* XN = (bf16_t*)(ws + WS_XN); bf16_t* MID = (bf16_t*)(ws + WS_MID);
        if (ph == 0) prologue_phase(P, lds);
        else if (ph == PH_FINAL) final_phase(P);
        else {
            const int l = (ph - 1) / 12, s = (ph - 1) % 12;
            const float* MODl = (const float*)(ws + WS_MOD) + (size_t)l * 3 * NMOD;
            const bf16_t* WT = (const bf16_t*)(ws + WS_WT) + (size_t)l * WT_L;
            if (s == 0 || s == 3 || s == 8) {
                const float* g = (s == 0 ? P->g_ffn1 : s == 3 ? P->g_mix : P->g_ffn2) + l * 1024; const int shc = s == 0 ? 0 : s == 3 ? 3 : 6;
                norm_phase(P, g, MODl, shc, shc + 1, ph == 1, ph == 1 ? 0 : (s == 8 ? (l == 1 ? 0 : 3) : 10));
            } else if (s == 1 || s == 2 || s == 4 || s == 7 || s == 9 || s == 10) {
                const int mode = (s == 1 || s == 9) ? 0 : (s == 4 ? 2 : 1);
                pg8::EpiAll E{ws, P->g_qn + l * 64, P->g_kn + l * 64, mode, l, s == 2 ? 2 : s == 7 ? 5 : 8, s == 7 ? 1.0f : 0.5f};
                const bf16_t* A = (s == 2 || s == 10) ? MID : XN;
                const bf16_t* Bt = WT + (mode == 0 ? WT_GU + (size_t)(s == 9 ? 1 : 0) * 5632 * 1024 : mode == 2 ? WT_IN : s == 7 ? WT_OUT : WT_DN + (size_t)(s == 10 ? 1 : 0) * 1024 * MIDP);
                const int N = mode == 0 ? 5632 : mode == 2 ? NIN : 1024, K = (s == 2 || s == 10) ? DFF : 1024;
                run_gemm(lds, A, Bt, N, K, (s == 2 || s == 10) ? DFF : 1024, (s == 2 || s == 10) ? 1 : 0, (l == 1 && s >= 7) ? 1 : 0, E);
            }
            else if (s == 5) {
#if FAST_FFT
                fft1_phase(P, l);
#endif
#if FAST_ATTN
                attn_phase(P, lds, l);
#endif
            }
#if FAST_FFT
            else if (s == 6) fft3_phase(P, lds, l);
#endif
        }
        if (ph + 1 < ph_hi) {
            if (ph == 0) { cg::this_grid().sync(); bar = xcd_barrier_post((unsigned*)(P->ws + WS_BAR), MISC + 8); }
            else xcd_barrier(bar);
        }
    }
#endif
}

extern "C" void kernel_launch(void* const* d_in, const int* in_sizes, int n_in, void* d_out, int out_size, void* d_ws, size_t ws_size, hipStream_t stream) {
    static int grid = 0;
    if (grid == 0) {
        if (ws_size < WS_END || n_in < 22) { fprintf(stderr, "kernel_launch: ws too small (%zu) or n_in %d\n", ws_size, n_in); grid = -1; return; }
        if (hipFuncSetAttribute((const void*)mega, hipFuncAttributeMaxDynamicSharedMemorySize, LDS_BYTES) != hipSuccess) { fprintf(stderr, "kernel_launch: hipFuncSetAttribute failed\n"); grid = -1; return; }
        int dev = 0, cus = 0, per_cu = 0; hipGetDevice(&dev); hipDeviceGetAttribute(&cus, hipDeviceAttributeMultiprocessorCount, dev);
        if (hipOccupancyMaxActiveBlocksPerMultiprocessor(&per_cu, (const void*)mega, 512, LDS_BYTES) != hipSuccess || per_cu < 1) { fprintf(stderr, "kernel_launch: occupancy query says %d\n", per_cu); grid = -1; return; }
        grid = cus;
    }
    if (grid < 0) return;
    Params P{};
    const float** pp = (const float**)&P;
    for (int i = 0; i < 22; ++i) pp[i] = (const float*)d_in[i];
    P.out = (float*)d_out; P.ws = (unsigned char*)d_ws;
    int lo = 0, hi = PH_END;
    void* args[] = {&P, &lo, &hi};
    hipError_t e = hipLaunchCooperativeKernel((const void*)mega, dim3(grid), dim3(512), args, LDS_BYTES, stream);
    if (e != hipSuccess) fprintf(stderr, "kernel_launch: cooperative launch failed: %s (grid %d)\n", hipGetErrorString(e), grid);
}
```

```cpp
#include <hip/hip_runtime.h>
#include <hip/hip_cooperative_groups.h>
#include <stdint.h>
#include <cstdio>
namespace cg = cooperative_groups;

typedef unsigned short bf16_t;
typedef float f32x4 __attribute__((ext_vector_type(4)));
__device__ __forceinline__ float bf2f(bf16_t v) { return __uint_as_float(((unsigned)v) << 16); }
__device__ __forceinline__ bf16_t f2bf(float f) { unsigned u = __float_as_uint(f); return (bf16_t)((u + 0x7fffu + ((u >> 16) & 1u)) >> 16); }
__device__ __forceinline__ unsigned pk2(float lo, float hi) { return (unsigned)f2bf(lo) | ((unsigned)f2bf(hi) << 16); }

constexpr int MIDP = 2880;
constexpr int DM = 1024, NB = 2, SEQ = 8192, CTXL = 256, RPB = SEQ + CTXL, M = NB * RPB, DFF = 2816, DIN = 1536, NMOD = 9216, NIN = 1792;
constexpr float QSCALE = 0.125f * 1.4426950408889634f;
constexpr float LOG2E = 1.4426950408889634f;
constexpr size_t MiB = 1u << 20;
constexpr size_t WS_H = 0, WS_XN = 66 * MiB, WS_MID = 99 * MiB;
constexpr size_t WS_QA = 99 * MiB, WS_QB = 112 * MiB, WS_KA = 125 * MiB, WS_KB = 130 * MiB, WS_VTA = 135 * MiB, WS_VTB = 140 * MiB, WS_VS = 145 * MiB, WS_ZS = 161 * MiB, WS_VC = 177 * MiB;
constexpr size_t WS_MOD = 201129984, WS_TAB = WS_MOD + 294912, WS_WT = WS_MOD + 524288, WS_PART = 270 * MiB, WS_END = 290 * MiB;
constexpr int TAB_COS = 0, TAB_ROPE = 8192;
constexpr size_t TAB_D1_BYTES = 65536, TAB_D3_BYTES = 65536 + 32768;
constexpr size_t WT_GU = 0, WT_DN = 2ull * 5632 * 1024, WT_IN = WT_DN + 2ull * 1024 * MIDP, WT_OUT = WT_IN + 1792ull * 1024, WT_L = WT_OUT + 1024ull * 1024;
static_assert(WS_WT + 2 * WT_L * 2 <= WS_PART, "ws map");

__device__ __forceinline__ float silu_f(float x) { return x * __builtin_amdgcn_rcpf(1.f + __expf(-x)); }
__device__ __forceinline__ int row_w(int row) { int b = row / RPB, t = row - b * RPB; return t >= SEQ ? 2 : b; }

struct Params {
    const float *x, *c, *ctx, *cctx, *w_ada, *b_ada, *g_ffn1, *g_mix, *g_ffn2, *w_in, *g_qn, *g_kn, *sink, *w_four, *w_out, *w1g, *w1u, *w1d, *w2g, *w2u, *w2d, *g_final;
    float* out; unsigned char* ws;
};
typedef const __attribute__((address_space(4))) Params* KP;

namespace pg8 {
#define PG8_LAS __attribute__((address_space(3)))
typedef unsigned short bf16_t;
typedef short bf16x8 __attribute__((ext_vector_type(8)));
typedef float f32x4 __attribute__((ext_vector_type(4)));
typedef unsigned u32x4 __attribute__((ext_vector_type(4)));
constexpr int BM = 256, BK = 64, HALF = 128, HTB = HALF * BK * 2  , STAGE_BYTES = 8 * HTB, NXCD = 8, WGM = 8;

__host__ __device__ __forceinline__ int lds_byte(int r, int c) { const int st = (r >> 4) * 2 + (c >> 5), rr = r & 15, cc = c & 31, ob = rr * 64 + cc * 2; return st * 1024 + (ob ^ (((ob >> 9) & 1) << 5)); }
__host__ __device__ __forceinline__ void stage_rc(int b, int& R, int& C) { const int st = b / 1024, sb = b % 1024, swz = sb ^ (((sb >> 9) & 1) << 5); R = (st >> 1) * 16 + swz / 64; C = (st & 1) * 32 + (swz % 64) / 2; }
__host__ __device__ __forceinline__ int perm32(int rho) { const int n = rho >> 4, i = rho & 15; return 8 * (i >> 2) + 4 * n + (i & 3); }

struct Unit { int pm, pn, ko; };
struct Gemm { const bf16_t* A; const bf16_t* Bt; int M, N, K, ld, blocked; };

struct StaticOrder {
    int nM, nN, nwg, G, c;
    __host__ __device__ void init(int M, int N, int G_, int c_) { nM = M / BM; nN = N / BM; nwg = nM * nN; G = G_; c = c_; }
    __host__ __device__ bool next(int i, Unit& u) const {
        const long L = (long)i * G + c; if (L >= nwg) return false;
        int wgid = (int)L; { const int q = nwg / NXCD, r = nwg % NXCD, xcd = wgid % NXCD, off = wgid / NXCD; wgid = (xcd < r ? xcd * (q + 1) : r * (q + 1) + (xcd - r) * q) + off; }
        const int nig = WGM * nN, gid = wgid / nig, fm = gid * WGM, gsz = (nM - fm) < WGM ? (nM - fm) : WGM;
        u.pm = fm + ((wgid % nig) % gsz); u.pn = (wgid % nig) / gsz; return true;
    }
    __device__ __forceinline__ void a_ready(const Unit&) const {}
    __device__ __forceinline__ void done(const Unit&) const {}
};

struct SplitOrder {
    int mode, nchunk, kchunk; StaticOrder S;
    __device__ void init(int mode_, int Mrows, int N, int G, int c, int nchunk_, int kchunk_) { mode = mode_; nchunk = nchunk_; kchunk = kchunk_; S.init(mode_ == 1 ? 64 * BM : Mrows, N, G, c); }
    __device__ bool next(int i, Unit& u) const {
        if (mode == 2) { const long L = (long)i * S.G + S.c; if (L >= 8 * nchunk) return false; const int un = (int)L / nchunk, ch = (int)L - un * nchunk;
            u.pm = (un >> 2) ? 65 : 32; u.pn = un & 3; u.ko = ch * kchunk; return true; }
        if (!S.next(i, u)) return false;
        u.ko = 0; if (mode == 1) u.pm += u.pm >> 5;
        return true;
    }
    __device__ __forceinline__ void a_ready(const Unit&) const {}
    __device__ __forceinline__ void done(const Unit&) const {}
};

__device__ __forceinline__ unsigned cvt_pk_bf16(float lo, float hi) { unsigned r; asm("v_cvt_pk_bf16_f32 %0, %1, %2" : "=v"(r) : "v"(lo), "v"(hi)); return r; }
__device__ __forceinline__ int tile_w(int pm) { const int b = pm / 33, wi = pm - b * 33; return wi == 32 ? 2 : b; }
struct EpiSwiglu {
    static constexpr bool PERM = false, AFTER_DRAIN = false;
    bf16_t* O;
    __device__ __forceinline__ void operator()(const f32x4 (&acc)[2][2][4][2], const Unit& u, int wr, int wc, int fr, int fq) const {
        const int row0 = u.pm * BM + wr * 64 + fr, col = u.pn * 128 + wc * 32 + fq * 8;
#pragma unroll
        for (int ai = 0; ai < 2; ++ai)
#pragma unroll
            for (int m = 0; m < 4; ++m) {
                const f32x4 g0 = acc[ai][0][m][0], u0 = acc[ai][1][m][0], g1 = acc[ai][0][m][1], u1 = acc[ai][1][m][1];
                u32x4 w;
                w.x = cvt_pk_bf16(silu_f(g0[0]) * u0[0], silu_f(g0[1]) * u0[1]); w.y = cvt_pk_bf16(silu_f(g0[2]) * u0[2], silu_f(g0[3]) * u0[3]);
                w.z = cvt_pk_bf16(silu_f(g1[0]) * u1[0], silu_f(g1[1]) * u1[1]); w.w = cvt_pk_bf16(silu_f(g1[2]) * u1[2], silu_f(g1[3]) * u1[3]);
                *(u32x4*)(O + (size_t)u.pm * BM * DFF + (size_t)(col >> 6) * (BM * 64) + (size_t)(wr * 64 + fr + ai * HALF + m * 16) * 64 + (col & 63)) = w;
            }
    }
};
struct EpiRes {
    static constexpr bool PERM = false, AFTER_DRAIN = false;
    float* H; const float* MODl; int gate_chunk; float coef; float* PART;
    __device__ __forceinline__ void operator()(const f32x4 (&acc)[2][2][4][2], const Unit& u, int wr, int wc, int fr, int fq) const {
        const float* gate = MODl + tile_w(u.pm) * NMOD + gate_chunk * 1024;
        const bool part = u.ko != 0;
        float* base = part ? PART + ((size_t)((u.ko >> 8) - 1) * 512 + (u.pm == 32 ? 0 : 256) + wr * 64 + fr) * DM : H + (size_t)(u.pm * BM + wr * 64 + fr) * DM;
#pragma unroll
        for (int bj = 0; bj < 2; ++bj)
#pragma unroll
            for (int n = 0; n < 2; ++n) {
                const int col = u.pn * BM + bj * HALF + wc * 32 + n * 16 + fq * 4;
                const f32x4 gv = *(const f32x4*)(gate + col) * coef;
                f32x4 old[2][4];
#pragma unroll
                for (int ai = 0; ai < 2; ++ai)
#pragma unroll
                    for (int m = 0; m < 4; ++m) old[ai][m] = part ? (f32x4){0.f, 0.f, 0.f, 0.f} : *(const f32x4*)(base + (size_t)(ai * HALF + m * 16) * DM + col);
#pragma unroll
                for (int ai = 0; ai < 2; ++ai)
#pragma unroll
                    for (int m = 0; m < 4; ++m) *(f32x4*)(base + (size_t)(ai * HALF + m * 16) * DM + col) = old[ai][m] + gv * acc[ai][bj][m][n];
            }
    }
};
struct EpiWin {
    static constexpr bool PERM = false, AFTER_DRAIN = false;
    const float* gqn; const float* gkn; const float* ROPE;
    bf16_t *QA, *QB, *KA, *KB, *VTA, *VTB; unsigned *VS, *VC;
    __device__ __forceinline__ void operator()(const f32x4 (&acc)[2][2][4][2], const Unit& u, int wr, int wc, int fr, int fq) const {
        const int unit = u.pn * 4 + wc;
        const int b = u.pm / 33, wi = u.pm - b * 33; const bool lat = wi < 32; const int t0 = wi * 256;
        if (unit < 20) {
            const bool isB = unit >= 10; const int ul = isB ? unit - 10 : unit;
            const bool isq = ul < 6, isk = ul >= 6 && ul < 8;
            f32x4 gg[2][2];
            if (isB && (isq || isk)) { const float* g = isq ? gqn : gkn;
#pragma unroll
                for (int bj = 0; bj < 2; ++bj)
#pragma unroll
                    for (int n = 0; n < 2; ++n) gg[bj][n] = *(const f32x4*)(g + 32 * bj + 16 * n + 4 * fq); }
#pragma unroll
            for (int ai = 0; ai < 2; ++ai)
#pragma unroll
                for (int m = 0; m < 4; ++m) {
                    const int t = t0 + ai * HALF + wr * 64 + m * 16 + fr; const size_t row = (size_t)b * RPB + t;
                    f32x4 v[2][2];
#pragma unroll
                    for (int bj = 0; bj < 2; ++bj)
#pragma unroll
                        for (int n = 0; n < 2; ++n) v[bj][n] = acc[ai][bj][m][n];
                    if (isB && (isq || isk)) {
                        float ss = 0.f;
#pragma unroll
                        for (int bj = 0; bj < 2; ++bj)
#pragma unroll
                            for (int n = 0; n < 2; ++n) ss += (v[bj][n][0] * v[bj][n][0] + v[bj][n][1] * v[bj][n][1]) + (v[bj][n][2] * v[bj][n][2] + v[bj][n][3] * v[bj][n][3]);
                        ss += __shfl_xor(ss, 16); ss += __shfl_xor(ss, 32);
                        const float r = rsqrtf(ss * (1.f / 64.f) + 1e-6f);
#pragma unroll
                        for (int bj = 0; bj < 2; ++bj)
#pragma unroll
                            for (int n = 0; n < 2; ++n) v[bj][n] = v[bj][n] * r * gg[bj][n];
                    }
                    if (lat && (isq || isk)) {
#pragma unroll
                        for (int bj = 0; bj < 2; ++bj) {
                            const int p = bj == 0 ? (t >> 6) : 128 + (t & 63);
                            const f32x4 cs0 = *(const f32x4*)(ROPE + (p * 16 + 4 * fq) * 2), cs1 = *(const f32x4*)(ROPE + (p * 16 + 4 * fq) * 2 + 4);
                            const f32x4 cv = {cs0[0], cs0[2], cs1[0], cs1[2]}, sv = {cs0[1], cs0[3], cs1[1], cs1[3]};
                            const f32x4 a = v[bj][0], bb = v[bj][1];
                            v[bj][0] = a * cv - bb * sv; v[bj][1] = bb * cv + a * sv;
                        }
                    }
                    if (isq || isk) {
                        const float sc = isq ? QSCALE : 1.f;
                        bf16_t* dst = isq ? ((isB ? QB : QA) + row * 384 + ul * 64) : ((isB ? KB : KA) + row * 128 + (ul - 6) * 64);
#pragma unroll
                        for (int bj = 0; bj < 2; ++bj)
#pragma unroll
                            for (int n = 0; n < 2; ++n) { const f32x4 x = v[bj][n] * sc; uint2 w; w.x = cvt_pk_bf16(x[0], x[1]); w.y = cvt_pk_bf16(x[2], x[3]);
                                *(uint2*)(dst + 32 * bj + 16 * n + 4 * fq) = w; }
                    } else {
                        bf16_t* dst = (isB ? VTB : VTA) + ((size_t)(b * 2 + (ul - 8)) * 64) * RPB + t;
#pragma unroll
                        for (int bj = 0; bj < 2; ++bj)
#pragma unroll
                            for (int n = 0; n < 2; ++n)
#pragma unroll
                                for (int i = 0; i < 4; ++i) dst[(size_t)(32 * bj + 16 * n + 4 * fq + i) * RPB] = f2bf(v[bj][n][i]);
                    }
                }
        } else {
            const int chb = ((unit - 20) >> 1) * 64 + 32 * ((unit - 20) & 1);
#pragma unroll
            for (int ai = 0; ai < 2; ++ai)
#pragma unroll
                for (int m = 0; m < 4; ++m) {
                    const int t = t0 + ai * HALF + wr * 64 + m * 16 + fr;
#pragma unroll
                    for (int bj = 0; bj < 2; ++bj)
#pragma unroll
                        for (int n = 0; n < 2; ++n) {
                            const f32x4 x = acc[ai][bj][m][n]; const int ch = chb + 16 * bj + 8 * n + 2 * fq;
                            const unsigned w0 = cvt_pk_bf16(x[0], x[1]), w1 = cvt_pk_bf16(x[2], x[3]);
                            if (lat) { unsigned* d = VS + ((size_t)(b * SEQ + t) * 256 + ch); d[0] = w0; d[1] = w1; }
                            else { unsigned* d = VC + ((size_t)(b * 256 + (t - SEQ)) * 256 + ch); d[0] = w0; d[1] = w1; }
                        }
                }
        }
    }
};

struct EpiAll {
    static constexpr bool PERM = false, AFTER_DRAIN = false;
    unsigned char* ws; const float* gqn; const float* gkn; int mode, l, chunk; float coef;
    __device__ __forceinline__ void operator()(const f32x4 (&acc)[2][2][4][2], const Unit& u, int wr, int wc, int fr, int fq) const {
        if (mode == 0) { EpiSwiglu E{(bf16_t*)(ws + WS_MID)}; E(acc, u, wr, wc, fr, fq); }
        else if (mode == 1) { EpiRes E{(float*)(ws + WS_H), (const float*)(ws + WS_MOD) + (size_t)l * 3 * NMOD, chunk, coef, (float*)(ws + WS_PART)}; E(acc, u, wr, wc, fr, fq); }
        else { EpiWin E{gqn, gkn, (const float*)(ws + WS_TAB) + TAB_ROPE, (bf16_t*)(ws + WS_QA), (bf16_t*)(ws + WS_QB), (bf16_t*)(ws + WS_KA), (bf16_t*)(ws + WS_KB),
                        (bf16_t*)(ws + WS_VTA), (bf16_t*)(ws + WS_VTB), (unsigned*)(ws + WS_VS), (unsigned*)(ws + WS_VC)}; E(acc, u, wr, wc, fr, fq); }
    }
};

template <class Epi, class Sched, bool ALIGN_EPI = false, bool SP2 = false>
__device__ __forceinline__ void gemm_phase(PG8_LAS unsigned char* lds, const Gemm g, const Sched& S, const Epi& E) {
    int tid_ = threadIdx.x; asm volatile("" : "+v"(tid_)); const int tid = tid_, wid = __builtin_amdgcn_readfirstlane(tid >> 6), lane = tid & 63, wr = wid >> 2, wc = wid & 3, fr = lane & 15, fq = lane >> 4;
    const int K = g.K, nt = K / BK, LD = g.blocked ? BK : g.ld;
    unsigned voffA[2], voffB[2];
#pragma unroll
    for (int i = 0; i < 2; ++i) { int R, C; stage_rc(tid * 16 + i * 8192, R, C); const int Rb = Epi::PERM ? ((R & ~31) + perm32(R & 31)) : R;
        voffA[i] = (unsigned)(R * LD + C) * 2u; voffB[i] = (unsigned)(Rb * LD + C) * 2u; }
    const size_t kstep = g.blocked ? (size_t)(BM * BK * 2) : (size_t)(BK * 2);
    const size_t hstep = (size_t)HALF * LD * 2;
    const size_t tstep = g.blocked ? (size_t)BM * g.ld * 2 : 2 * hstep;
    const unsigned ldsw = (unsigned)wid * 1024u;
    const int aoff = lds_byte(wr * 64 + fr, fq * 8), boff = lds_byte(wc * 32 + fr, fq * 8);
#define PG8_SA(b, h) (((b) * 2 + (h)) * HTB)
#define PG8_SB(b, h) ((4 + (b) * 2 + (h)) * HTB)
#define PG8_STAGE(bufoff, gbase, voff) do { _Pragma("unroll") for (int _i = 0; _i < 2; ++_i) \
        __builtin_amdgcn_global_load_lds((const unsigned*)((const char*)(gbase) + (voff)[_i]), (PG8_LAS unsigned*)(lds + (bufoff) + ldsw + _i * 8192), 16, 0, 0); } while (0)
#define PG8_LDA(dst, b, h) do { _Pragma("unroll") for (int m = 0; m < 4; ++m) _Pragma("unroll") for (int k = 0; k < 2; ++k) dst[m][k] = *(const PG8_LAS bf16x8*)(lds + PG8_SA(b, h) + aoff + m * 2048 + k * 1024); } while (0)
#define PG8_LDB(dst, b, h) do { _Pragma("unroll") for (int n = 0; n < 2; ++n) _Pragma("unroll") for (int k = 0; k < 2; ++k) dst[n][k] = *(const PG8_LAS bf16x8*)(lds + PG8_SB(b, h) + boff + n * 2048 + k * 1024); } while (0)
#define PG8_MMA(ai, bj, At, Bt) do { __builtin_amdgcn_s_setprio(1); _Pragma("unroll") for (int m = 0; m < 4; ++m) _Pragma("unroll") for (int n = 0; n < 2; ++n) _Pragma("unroll") for (int k = 0; k < 2; ++k) \
        acc[ai][bj][m][n] = __builtin_amdgcn_mfma_f32_16x16x32_bf16(Bt[n][k], At[m][k], acc[ai][bj][m][n], 0, 0, 0); __builtin_amdgcn_s_setprio(0); } while (0)
#define PG8_WAIT_V(n) asm volatile("s_waitcnt vmcnt(" #n ")" ::: "memory")
#define PG8_WAIT_L(n) asm volatile("s_waitcnt lgkmcnt(" #n ")" ::: "memory")
#define PG8_BAR __builtin_amdgcn_s_barrier()
#define PG8_SCHED __builtin_amdgcn_sched_barrier(0)
    Unit cur, nxt; int ui = 0;
    if (!S.next(0, cur)) return;
    f32x4 acc[2][2][4][2];
#pragma unroll
    for (int a = 0; a < 2; ++a)
#pragma unroll
        for (int b = 0; b < 2; ++b)
#pragma unroll
            for (int m = 0; m < 4; ++m)
#pragma unroll
                for (int n = 0; n < 2; ++n) acc[a][b][m][n] = (f32x4){0.f, 0.f, 0.f, 0.f};
    bf16x8 At[4][2], B0[2][2], B1[2][2];
    const char* cA = (const char*)g.A + (size_t)cur.pm * tstep + (size_t)(cur.ko / BK) * kstep; const char* cB = (const char*)g.Bt + (size_t)cur.pn * tstep + (size_t)(cur.ko / BK) * kstep;
    S.a_ready(cur);
    if constexpr (SP2) {
        PG8_STAGE(PG8_SB(0, 0), cB, voffB); PG8_STAGE(PG8_SB(0, 1), cB + hstep, voffB); PG8_STAGE(PG8_SA(0, 0), cA, voffA); PG8_STAGE(PG8_SA(0, 1), cA + hstep, voffA);
        if (wr == 1) PG8_BAR;
        PG8_WAIT_V(2); PG8_BAR;
        PG8_STAGE(PG8_SB(1, 0), cB + kstep, voffB); PG8_STAGE(PG8_SA(1, 0), cA + kstep, voffA); PG8_STAGE(PG8_SB(1, 1), cB + hstep + kstep, voffB);
        PG8_WAIT_V(6); PG8_BAR;
    } else {
        PG8_STAGE(PG8_SB(0, 0), cB, voffB); PG8_STAGE(PG8_SA(0, 0), cA, voffA); PG8_STAGE(PG8_SB(0, 1), cB + hstep, voffB); PG8_STAGE(PG8_SA(0, 1), cA + hstep, voffA);
        if (wr == 1) PG8_BAR;
        PG8_WAIT_V(4); PG8_BAR;
        PG8_STAGE(PG8_SB(1, 0), cB + kstep, voffB); PG8_STAGE(PG8_SA(1, 0), cA + kstep, voffA); PG8_STAGE(PG8_SB(1, 1), cB + hstep + kstep, voffB);
        PG8_WAIT_V(6); PG8_BAR;
    }
    for (;;) {
        const bool has_next = S.next(ui + 1, nxt);
        const char* nA = has_next ? (const char*)g.A + (size_t)nxt.pm * tstep + (size_t)(nxt.ko / BK) * kstep : cA; const char* nB = has_next ? (const char*)g.Bt + (size_t)nxt.pn * tstep + (size_t)(nxt.ko / BK) * kstep : cB;
        for (int t = 0; t < nt; t += 2) {
            const bool last = (t == nt - 2);
            const char* a1 = cA + (size_t)(t + 1) * kstep;
            const char* a2 = last ? nA : cA + (size_t)(t + 2) * kstep; const char* b2 = last ? nB : cB + (size_t)(t + 2) * kstep;
            const char* a3 = a2 + kstep; const char* b3 = b2 + kstep;
            if (last && has_next) S.a_ready(nxt);
            if constexpr (SP2) {
            PG8_LDB(B0, 0, 0); PG8_LDB(B1, 0, 1); PG8_SCHED; PG8_LDA(At, 0, 0); PG8_STAGE(PG8_SA(1, 1), a1 + hstep, voffA);
            PG8_WAIT_V(8); PG8_WAIT_L(0); PG8_BAR; PG8_MMA(0, 0, At, B0); PG8_MMA(0, 1, At, B1); PG8_BAR; PG8_SCHED;
            PG8_LDA(At, 0, 1); PG8_STAGE(PG8_SB(0, 0), b2, voffB); PG8_STAGE(PG8_SB(0, 1), b2 + hstep, voffB); PG8_STAGE(PG8_SA(0, 0), a2, voffA);
            PG8_WAIT_V(8); PG8_WAIT_L(0); PG8_BAR; PG8_MMA(1, 0, At, B0); PG8_MMA(1, 1, At, B1); PG8_BAR; PG8_SCHED;
            PG8_LDB(B0, 1, 0); PG8_LDB(B1, 1, 1); PG8_SCHED; PG8_LDA(At, 1, 0); PG8_STAGE(PG8_SA(0, 1), a2 + hstep, voffA);
            PG8_WAIT_V(8); PG8_WAIT_L(0); PG8_BAR; PG8_MMA(0, 0, At, B0); PG8_MMA(0, 1, At, B1); PG8_BAR; PG8_SCHED;
            PG8_LDA(At, 1, 1); PG8_STAGE(PG8_SB(1, 0), b3, voffB); PG8_STAGE(PG8_SB(1, 1), b3 + hstep, voffB); PG8_STAGE(PG8_SA(1, 0), a3, voffA);
            PG8_WAIT_V(8); PG8_WAIT_L(0); PG8_BAR; PG8_MMA(1, 0, At, B0); PG8_MMA(1, 1, At, B1); PG8_BAR; PG8_SCHED;
            } else {
            PG8_LDB(B0, 0, 0); PG8_SCHED; PG8_LDA(At, 0, 0); PG8_STAGE(PG8_SA(1, 1), a1 + hstep, voffA);
            PG8_WAIT_L(8); PG8_BAR; PG8_WAIT_L(0); PG8_MMA(0, 0, At, B0); PG8_BAR; PG8_SCHED;
            PG8_LDB(B1, 0, 1); PG8_STAGE(PG8_SB(0, 0), b2, voffB);
            PG8_BAR; PG8_WAIT_L(0); PG8_MMA(0, 1, At, B1); PG8_BAR;
            PG8_LDA(At, 0, 1); PG8_STAGE(PG8_SA(0, 0), a2, voffA);
            PG8_BAR; PG8_WAIT_L(0); PG8_MMA(1, 0, At, B0); PG8_BAR; PG8_SCHED;
            PG8_STAGE(PG8_SB(0, 1), b2 + hstep, voffB);
            PG8_WAIT_V(6); PG8_BAR; PG8_MMA(1, 1, At, B1); PG8_BAR;
            PG8_LDB(B0, 1, 0); PG8_SCHED; PG8_LDA(At, 1, 0); PG8_STAGE(PG8_SA(0, 1), a2 + hstep, voffA);
            PG8_WAIT_L(8); PG8_BAR; PG8_WAIT_L(0); PG8_MMA(0, 0, At, B0); PG8_BAR; PG8_SCHED;
            PG8_LDB(B1, 1, 1); PG8_STAGE(PG8_SB(1, 0), b3, voffB);
            PG8_BAR; PG8_WAIT_L(0); PG8_MMA(0, 1, At, B1); PG8_BAR;
            PG8_LDA(At, 1, 1); PG8_STAGE(PG8_SA(1, 0), a3, voffA);
            PG8_BAR; PG8_WAIT_L(0); PG8_MMA(1, 0, At, B0); PG8_BAR; PG8_SCHED;
            PG8_STAGE(PG8_SB(1, 1), b3 + hstep, voffB);
            PG8_WAIT_V(6); PG8_BAR; PG8_MMA(1, 1, At, B1); PG8_BAR;
            }
        }
        if constexpr (ALIGN_EPI) { if (wr == 0) PG8_BAR; }
        if constexpr (!Epi::AFTER_DRAIN) { E(acc, cur, wr, wc, fr, fq); S.done(cur); }
        if (!has_next) break;
#pragma unroll
        for (int a = 0; a < 2; ++a)
#pragma unroll
            for (int b = 0; b < 2; ++b)
#pragma unroll
                for (int m = 0; m < 4; ++m)
#pragma unroll
                    for (int n = 0; n < 2; ++n) acc[a][b][m][n] = (f32x4){0.f, 0.f, 0.f, 0.f};
        cur = nxt; cA = nA; cB = nB; ++ui;
        if constexpr (ALIGN_EPI) { if (wr == 1) PG8_BAR; }
    }
    PG8_WAIT_V(0);
    if constexpr (!ALIGN_EPI) { if (wr == 0) PG8_BAR; }
    PG8_BAR;
    if constexpr (Epi::AFTER_DRAIN) { E.fused(acc, cur, wr, wc, fr, fq, lds, wid, lane); S.done(cur); }
#undef PG8_SA
#undef PG8_SB
#undef PG8_STAGE
#undef PG8_LDA
#undef PG8_LDB
#undef PG8_MMA
#undef PG8_WAIT_V
#undef PG8_WAIT_L
#undef PG8_BAR
#undef PG8_SCHED
}
}
#define FAST_ATTN 1
#define FAST_FFT 1
#define LAS __attribute__((address_space(3)))
__device__ __forceinline__ float wave_sum(float v) {
#pragma unroll
    for (int o = 1; o < 64; o <<= 1) v += __shfl_xor(v, o);
    return v;
}
__device__ __forceinline__ void tr_write(const LAS float* scr, bf16_t* Bt, int ldk, int k0, int P0, int P1, int P2, int P3, int lane) {
    const int c = lane & 7, nl = lane >> 3;
#pragma unroll
    for (int j = 0; j < 4; ++j) { const int n = nl + 8 * j; const LAS float* s = scr + (8 * c) * 33 + n; const int P = j == 0 ? P0 : j == 1 ? P1 : j == 2 ? P2 : P3;
        uint4 o; o.x = pk2(s[0], s[33]); o.y = pk2(s[2 * 33], s[3 * 33]); o.z = pk2(s[4 * 33], s[5 * 33]); o.w = pk2(s[6 * 33], s[7 * 33]);
        { typedef unsigned tr_u32x4 __attribute__((ext_vector_type(4))); __builtin_nontemporal_store((tr_u32x4){o.x, o.y, o.z, o.w}, (tr_u32x4*)(Bt + (size_t)P * ldk + k0 + 8 * c)); } }
    asm volatile("s_waitcnt lgkmcnt(0)" ::: "memory");
}
__device__ __forceinline__ void tr_load(LAS float* scr, const float* W, int ldw, int k0, int col0, int lane) {
    float v[32];
#pragma unroll
    for (int i = 0; i < 32; ++i) v[i] = __builtin_nontemporal_load(W + (size_t)(k0 + 2 * i + (lane >> 5)) * ldw + col0 + (lane & 31));
#pragma unroll
    for (int i = 0; i < 32; ++i) scr[(2 * i + (lane >> 5)) * 33 + (lane & 31)] = v[i];
    asm volatile("s_waitcnt lgkmcnt(0)" ::: "memory");
}
__device__ __forceinline__ int perm_gu(int j, int t) { const int jj = j & 127; return 256 * (j >> 7) + 128 * t + 32 * (jj >> 5) + 16 * ((jj & 7) >> 2) + 4 * ((jj & 31) >> 3) + (jj & 3); }
__device__ __forceinline__ int perm_in(int u, int d) { return 256 * (u >> 2) + 32 * (u & 3) + 128 * (d >> 5) + (d & 31); }

__device__ __forceinline__ void prologue_phase(KP P, LAS unsigned char* lds) {
    int tid_ = threadIdx.x, bid_ = blockIdx.x; asm volatile("" : "+v"(tid_)); asm volatile("" : "+s"(bid_));
    const int tid = tid_, lane = tid & 63, wave = tid >> 6, bid = bid_, G = gridDim.x;
    float* MOD = (float*)(P->ws + WS_MOD); float* TAB = (float*)(P->ws + WS_TAB);
    LAS float* cs64 = (LAS float*)(lds + 8 * 8448);
    LAS unsigned* ctr = (LAS unsigned*)(lds + 8 * 8448 + 256);
    if (tid < 64) cs64[tid] = cospif((float)tid / 32.f);
    if (tid == 64) ctr[0] = 0u;
    {
        const int i = bid * 512 + tid;
        if (i < 8192) TAB[TAB_COS + i] = cospif((float)i / 4096.f);
        else if (i < 8192 + 3072) { const int e = i - 8192, p = e / 16, k = e % 16; const float inv = powf(10000.f, -(float)(2 * k) / 32.f);
            const float ang = (float)(p < 128 ? p : p - 128) * inv; TAB[TAB_ROPE + e * 2] = cosf(ang); TAB[TAB_ROPE + e * 2 + 1] = sinf(ang); }
        else if (i < 8192 + 3072 + 16384) { const int e = i - 8192 - 3072, mrow = e >> 7, kcol = e & 127; const int k1 = mrow >> 1, ro = mrow & 1, l1 = kcol >> 1, ri = kcol & 1;
            const int j = (k1 * l1) & 63; const float cv = cospif((float)j / 32.f), sv = sinpif((float)j / 32.f);
            const float v = (ro == ri) ? cv : (ro == 0 ? sv : -sv);
            ((bf16_t*)(P->ws + WS_TAB + TAB_D1_BYTES))[e] = f2bf(v); }
        else if (i < 8192 + 3072 + 16384 + 32768) { const int e = i - 8192 - 3072 - 16384, k2 = e >> 8, kcol = e & 255, l2 = kcol >> 1, ri = kcol & 1;
            const int j = (k2 * l2) & 127; const float v = ri == 0 ? cospif((float)j / 64.f) : sinpif((float)j / 64.f);
            ((bf16_t*)(P->ws + WS_TAB + TAB_D3_BYTES))[e] = f2bf(v); }
    }
    {
        LAS float* sv = (LAS float*)lds;
        LAS float* red = (LAS float*)(lds + 12288);
        for (int i = tid; i < 1024; i += 512) { sv[i] = silu_f(P->c[i]); sv[1024 + i] = silu_f(P->c[1024 + i]); sv[2048 + i] = silu_f(P->cctx[i]); }
        __syncthreads();
        for (int it = bid; it < 256; it += G) {
            const int l = it >> 7, n0 = (it & 127) * 72;
            const float* W = P->w_ada + (size_t)l * 1024 * NMOD + n0;
            float a0 = 0.f, a1 = 0.f, a2 = 0.f, e0 = 0.f, e1 = 0.f, e2 = 0.f;
            const int ks = wave * 128 + 16 * (lane >> 3);
#pragma unroll
            for (int j = 0; j < 16; ++j) { const float w = __builtin_nontemporal_load(W + (size_t)(ks + j) * NMOD + 64 + (lane & 7)); e0 += sv[ks + j] * w; e1 += sv[1024 + ks + j] * w; e2 += sv[2048 + ks + j] * w; }
#pragma unroll 32
            for (int k = wave * 128; k < wave * 128 + 128; ++k) { const float w = __builtin_nontemporal_load(W + (size_t)k * NMOD + lane); a0 += sv[k] * w; a1 += sv[1024 + k] * w; a2 += sv[2048 + k] * w; }
#pragma unroll
            for (int o = 8; o < 64; o <<= 1) { e0 += __shfl_xor(e0, o); e1 += __shfl_xor(e1, o); e2 += __shfl_xor(e2, o); }
            red[(wave * 3 + 0) * 72 + lane] = a0; red[(wave * 3 + 1) * 72 + lane] = a1; red[(wave * 3 + 2) * 72 + lane] = a2;
            if (lane < 8) { red[(wave * 3 + 0) * 72 + 64 + lane] = e0; red[(wave * 3 + 1) * 72 + 64 + lane] = e1; red[(wave * 3 + 2) * 72 + 64 + lane] = e2; }
            __syncthreads();
            if (tid < 216) { const int w = tid / 72, cc = tid - w * 72; float s = P->b_ada[l * NMOD + n0 + cc];
#pragma unroll
                for (int q = 0; q < 8; ++q) s += red[(q * 3 + w) * 72 + cc];
                MOD[(size_t)(l * 3 + w) * NMOD + n0 + cc] = s; }
            __syncthreads();
        }
    }
    {
        LAS float* scr = (LAS float*)(lds + wave * 8448);
        const int nl = lane >> 3;
        for (int hid = bid + G * wave; hid < 768 && wave < 8; hid += 8 * G) {
            const int l = hid / 384; int r = hid - l * 384;
            bf16_t* WT = (bf16_t*)(P->ws + WS_WT) + (size_t)l * WT_L;
            if (r < 256) {
                const int kb = r / 16, ob = r % 16;
                const int u = 20 + (ob >> 1), g = (u - 20) >> 1, half = (u - 20) & 1, q = (ob & 1) * 32 + (lane & 31);
                const int dch = 32 * half + (q >> 1), ri = q & 1;
                const float* W = P->w_in + (size_t)l * 1024 * DIN + 1280 + g * 64;
                float tw[64];
#pragma unroll
                for (int cc = 0; cc < 64; ++cc) { const int j = (cc * dch) & 63; tw[cc] = ri == 0 ? cs64[j] : -cs64[(j - 16) & 63]; }
                for (int i = 0; i < 32; ++i) { const int kk = 2 * i + (lane >> 5); const float4* w4 = (const float4*)(W + (size_t)(kb * 64 + kk) * DIN); float a = 0.f;
#pragma unroll
                    for (int c4 = 0; c4 < 16; ++c4) { const float4 wv = w4[c4]; a += wv.x * tw[4 * c4] + wv.y * tw[4 * c4 + 1] + wv.z * tw[4 * c4 + 2] + wv.w * tw[4 * c4 + 3]; }
                    scr[kk * 33 + (lane & 31)] = a; }
                asm volatile("s_waitcnt lgkmcnt(0)" ::: "memory");
                const int d = (ob & 1) * 32 + nl;
                tr_write(scr, WT + WT_IN, 1024, kb * 64, perm_in(u, d), perm_in(u, d + 8), perm_in(u, d + 16), perm_in(u, d + 24), lane);
            } else {
                r -= 256; const int g = r / 32, nb = r % 32;
                const float* wo = P->w_out + (size_t)l * 1024 * 1024 + (size_t)(768 + g * 64) * 1024 + nb * 32 + (lane & 31);
                const float* wf = P->w_four + (size_t)(l * 4 + g) * 4096;
                float wov[64];
#pragma unroll
                for (int d = 0; d < 64; ++d) wov[d] = wo[(size_t)d * 1024];
                for (int i = 0; i < 32; ++i) { const int kk = 2 * i + (lane >> 5); const float4* f4 = (const float4*)(wf + kk * 64); float a = 0.f;
#pragma unroll
                    for (int d4 = 0; d4 < 16; ++d4) { const float4 fv = f4[d4]; a += fv.x * wov[4 * d4] + fv.y * wov[4 * d4 + 1] + fv.z * wov[4 * d4 + 2] + fv.w * wov[4 * d4 + 3]; }
                    scr[kk * 33 + (lane & 31)] = a; }
                asm volatile("s_waitcnt lgkmcnt(0)" ::: "memory");
                const int j = nb * 32 + nl;
                tr_write(scr, WT + WT_OUT, 1024, 768 + g * 64, j, j + 8, j + 16, j + 24, lane);
            }
        }
        constexpr int NA = 4 * 1408, NBd = 2 * 1408, NC = 640, NE = 384, NL = NA + NBd + NC + NE;
        const int lo = (int)(((long)bid * (2 * NL)) / G), hi = (int)(((long)(bid + 1) * (2 * NL)) / G);
        for (;;) {
            unsigned iu = 0u; if (lane == 0) iu = __hip_atomic_fetch_add(ctr, 1u, __ATOMIC_RELAXED, __HIP_MEMORY_SCOPE_WORKGROUP);
            const int it = lo + (int)__builtin_amdgcn_readfirstlane(iu);
            if (it >= hi) break;
            const int l = it / NL; int r = it - l * NL;
            bf16_t* WT = (bf16_t*)(P->ws + WS_WT) + (size_t)l * WT_L;
            if (r < NA) { const int f = r / 2816, t = (r / 1408) & 1, q = r % 1408, kb = q / 88, nb = q % 88;
                const float* W = (f == 0 ? (t == 0 ? P->w1g : P->w1u) : (t == 0 ? P->w2g : P->w2u)) + (size_t)l * 1024 * DFF;
                tr_load(scr, W, DFF, kb * 64, nb * 32, lane);
                const int j = nb * 32 + nl;
                tr_write(scr, WT + WT_GU + (size_t)f * 5632 * 1024, 1024, kb * 64, perm_gu(j, t), perm_gu(j + 8, t), perm_gu(j + 16, t), perm_gu(j + 24, t), lane);
                continue; }
            r -= NA;
            if (r < NBd) { const int f = r / 1408, q = r % 1408, kb = q / 32, nb = q % 32;
                const float* W = (f == 0 ? P->w1d : P->w2d) + (size_t)l * DFF * 1024;
                tr_load(scr, W, 1024, kb * 64, nb * 32, lane);
                const int j = nb * 32 + nl;
                { bf16_t* Bd = WT + WT_DN + (size_t)f * 1024 * MIDP + (size_t)(j >> 8) * 256 * DFF + (size_t)kb * (256 * 64);
                  tr_write(scr, Bd, 64, 0, j & 255, (j + 8) & 255, (j + 16) & 255, (j + 24) & 255, lane); }
                continue; }
            r -= NBd;
            if (r < NC) { const int kb = r / 40, nb = r % 40;
                tr_load(scr, P->w_in + (size_t)l * 1024 * DIN, DIN, kb * 64, nb * 32, lane);
                const int u = nb >> 1, d = (nb & 1) * 32 + nl;
                tr_write(scr, WT + WT_IN, 1024, kb * 64, perm_in(u, d), perm_in(u, d + 8), perm_in(u, d + 16), perm_in(u, d + 24), lane);
                continue; }
            r -= NC;
            { const int kb = r / 32, nb = r % 32;
                tr_load(scr, P->w_out + (size_t)l * 1024 * 1024, 1024, kb * 64, nb * 32, lane);
                const int j = nb * 32 + nl;
                tr_write(scr, WT + WT_OUT, 1024, kb * 64, j, j + 8, j + 16, j + 24, lane); }
        }
    }
}
__device__ __forceinline__ void norm_phase(KP P, const float* g, const float* MODl, int shc, int scc, bool from_input, int npart) {
    int tid_ = threadIdx.x, bid_ = blockIdx.x; asm volatile("" : "+v"(tid_)); asm volatile("" : "+s"(bid_));
    const int lane = tid_ & 63, gw = bid_ * 8 + (tid_ >> 6), NGW = gridDim.x * 8;
    float* H = (float*)(P->ws + WS_H); bf16_t* XN = (bf16_t*)(P->ws + WS_XN);
    constexpr int RU = 3;
    for (int row0 = gw; row0 < M; row0 += RU * NGW) {
        float4 v[RU][4]; float ss[RU];
#pragma unroll
        for (int u = 0; u < RU; ++u) { const int row = row0 + u * NGW; ss[u] = 0.f;
            if (row < M) { const int b = row / RPB, t = row - b * RPB;
                const float4* h = from_input ? (t < SEQ ? (const float4*)(P->x + ((size_t)b * SEQ + t) * DM) : (const float4*)(P->ctx + ((size_t)b * CTXL + (t - SEQ)) * DM)) : (const float4*)(H + (size_t)row * DM);
#pragma unroll
                for (int j = 0; j < 4; ++j) { if (from_input) { const f32x4 t4 = __builtin_nontemporal_load((const f32x4*)h + lane + 64 * j); v[u][j] = make_float4(t4[0], t4[1], t4[2], t4[3]); }
                    else v[u][j] = h[lane + 64 * j]; } } }
#pragma unroll
        for (int u = 0; u < RU; ++u) { const int row = row0 + u * NGW;
            if (row < M) { const int b = row / RPB, t = row - b * RPB, w = t >= SEQ ? 2 : b;
                if (t >= SEQ && npart > 0) {
                    const float4* pp = (const float4*)(P->ws + WS_PART) + (size_t)(b * CTXL + (t - SEQ)) * 256 + lane;
                    for (int q = 0; q < npart; ++q) {
#pragma unroll
                        for (int j = 0; j < 4; ++j) { const float4 a = pp[(size_t)q * 512 * 256 + 64 * j]; v[u][j].x += a.x; v[u][j].y += a.y; v[u][j].z += a.z; v[u][j].w += a.w; } } }
#pragma unroll
                for (int j = 0; j < 4; ++j) ss[u] += v[u][j].x * v[u][j].x + v[u][j].y * v[u][j].y + v[u][j].z * v[u][j].z + v[u][j].w * v[u][j].w;
                if (from_input || (t >= SEQ && npart > 0)) {
#pragma unroll
                    for (int j = 0; j < 4; ++j) ((float4*)(H + (size_t)row * DM))[lane + 64 * j] = v[u][j]; }
                const float r = rsqrtf(wave_sum(ss[u]) * (1.f / DM) + 1e-6f);
                const float* sh = MODl + w * NMOD + shc * 1024; const float* sc = MODl + w * NMOD + scc * 1024;
#pragma unroll
                for (int j = 0; j < 4; ++j) { const int c = (lane + 64 * j) * 4; const float4 gg = *(const float4*)(g + c), s4 = *(const float4*)(sh + c), c4 = *(const float4*)(sc + c);
                    uint2 o; o.x = pk2(v[u][j].x * r * gg.x * (1.f + c4.x) + s4.x, v[u][j].y * r * gg.y * (1.f + c4.y) + s4.y);
                    o.y = pk2(v[u][j].z * r * gg.z * (1.f + c4.z) + s4.z, v[u][j].w * r * gg.w * (1.f + c4.w) + s4.w);
                    *(uint2*)(XN + (size_t)row * DM + c) = o; } } }
    }
}
__device__ __forceinline__ void final_phase(KP P) {
    int tid_ = threadIdx.x, bid_ = blockIdx.x; asm volatile("" : "+v"(tid_)); asm volatile("" : "+s"(bid_));
    const int lane = tid_ & 63, gw = bid_ * 8 + (tid_ >> 6), NGW = gridDim.x * 8;
    const float* H = (const float*)(P->ws + WS_H);
    for (int orow = gw; orow < NB * SEQ; orow += NGW) {
        const int b = orow / SEQ, t = orow - b * SEQ;
        const float4* h = (const float4*)(H + (size_t)(b * RPB + t) * DM);
        float4 v[4]; float ss = 0.f;
#pragma unroll
        for (int j = 0; j < 4; ++j) { v[j] = h[lane + 64 * j]; ss += v[j].x * v[j].x + v[j].y * v[j].y + v[j].z * v[j].z + v[j].w * v[j].w; }
        const float r = rsqrtf(wave_sum(ss) * (1.f / DM) + 1e-6f);
#pragma unroll
        for (int j = 0; j < 4; ++j) { const int c = (lane + 64 * j) * 4; const float4 gg = *(const float4*)(P->g_final + c);
            float4 o; o.x = v[j].x * r * gg.x; o.y = v[j].y * r * gg.y; o.z = v[j].z * r * gg.z; o.w = v[j].w * r * gg.w;
            __builtin_nontemporal_store((f32x4){o.x, o.y, o.z, o.w}, (f32x4*)(P->out + (size_t)orow * DM + c)); }
    }
}
template <class Epi> __device__ __forceinline__ void run_gemm(LAS unsigned char* lds, const bf16_t* A, const bf16_t* Bt, int N, int K, int lda, int blocked, int no_ctx, Epi E) {
    const int npass = (N == 1024 && !no_ctx) ? 2 : 1;
    for (int pass = 0; pass < npass; ++pass) {
        pg8::Gemm g{A, Bt, M, N, pass ? 256 : K, lda, blocked}; pg8::SplitOrder S; S.init((N == 1024 || no_ctx) ? 1 + pass : 0, M, N, (int)gridDim.x, (int)blockIdx.x, K / 256, 256);
        pg8::gemm_phase<Epi, pg8::SplitOrder, true, true>(lds, g, S, E);
    }
}

typedef float f32x16 __attribute__((ext_vector_type(16)));
typedef short bf16x8_t __attribute__((ext_vector_type(8)));
typedef short s16x4_t __attribute__((ext_vector_type(4)));
typedef unsigned u32x4_t __attribute__((ext_vector_type(4)));
typedef unsigned u32x2_t __attribute__((ext_vector_type(2)));
constexpr int AT_KBUF = 0, AT_VBUF = 32768, AT_VSTRIDE = 264, AT_VBYTES = 64 * AT_VSTRIDE, AT_COMB = AT_VBUF + 3 * AT_VBYTES, AT_COMB_PAIR = 34 * 64 * 4;
static_assert(AT_COMB + 4 * AT_COMB_PAIR <= 131072, "attention LDS map");
typedef float at_f32x2 __attribute__((ext_vector_type(2))); typedef __bf16 at_bf16x2 __attribute__((ext_vector_type(2)));
__device__ __forceinline__ unsigned cvtpk(float lo, float hi) { const at_f32x2 v = {lo, hi}; const at_bf16x2 b = __builtin_convertvector(v, at_bf16x2); return __builtin_bit_cast(unsigned, b); }

__device__ __forceinline__ void attn_unit(KP P, LAS unsigned char* lds, int l, int tid, int b, int hh, int q0, bool lat) {
    unsigned char* ws = P->ws;
    const int lane = tid & 63, r32 = lane & 31, hi = lane >> 5, wid = __builtin_amdgcn_readfirstlane(tid >> 6), g = wid >> 2, wq = wid & 3;
    const bool isB = hh >= 6; const int h = isB ? hh - 6 : hh, kvh = h / 3;
    const bf16_t* Q = (const bf16_t*)(ws + (isB ? WS_QB : WS_QA)) + ((size_t)b * RPB + q0 + 32 * wq + r32) * 384 + h * 64;
    const bf16_t* Kg = (const bf16_t*)(ws + (isB ? WS_KB : WS_KA)) + (size_t)b * RPB * 128 + kvh * 64;
    const bf16_t* Vg = (const bf16_t*)(ws + (isB ? WS_VTB : WS_VTA)) + ((size_t)(b * 2 + kvh) * 64) * RPB;
    int npre, kb_lo, nsteps;
    if (!lat) { npre = 2; kb_lo = 0; nsteps = 2; }
    else if (isB) { npre = 0; kb_lo = 0; nsteps = 66; }
    else { const int qb = q0 >> 7; kb_lo = qb > 0 ? qb - 1 : 0; const int kb_hi = qb < 63 ? qb + 1 : 63; npre = 2; nsteps = 2 + (kb_hi - kb_lo + 1); }
    const int kkey0 = tid >> 3, kc = tid & 7;
    const unsigned kdst0 = (unsigned)(kkey0 * 128 + ((kc ^ ((kkey0 >> 1) & 7)) * 16));
    const int vd0 = tid >> 4, vc = tid & 15;
    const unsigned vdst0 = (unsigned)(vd0 * AT_VSTRIDE + vc * 16);
    const bf16_t* kg0 = Kg + (size_t)kkey0 * 128 + kc * 8;
    const bf16_t* vg0 = Vg + (size_t)vd0 * RPB + vc * 8;
    u32x4_t pk0, pk1, pv0, pv1;
#define AT_KP0(s) ((s) < npre ? SEQ + 128 * (s) : 128 * (kb_lo + (s) - npre))
#define AT_LOADK(s) do { const int kp0_ = AT_KP0(s); pk0 = *(const u32x4_t*)(kg0 + (size_t)kp0_ * 128); pk1 = *(const u32x4_t*)(kg0 + (size_t)(kp0_ + 64) * 128); } while (0)
#define AT_LOADV(s) do { const int kp0_ = AT_KP0(s); pv0 = *(const u32x4_t*)(vg0 + kp0_); pv1 = *(const u32x4_t*)(vg0 + (size_t)32 * RPB + kp0_); } while (0)
#define AT_STOREK(buf) do { LAS unsigned char* kb_ = lds + AT_KBUF + (buf) * 16384; *(LAS u32x4_t*)(kb_ + kdst0) = pk0; *(LAS u32x4_t*)(kb_ + kdst0 + 8192) = pk1; } while (0)
#define AT_STOREV(buf) do { LAS unsigned char* vb_ = lds + AT_VBUF + (buf) * AT_VBYTES; \
        *(LAS u32x2_t*)(vb_ + vdst0) = (u32x2_t){pv0.x, pv0.y}; *(LAS u32x2_t*)(vb_ + vdst0 + 8) = (u32x2_t){pv0.z, pv0.w}; \
        *(LAS u32x2_t*)(vb_ + vdst0 + 32 * AT_VSTRIDE) = (u32x2_t){pv1.x, pv1.y}; *(LAS u32x2_t*)(vb_ + vdst0 + 32 * AT_VSTRIDE + 8) = (u32x2_t){pv1.z, pv1.w}; } while (0)
#define AT_QK_LD(buf) do { const LAS unsigned char* kb_ = lds + AT_KBUF + (buf) * 16384; \
        _Pragma("unroll") for (int d0 = 0; d0 < 4; ++d0) { kf[2 * d0] = *(const LAS bf16x8_t*)(kb_ + koff[d0]); kf[2 * d0 + 1] = *(const LAS bf16x8_t*)(kb_ + koff[d0] + 4096); } } while (0)
#define AT_QK_MMA(S0_, S1_) do { S0_ = __builtin_amdgcn_mfma_f32_32x32x16_bf16(kf[0], qf[0], negm, 0, 0, 0); S1_ = __builtin_amdgcn_mfma_f32_32x32x16_bf16(kf[1], qf[0], negm, 0, 0, 0); \
        _Pragma("unroll") for (int d0 = 1; d0 < 4; ++d0) { \
            S0_ = __builtin_amdgcn_mfma_f32_32x32x16_bf16(kf[2 * d0], qf[d0], S0_, 0, 0, 0); S1_ = __builtin_amdgcn_mfma_f32_32x32x16_bf16(kf[2 * d0 + 1], qf[d0], S1_, 0, 0, 0); } } while (0)
#define AT_QK(S0_, S1_, buf) do { AT_QK_LD(buf); __builtin_amdgcn_sched_barrier(0); AT_QK_MMA(S0_, S1_); } while (0)
    AT_LOADK(0); AT_LOADV(0);
    u32x4_t pk2, pk3;
    { const int kp1_ = AT_KP0(1); pk2 = *(const u32x4_t*)(kg0 + (size_t)kp1_ * 128); pk3 = *(const u32x4_t*)(kg0 + (size_t)(kp1_ + 64) * 128); }
    bf16x8_t qf[4], kf[8], vfr[8];
#pragma unroll
    for (int d0 = 0; d0 < 4; ++d0) qf[d0] = *(const bf16x8_t*)(Q + 16 * d0 + 8 * hi);
    const int key0 = 64 * g + r32; const int swz = (key0 >> 1) & 7;
    unsigned koff[4];
#pragma unroll
    for (int d0 = 0; d0 < 4; ++d0) koff[d0] = (unsigned)(key0 * 128 + (((2 * d0 + hi) ^ swz) * 16));
    const unsigned voff = (unsigned)(r32 * AT_VSTRIDE + 128 * g + 8 * hi);
    f32x16 O0 = {}, O1 = {};
    float m = 0.f, lsum = 0.f, pend = 0.f;
    f32x16 negm = {};
    constexpr float AT_THR = 8.f;
    const int qp = q0 + 32 * wq + r32;
    AT_STOREK(0); AT_STOREV(0);
    { LAS unsigned char* kb_ = lds + AT_KBUF + 16384; *(LAS u32x4_t*)(kb_ + kdst0) = pk2; *(LAS u32x4_t*)(kb_ + kdst0 + 8192) = pk3; }
    __syncthreads();
    f32x16 S0, S1;
    AT_QK(S0, S1, 0);
    __syncthreads();
#define AT_PV_LD(vs) do { const LAS unsigned char* vb_ = lds + AT_VBUF + (vs) * AT_VBYTES; \
        _Pragma("unroll") for (int sl = 0; sl < 4; ++sl) _Pragma("unroll") for (int dd = 0; dd < 2; ++dd) { \
            const u32x2_t lo = *(const LAS u32x2_t*)(vb_ + voff + dd * 32 * AT_VSTRIDE + 32 * sl), hi8 = *(const LAS u32x2_t*)(vb_ + voff + dd * 32 * AT_VSTRIDE + 32 * sl + 16); \
            const u32x4_t vw = {lo.x, lo.y, hi8.x, hi8.y}; vfr[2 * sl + dd] = __builtin_bit_cast(bf16x8_t, vw); } } while (0)
#define AT_PV_MMA() do { _Pragma("unroll") for (int sl = 0; sl < 4; ++sl) { const bf16x8_t pf = __builtin_bit_cast(bf16x8_t, pp[sl]); \
            O0 = __builtin_amdgcn_mfma_f32_32x32x16_bf16(vfr[2 * sl], pf, O0, 0, 0, 0); O1 = __builtin_amdgcn_mfma_f32_32x32x16_bf16(vfr[2 * sl + 1], pf, O1, 0, 0, 0); } } while (0)
#define AT_PV(vs) do { AT_PV_LD(vs); __builtin_amdgcn_sched_barrier(0); AT_PV_MMA(); } while (0)
    u32x4_t pp[4] = {};
    int vs_prev = 0, vs_cur = 0, vs_next = 1;
    for (int s = 0; s < nsteps; ++s) {
        if (s + 2 < nsteps) AT_LOADK(s + 2);
        if (s + 1 < nsteps) AT_LOADV(s + 1);
        f32x16 N0, N1;
        if (lat && !isB && s >= npre) {
            const int kpb = AT_KP0(s) + 64 * g + 4 * hi - qp;
#pragma unroll
            for (int r = 0; r < 16; ++r) { const int dlt = kpb + (r & 3) + 8 * (r >> 2);
                if (dlt > 128 || dlt < -128) S0[r] = -1e30f;
                if (dlt + 32 > 128 || dlt + 32 < -128) S1[r] = -1e30f; }
        }
        if (__any(pend != 0.f)) { S0 = S0 - pend; S1 = S1 - pend; }
        AT_QK_LD((s + 1) & 1);
        __builtin_amdgcn_sched_barrier(0);
        __builtin_amdgcn_s_setprio(1); AT_QK_MMA(N0, N1); __builtin_amdgcn_s_setprio(0);
        AT_PV_LD(vs_prev);
        __builtin_amdgcn_sched_barrier(0);
        __builtin_amdgcn_s_setprio(1); AT_PV_MMA(); __builtin_amdgcn_s_setprio(0);
        __builtin_amdgcn_sched_barrier(0);
        float rm = __builtin_fmaxf(__builtin_fmaxf(S0[0], S1[0]), S0[1]);
#pragma unroll
        for (int r = 1; r < 16; ++r) rm = __builtin_fmaxf(__builtin_fmaxf(rm, S1[r]), r < 15 ? S0[r + 1] : S1[r]);
        { const auto rr = __builtin_amdgcn_permlane32_swap(__float_as_uint(rm), __float_as_uint(rm), false, false); rm = fmaxf(__uint_as_float(rr[0]), __uint_as_float(rr[1])); }
        float alpha = 1.f; pend = 0.f;
        if (s == 0 || __any(rm > AT_THR)) {
            const float dl = s == 0 ? rm : fmaxf(rm, 0.f);
            S0 = S0 - dl; S1 = S1 - dl; negm = negm - dl; m += dl; pend = dl;
            alpha = __builtin_amdgcn_exp2f(-dl); lsum *= alpha;
        }
        float ps = 0.f;
#pragma unroll
        for (int r = 0; r < 16; ++r) { S0[r] = __builtin_amdgcn_exp2f(S0[r]); S1[r] = __builtin_amdgcn_exp2f(S1[r]); ps += S0[r] + S1[r]; }
        lsum += ps;
#pragma unroll
        for (int sl = 0; sl < 4; ++sl) { const int rb = 8 * (sl & 1);
            if (sl < 2) pp[sl] = (u32x4_t){cvtpk(S0[rb], S0[rb + 1]), cvtpk(S0[rb + 2], S0[rb + 3]), cvtpk(S0[rb + 4], S0[rb + 5]), cvtpk(S0[rb + 6], S0[rb + 7])};
            else pp[sl] = (u32x4_t){cvtpk(S1[rb], S1[rb + 1]), cvtpk(S1[rb + 2], S1[rb + 3]), cvtpk(S1[rb + 4], S1[rb + 5]), cvtpk(S1[rb + 6], S1[rb + 7])}; }
        __builtin_amdgcn_sched_barrier(0);
        if (__any(alpha != 1.f)) {
#pragma unroll
            for (int r = 0; r < 16; ++r) { O0[r] *= alpha; O1[r] *= alpha; } }
        if (s + 2 < nsteps) AT_STOREK(s & 1);
        if (s + 1 < nsteps) AT_STOREV(vs_next);
        __syncthreads();
        S0 = N0; S1 = N1;
        vs_prev = vs_cur; vs_cur = vs_next; vs_next = vs_next == 2 ? 0 : vs_next + 1;
    }
    AT_PV(vs_prev);
#undef AT_PV
#undef AT_PV_LD
#undef AT_PV_MMA
#undef AT_QK_LD
#undef AT_QK_MMA
#undef AT_LOADK
#undef AT_LOADV
#undef AT_STOREK
#undef AT_STOREV
#undef AT_QK
    float ltot = lsum + __shfl_xor(lsum, 32);
    LAS float* comb = (LAS float*)(lds + AT_COMB + wq * AT_COMB_PAIR);
    if (g == 1) {
        comb[lane] = m; comb[64 + lane] = ltot;
#pragma unroll
        for (int r = 0; r < 16; ++r) { comb[(2 + r) * 64 + lane] = O0[r]; comb[(18 + r) * 64 + lane] = O1[r]; }
    }
    __syncthreads();
    if (g == 0) {
        const float m1 = comb[lane], l1 = comb[64 + lane];
        float mf = fmaxf(m, m1); float sk = 0.f;
        if (!isB) { const float s2 = P->sink[l * 6 + h] * LOG2E; mf = fmaxf(mf, s2); sk = __builtin_amdgcn_exp2f(s2 - mf); }
        const float a0 = __builtin_amdgcn_exp2f(m - mf), a1 = __builtin_amdgcn_exp2f(m1 - mf);
        const float inv = 1.f / (ltot * a0 + l1 * a1 + sk);
        const float c0 = a0 * inv, c1 = a1 * inv;
        bf16_t* dst = (bf16_t*)(ws + WS_XN) + ((size_t)b * RPB + q0 + 32 * wq + r32) * DM + (isB ? 384 : 0) + h * 64 + 4 * hi;
#pragma unroll
        for (int rq = 0; rq < 4; ++rq) {
            float o[8];
#pragma unroll
            for (int i = 0; i < 4; ++i) { o[i] = O0[4 * rq + i] * c0 + comb[(2 + 4 * rq + i) * 64 + lane] * c1; o[4 + i] = O1[4 * rq + i] * c0 + comb[(18 + 4 * rq + i) * 64 + lane] * c1; }
            *(u32x2_t*)(dst + 8 * rq) = (u32x2_t){cvtpk(o[0], o[1]), cvtpk(o[2], o[3])};
            *(u32x2_t*)(dst + 32 + 8 * rq) = (u32x2_t){cvtpk(o[4], o[5]), cvtpk(o[6], o[7])};
        }
    }
    __syncthreads();
#undef AT_KP0
}
__device__ __forceinline__ void attn_phase(KP P, LAS unsigned char* lds, int l) {
    int tid_ = threadIdx.x, bid_ = blockIdx.x; asm volatile("" : "+v"(tid_)); asm volatile("" : "+s"(bid_));
    const int G = gridDim.x;
    const bool xcd = (G == 256);
    const int NU = 1536 + (l == 0 ? 48 : 0);
    for (int it = 0;; ++it) {
        int idx;
        if (xcd) { if (it >= 7) break; idx = it < 6 ? (it / 3) * 768 + (bid_ & 7) * 96 + (it % 3) * 32 + (bid_ >> 3) : 1536 + bid_; if (idx >= NU) break; }
        else { idx = bid_ + it * G; if (idx >= NU) break; }
        int b, hh, q0; bool lat = true;
        if (idx < 768) { b = idx / 384; hh = 6 + (idx % 384) / 64; q0 = (idx & 63) * 128; }
        else if (idx < 1536) { const int u = idx - 768; b = u / 384; hh = (u % 384) / 64; q0 = (u & 63) * 128; }
        else { const int u = idx - 1536; b = u / 24; hh = (u % 24) >> 1; q0 = SEQ + 128 * (u & 1); lat = false; }
        attn_unit(P, lds, l, tid_, b, hh, q0, lat);
    }
}

__device__ __forceinline__ void fft1_phase(KP P, int l) {
    int tid_ = threadIdx.x, bid_ = blockIdx.x; asm volatile("" : "+v"(tid_)); asm volatile("" : "+s"(bid_));
    unsigned char* ws = P->ws;
    const int lane = tid_ & 63, r32 = lane & 31, hi = lane >> 5, w = tid_ >> 6;
    const bf16_t* D1 = (const bf16_t*)(ws + WS_TAB + TAB_D1_BYTES); const float* TAB = (const float*)(ws + WS_TAB);
    for (int it = bid_; it < 256; it += gridDim.x) {
        const int b = it >> 7, l2 = it & 127, ch = 32 * w + r32;
        const unsigned* vsrc = (const unsigned*)(ws + WS_VS) + ((size_t)(b * SEQ + l2 + 512 * hi)) * 256 + ch;
        u32x4_t bfr[8];
#pragma unroll
        for (int s = 0; s < 8; ++s)
#pragma unroll
            for (int j = 0; j < 4; ++j) bfr[s][j] = vsrc[(size_t)(128 * (8 * s + j)) * 256];
        f32x16 acc[4] = {};
#pragma unroll
        for (int s = 0; s < 8; ++s) {
            const bf16x8_t bf = __builtin_bit_cast(bf16x8_t, bfr[s]);
#pragma unroll
            for (int mt = 0; mt < 4; ++mt) { const bf16x8_t af = *(const bf16x8_t*)(D1 + (32 * mt + r32) * 128 + 16 * s + 8 * hi);
                acc[mt] = __builtin_amdgcn_mfma_f32_32x32x16_bf16(af, bf, acc[mt], 0, 0, 0); }
        }
        unsigned* zs = (unsigned*)(ws + WS_ZS);
#pragma unroll
        for (int mt = 0; mt < 4; ++mt)
#pragma unroll
            for (int rq = 0; rq < 4; ++rq)
#pragma unroll
                for (int e = 0; e < 2; ++e) {
                    const int k1 = 16 * mt + 4 * rq + 2 * hi + e; const int idx = k1 * l2;
                    const float ct = TAB[TAB_COS + idx], st = TAB[TAB_COS + ((idx - 2048) & 8191)];
                    const float yr = acc[mt][4 * rq + 2 * e], yi = acc[mt][4 * rq + 2 * e + 1];
                    zs[((size_t)(b * 64 + k1) * 128 + l2) * 256 + ch] = cvtpk(yr * ct + yi * st, yi * ct - yr * st);
                }
    }
    if (l == 0) {
        const unsigned* VC = (const unsigned*)(ws + WS_VC); bf16_t* OM = (bf16_t*)(ws + WS_XN);
        for (int gt = bid_ * 512 + tid_; gt < NB * CTXL * 256; gt += gridDim.x * 512) {
            const int ch = gt & 255, k = (gt >> 8) & 255, b = gt >> 16;
            const unsigned* vp = VC + (size_t)(b * 256) * 256 + ch; float a = 0.f;
#pragma unroll 8
            for (int j = 0; j < 256; ++j) { const unsigned pk = vp[(size_t)j * 256]; const float vr = __uint_as_float(pk << 16), vi = __uint_as_float(pk & 0xffff0000u);
                const int ix = ((k * j) & 255) * 32; a += vr * TAB[TAB_COS + ix] + vi * TAB[TAB_COS + ((ix - 2048) & 8191)]; }
            OM[(size_t)(b * RPB + SEQ + k) * DM + 768 + ch] = f2bf(a * (1.f / 128.f));
        }
    }
}
__device__ __forceinline__ void fft3_phase(KP P, LAS unsigned char* lds, int l) {
    int tid_ = threadIdx.x, bid_ = blockIdx.x; asm volatile("" : "+v"(tid_)); asm volatile("" : "+s"(bid_));
    unsigned char* ws = P->ws;
    const int lane = tid_ & 63, r32 = lane & 31, hi = lane >> 5, w = tid_ >> 6;
    const bf16_t* D3 = (const bf16_t*)(ws + WS_TAB + TAB_D3_BYTES); bf16_t* OM = (bf16_t*)(ws + WS_XN);
    for (int it = bid_; it < 256; it += gridDim.x) {
        const int b = it >> 7, k1 = (it & 127) >> 1, chh = it & 1, ch = 32 * (4 * chh + (w & 3)) + r32, mh = w >> 2;
        const unsigned* zsrc = (const unsigned*)(ws + WS_ZS) + ((size_t)(b * 64 + k1) * 128 + 4 * hi) * 256 + ch;
        f32x16 acc[2] = {};
#pragma unroll
        for (int sh = 0; sh < 2; ++sh) {
            u32x4_t bfr[8];
#pragma unroll
            for (int s = 0; s < 8; ++s)
#pragma unroll
                for (int j = 0; j < 4; ++j) bfr[s][j] = zsrc[(size_t)(8 * (8 * sh + s) + j) * 256];
#pragma unroll
            for (int s = 0; s < 8; ++s) {
                const bf16x8_t bf = __builtin_bit_cast(bf16x8_t, bfr[s]);
#pragma unroll
                for (int mi = 0; mi < 2; ++mi) { const bf16x8_t af = *(const bf16x8_t*)(D3 + (32 * (2 * mh + mi) + r32) * 256 + 16 * (8 * sh + s) + 8 * hi);
                    acc[mi] = __builtin_amdgcn_mfma_f32_32x32x16_bf16(af, bf, acc[mi], 0, 0, 0); }
            }
        }
#pragma unroll
        for (int mi = 0; mi < 2; ++mi)
#pragma unroll
            for (int r = 0; r < 16; ++r) { const int k2 = 32 * (2 * mh + mi) + (r & 3) + 8 * (r >> 2) + 4 * hi;
                OM[((size_t)b * RPB + k1 + 64 * k2) * DM + 768 + ch] = f2bf(acc[mi][r] * 0.0013810679320049757f); }
    }
}

#define GAS __attribute__((address_space(1)))
#define XB_TMO      128
#define XB_XCNT(j)  (256  + 64 * (j))
#define XB_XSUB(j)  (1280 + 64 * (j))
#define XB_XGEN(j)  (2304 + 64 * (j))
#define XB_TOP      3328
#define XB_TOPGEN   3392
#define XCD_BAR_WORDS 3456
#define XB_SPIN_CAP (1u << 18)

__device__ __forceinline__ unsigned xb_ld(unsigned* p)              { return __hip_atomic_load(p, __ATOMIC_RELAXED, __HIP_MEMORY_SCOPE_AGENT); }
__device__ __forceinline__ unsigned xb_add(unsigned* p, unsigned v) { return __hip_atomic_fetch_add(p, v, __ATOMIC_RELAXED, __HIP_MEMORY_SCOPE_AGENT); }
__device__ __forceinline__ unsigned xb_xcc_id() { return (unsigned)__builtin_amdgcn_s_getreg((3 << 11) | 20) & 0xFu; }
#define XB_SPIN(cond, bar) do { unsigned _sp = 0; while (cond) { __builtin_amdgcn_s_sleep(1); \
    if ((++_sp & 255u) == 0u) { if (xb_ld(&(bar)[XB_TMO])) break; if (_sp > XB_SPIN_CAP) { atomicAdd(&(bar)[XB_TMO], 1u); break; } } } } while (0)

struct XcdBarrier {
    unsigned* bar; unsigned x;
    volatile LAS unsigned* st;
};

__device__ __forceinline__ XcdBarrier xcd_barrier_post(unsigned* bar, volatile LAS unsigned* st) {
    XcdBarrier b; b.bar = bar; b.x = xb_xcc_id(); b.st = st;
    if (threadIdx.x == 0) (void)xb_add(&bar[XB_XCNT(b.x)], 1u);
    return b;
}
__device__ __forceinline__ void xcd_barrier_complete(unsigned* bar, unsigned x, unsigned& nloc, unsigned& nx) {
    const unsigned G = gridDim.x * gridDim.y * gridDim.z;
    unsigned sum, cnt, mine, sp = 0u;
    for (;;) {
        sum = 0u; cnt = 0u; mine = 0u;
#pragma unroll
        for (unsigned j = 0; j < 16; ++j) { const unsigned c = xb_ld(&bar[XB_XCNT(j)]); sum += c; cnt += (c > 0u) ? 1u : 0u; mine = (j == x) ? c : mine; }
        if (sum == G) break;
        __builtin_amdgcn_s_sleep(1);
        if ((++sp & 255u) == 0u) { if (xb_ld(&bar[XB_TMO])) break; if (sp > XB_SPIN_CAP) { atomicAdd(&bar[XB_TMO], 1u); break; } }
    }
    nloc = mine > 0u ? mine : 1u; nx = cnt > 0u ? cnt : 1u;
}

__device__ __forceinline__ void xcd_barrier(const XcdBarrier& b) {
    asm volatile("s_waitcnt vmcnt(0)" ::: "memory");
    __syncthreads();
    if (threadIdx.x == 0) {
        unsigned* bar = b.bar;
        __builtin_amdgcn_s_waitcnt(0);
        unsigned nloc = b.st[0], nx = b.st[1];
        if (nloc == 0u) { xcd_barrier_complete(bar, b.x, nloc, nx); b.st[0] = nloc; b.st[1] = nx; }
        const unsigned old = xb_add(&bar[XB_XSUB(b.x)], 1u);
        const unsigned gen = old / nloc;
        if (old + 1u == (gen + 1u) * nloc) {
            __builtin_amdgcn_fence(__ATOMIC_RELEASE, "agent");
            asm volatile("s_waitcnt vmcnt(0)" ::: "memory");
            const unsigned og = xb_add(&bar[XB_TOP], 1u);
            const unsigned tg = og / nx;
            if (og + 1u == (tg + 1u) * nx) xb_add(&bar[XB_TOPGEN], 1u);
            else XB_SPIN(xb_ld(&bar[XB_TOPGEN]) == tg, bar);
            __builtin_amdgcn_fence(__ATOMIC_ACQUIRE, "agent");
            xb_add(&bar[XB_XGEN(b.x)], 1u);
            asm volatile("s_waitcnt vmcnt(0)" ::: "memory");
        } else {
            XB_SPIN(xb_ld(&bar[XB_XGEN(b.x)]) == gen, bar);
            __builtin_amdgcn_fence(__ATOMIC_ACQUIRE, "agent");
            asm volatile("s_waitcnt vmcnt(0)" ::: "memory");
        }
    }
    __syncthreads();
}

constexpr int LDS_BYTES = 132096;
constexpr int PH_FINAL = 25, PH_END = 26;
constexpr size_t WS_BAR = WS_MOD + 262144;
constexpr int MISC_OFF = 131072;
__global__ void __launch_bounds__(512, 2) mega(Params Pk, int ph_lo, int ph_hi) {
#if defined(__HIP_DEVICE_COMPILE__)
    extern __shared__ __attribute__((aligned(16))) unsigned char lds_raw[];
    LAS unsigned char* lds = (LAS unsigned char*)lds_raw;
    volatile LAS unsigned* MISC = (volatile LAS unsigned*)(lds + MISC_OFF);
    if (threadIdx.x < 32) MISC[threadIdx.x] = 0u;
    __syncthreads();
    XcdBarrier bar; bar.bar = nullptr; bar.x = 0; bar.st = nullptr;
    for (int ph = ph_lo; ph < ph_hi; ++ph) {
        KP P = (KP)__builtin_amdgcn_kernarg_segment_ptr(); asm volatile("" : "+s"(P));
        if (ph == 0 && blockIdx.x == 0) { unsigned* bw = (unsigned*)(P->ws + WS_BAR); for (int i = threadIdx.x; i < XCD_BAR_WORDS; i += 512) bw[i] = 0u; }
        unsigned char* ws = P->ws;
        float* H = (float*)(ws + WS_H); bf16_t* XN = (bf16_t*)(ws + WS_XN); bf16_t* MID = (bf16_t*)(ws + WS_MID);
        if (ph == 0) prologue_phase(P, lds);
        else if (ph == PH_FINAL) final_phase(P);
        else {
            const int l = (ph - 1) / 12, s = (ph - 1) % 12;
            const float* MODl = (const float*)(ws + WS_MOD) + (size_t)l * 3 * NMOD;
            const bf16_t* WT = (const bf16_t*)(ws + WS_WT) + (size_t)l * WT_L;
            if (s == 0 || s == 3 || s == 8) {
                const float* g = (s == 0 ? P->g_ffn1 : s == 3 ? P->g_mix : P->g_ffn2) + l * 1024; const int shc = s == 0 ? 0 : s == 3 ? 3 : 6;
                norm_phase(P, g, MODl, shc, shc + 1, ph == 1, ph == 1 ? 0 : (s == 8 ? (l == 1 ? 0 : 3) : 10));
            } else if (s == 1 || s == 2 || s == 4 || s == 7 || s == 9 || s == 10) {
                const int mode = (s == 1 || s == 9) ? 0 : (s == 4 ? 2 : 1);
                pg8::EpiAll E{ws, P->g_qn + l * 64, P->g_kn + l * 64, mode, l, s == 2 ? 2 : s == 7 ? 5 : 8, s == 7 ? 1.0f : 0.5f};
                const bf16_t* A = (s == 2 || s == 10) ? MID : XN;
                const bf16_t* Bt = WT + (mode == 0 ? WT_GU + (size_t)(s == 9 ? 1 : 0) * 5632 * 1024 : mode == 2 ? WT_IN : s == 7 ? WT_OUT : WT_DN + (size_t)(s == 10 ? 1 : 0) * 1024 * MIDP);
                const int N = mode == 0 ? 5632 : mode == 2 ? NIN : 1024, K = (s == 2 || s == 10) ? DFF : 1024;
                run_gemm(lds, A, Bt, N, K, (s == 2 || s == 10) ? DFF : 1024, (s == 2 || s == 10) ? 1 : 0, (l == 1 && s >= 7) ? 1 : 0, E);
            }
            else if (s == 5) {
#if FAST_FFT
                fft1_phase(P, l);
#endif
#if FAST_ATTN
                attn_phase(P, lds, l);
#endif
            }
#if FAST_FFT
            else if (s == 6) fft3_phase(P, lds, l);
#endif
        }
        if (ph + 1 < ph_hi) {
            if (ph == 0) { cg::this_grid().sync(); bar = xcd_barrier_post((unsigned*)(P->ws + WS_BAR), MISC + 8); }
            else xcd_barrier(bar);
        }
    }
#endif
}

extern "C" void kernel_launch(void* const* d_in, const int* in_sizes, int n_in, void* d_out, int out_size, void* d_ws, size_t ws_size, hipStream_t stream) {
    static int grid = 0;
    if (grid == 0) {
        if (ws_size < WS_END || n_in < 22) { fprintf(stderr, "kernel_launch: ws too small (%zu) or n_in %d\n", ws_size, n_in); grid = -1; return; }
        if (hipFuncSetAttribute((const void*)mega, hipFuncAttributeMaxDynamicSharedMemorySize, LDS_BYTES) != hipSuccess) { fprintf(stderr, "kernel_launch: hipFuncSetAttribute failed\n"); grid = -1; return; }
        int dev = 0, cus = 0, per_cu = 0; hipGetDevice(&dev); hipDeviceGetAttribute(&cus, hipDeviceAttributeMultiprocessorCount, dev);
        if (hipOccupancyMaxActiveBlocksPerMultiprocessor(&per_cu, (const void*)mega, 512, LDS_BYTES) != hipSuccess || per_cu < 1) { fprintf(stderr, "kernel_launch: occupancy query says %d\n", per_cu); grid = -1; return; }
        grid = cus;
    }
    if (grid < 0) return;
    Params P{};
    const float** pp = (const float**)&P;
    for (int i = 0; i < 22; ++i) pp[i] = (const float*)d_in[i];
    P.out = (float*)d_out; P.ws = (unsigned char*)d_ws;
    int lo = 0, hi = PH_END;
    void* args[] = {&P, &lo, &hi};
    hipError_t e = hipLaunchCooperativeKernel((const void*)mega, dim3(grid), dim3(512), args, LDS_BYTES, stream);
    if (e != hipSuccess) fprintf(stderr, "kernel_launch: cooperative launch failed: %s (grid %d)\n", hipGetErrorString(e), grid);
}
```
